# Optimizing an MI355X kernel written in HIP

```python
import jax, jax.numpy as jnp
from jax import lax
import numpy as np

D_MODEL = 1024
BATCH = 4
SEQ = 8192
DEPTH = 1

MIX_WIDTH = D_MODEL
ATTN_HEAD_DIM = 64
ATTN_WIDTH = MIX_WIDTH // 2
N_ATTN_HEADS = ATTN_WIDTH // ATTN_HEAD_DIM
DILATED_PATTERNS = ((128, 1), (512, 4), (2048, 16))
ATTN_BLOCK = 128
RET_V_DIM = 128
RET_V_WIDTH = MIX_WIDTH - ATTN_WIDTH
N_RET_HEADS = RET_V_WIDTH // RET_V_DIM
RET_QK_DIM = RET_V_DIM // 2
RET_QK_WIDTH = N_RET_HEADS * RET_QK_DIM
RET_CHUNK = 128
ROPE_BASE = 10000.0
D_FF = ((8 * D_MODEL // 3 + 127) // 128) * 128
CONV_WIDTH = 3
NORM_EPS = 1e-6
MASK_VALUE = -1e30
IN_SPLITS = (ATTN_WIDTH, ATTN_WIDTH, ATTN_WIDTH,
             RET_QK_WIDTH, RET_QK_WIDTH, RET_V_WIDTH,
             RET_V_WIDTH)
IN_WIDTH = sum(IN_SPLITS)
SPLIT_POINTS = tuple(int(i) for i in np.cumsum(IN_SPLITS)[:-1])

kernel_name = "hybrid_dilated_attn_retention_convffn"


def rms_norm(x, gain):
    xf = x.astype(jnp.float32)
    y = xf * lax.rsqrt(jnp.mean(xf * xf, axis=-1, keepdims=True) + NORM_EPS)
    return (y * gain.astype(jnp.float32)).astype(x.dtype)


def dilated_window_attention(q, k, v, window, dilation):
    b, s, h, e = q.shape
    steps = window // dilation
    assert steps <= ATTN_BLOCK
    sub_len = s // dilation
    nb = -(-sub_len // ATTN_BLOCK)
    sub_pad = nb * ATTN_BLOCK

    def to_sub(t):
        t = t.reshape(b, sub_len, dilation, h, e).transpose(0, 2, 1, 3, 4)
        return jnp.pad(t, ((0, 0), (0, 0), (0, sub_pad - sub_len), (0, 0), (0, 0)))

    def with_prev(t):
        tb = t.reshape(b, dilation, nb, ATTN_BLOCK, h, e)
        prev = jnp.pad(tb, ((0, 0), (0, 0), (1, 0), (0, 0), (0, 0), (0, 0)))[:, :, :-1]
        return jnp.concatenate([prev, tb], axis=3)

    qb = to_sub(q * (e ** -0.5)).reshape(b, dilation, nb, ATTN_BLOCK, h, e)
    kb = with_prev(to_sub(k))
    vb = with_prev(to_sub(v))
    scores = jnp.einsum('brnqhe,brnkhe->brnhqk', qb, kb).astype(jnp.float32)
    o_idx = jnp.arange(ATTN_BLOCK)[:, None]
    j_idx = jnp.arange(2 * ATTN_BLOCK)[None, :]
    dist = o_idx + ATTN_BLOCK - j_idx
    band = (dist >= 0) & (dist <= steps)
    key_pos = jnp.arange(nb)[:, None, None] * ATTN_BLOCK + j_idx[None] - ATTN_BLOCK
    mask = band[None] & (key_pos >= 0)
    scores = jnp.where(mask[None, None, :, None], scores, MASK_VALUE)
    lse = jax.nn.logsumexp(scores, axis=-1)
    probs = jnp.exp(scores - lse[..., None])
    out = jnp.einsum('brnhqk,brnkhe->brnqhe', probs.astype(v.dtype), vb)
    out = out.reshape(b, dilation, sub_pad, h, e)[:, :, :sub_len]
    out = out.transpose(0, 2, 1, 3, 4).reshape(b, s, h, e)
    lse = lse.transpose(0, 1, 2, 4, 3).reshape(b, dilation, sub_pad, h)[:, :, :sub_len]
    lse = lse.transpose(0, 2, 1, 3).reshape(b, s, h)
    return out, lse


def longnet_attention(q, k, v):
    outs, lses = [], []
    for window, dilation in DILATED_PATTERNS:
        o, l = dilated_window_attention(q, k, v, window, dilation)
        outs.append(o)
        lses.append(l)
    weights = jax.nn.softmax(jnp.stack(lses), axis=0)
    out = jnp.einsum('pbsh,pbshe->bshe', weights, jnp.stack(outs).astype(jnp.float32))
    return out.astype(q.dtype)


def rotary(x, positions):
    e = x.shape[-1]
    freqs = ROPE_BASE ** (-jnp.arange(0, e, 2, dtype=jnp.float32) / e)
    ang = positions.astype(jnp.float32)[:, None] * freqs[None]
    cos = jnp.cos(ang)[None, :, None, :]
    sin = jnp.sin(ang)[None, :, None, :]
    x1, x2 = x[..., : e // 2], x[..., e // 2:]
    return jnp.concatenate([x1 * cos - x2 * sin, x1 * sin + x2 * cos], axis=-1)


def chunkwise_retention(q, k, v):
    b, s, h, dk = q.shape
    dv = v.shape[-1]
    n = s // RET_CHUNK
    log_gamma = jnp.log1p(-jnp.exp2(-5.0 - jnp.arange(h, dtype=jnp.float32)))
    idx = jnp.arange(RET_CHUNK, dtype=jnp.float32)
    rel = idx[:, None] - idx[None, :]
    inner_decay = jnp.where(rel >= 0, jnp.exp(log_gamma[:, None, None] * jnp.maximum(rel, 0.0)), 0.0)
    qc = q.reshape(b, n, RET_CHUNK, h, dk)
    kc = k.reshape(b, n, RET_CHUNK, h, dk)
    vc = v.reshape(b, n, RET_CHUNK, h, dv)
    scores = jnp.einsum('bnihd,bnjhd->bnhij', qc, kc) * inner_decay
    inner = jnp.einsum('bnhij,bnjhe->bnihe', scores, vc)
    k_decay = jnp.exp(log_gamma[None, :] * (RET_CHUNK - 1 - idx)[:, None])
    chunk_kv = jnp.einsum('bnjhd,bnjhe->nbhde', kc * k_decay[:, :, None], vc)
    chunk_decay = jnp.exp(log_gamma * RET_CHUNK)[None, :, None, None]

    def step(state, kv):
        return chunk_decay * state + kv, state

    _, prev_states = lax.scan(step, jnp.zeros((b, h, dk, dv), jnp.float32), chunk_kv)
    q_decay = jnp.exp(log_gamma[None, :] * (idx + 1.0)[:, None])
    cross = jnp.einsum('bnihd,nbhde->bnihe', qc * q_decay[:, :, None], prev_states)
    return (inner + cross).reshape(b, s, h, dv)


def hybrid_mixer(h, w_in, w_out):
    b, s, _ = h.shape
    proj = h @ w_in
    q_a, k_a, v_a, q_r, k_r, v_r, g_r = jnp.split(proj, SPLIT_POINTS, axis=-1)
    heads_a = lambda t: t.reshape(b, s, N_ATTN_HEADS, ATTN_HEAD_DIM)
    attn = longnet_attention(heads_a(q_a), heads_a(k_a), heads_a(v_a)).reshape(b, s, ATTN_WIDTH)
    positions = jnp.arange(s)
    qr = rotary(q_r.astype(jnp.float32).reshape(b, s, N_RET_HEADS, RET_QK_DIM), positions)
    kr = rotary(k_r.astype(jnp.float32).reshape(b, s, N_RET_HEADS, RET_QK_DIM), positions) * (RET_QK_DIM ** -0.5)
    vr = v_r.astype(jnp.float32).reshape(b, s, N_RET_HEADS, RET_V_DIM)
    ret = chunkwise_retention(qr, kr, vr)
    ret = ret * lax.rsqrt(jnp.mean(ret * ret, axis=-1, keepdims=True) + NORM_EPS)
    ret = ret.reshape(b, s, RET_V_WIDTH) * jax.nn.silu(g_r.astype(jnp.float32))
    mixed = jnp.concatenate([attn, ret.astype(h.dtype)], axis=-1)
    return mixed @ w_out


def shift_right(t, n):
    return jnp.pad(t, ((0, 0), (n, 0), (0, 0)))[:, : t.shape[1]]


def conv_ffn(h, w_up, conv_w, conv_b, w_down):
    u = h @ w_up
    y = conv_b + conv_w[CONV_WIDTH - 1] * u
    for tap in range(1, CONV_WIDTH):
        y = y + conv_w[CONV_WIDTH - 1 - tap] * shift_right(u, tap)
    gate, up = jnp.split(y, 2, axis=-1)
    return (jax.nn.gelu(gate, approximate=True) * up) @ w_down


def setup_inputs(seed: int = 0) -> dict:
    key = jax.random.key(seed)
    ks = jax.random.split(key, 11)
    f32 = jnp.float32

    def gain(k):
        return 1.0 + 0.05 * jax.random.normal(k, (DEPTH, D_MODEL), f32)

    return {
        "x": jax.random.normal(ks[0], (BATCH, SEQ, D_MODEL), f32),
        "mix_pre_gain": gain(ks[1]),
        "mix_post_gain": gain(ks[2]),
        "w_in": jax.random.normal(ks[3], (DEPTH, D_MODEL, IN_WIDTH), f32) * D_MODEL ** -0.5,
        "w_out": jax.random.normal(ks[4], (DEPTH, MIX_WIDTH, D_MODEL), f32) * MIX_WIDTH ** -0.5,
        "ffn_pre_gain": gain(ks[5]),
        "ffn_post_gain": gain(ks[6]),
        "w_up": jax.random.normal(ks[7], (DEPTH, D_MODEL, 2 * D_FF), f32) * D_MODEL ** -0.5,
        "conv_w": jax.random.normal(ks[8], (DEPTH, CONV_WIDTH, 2 * D_FF), f32) * CONV_WIDTH ** -0.5,
        "conv_b": 0.02 * jax.random.normal(ks[9], (DEPTH, 2 * D_FF), f32),
        "w_down": jax.random.normal(ks[10], (DEPTH, D_FF, D_MODEL), f32) * D_FF ** -0.5,
    }


def reference(x, mix_pre_gain, mix_post_gain, w_in, w_out, ffn_pre_gain, ffn_post_gain,
              w_up, conv_w, conv_b, w_down):
    for layer in range(DEPTH):
        mix = hybrid_mixer(rms_norm(x, mix_pre_gain[layer]), w_in[layer], w_out[layer])
        x = x + rms_norm(mix, mix_post_gain[layer])
        ffn = conv_ffn(rms_norm(x, ffn_pre_gain[layer]), w_up[layer], conv_w[layer],
                       conv_b[layer], w_down[layer])
        x = x + rms_norm(ffn, ffn_post_gain[layer])
    return x
```

```cpp
#include <hip/hip_runtime.h>
#include <cstdio>
#include <cstdint>

namespace nv {
constexpr int B = 4, S = 8192, D = 1024, INW = 3072, FF = 2816, FF2 = 5632;
constexpr float EPS = 1e-6f;
__device__ const float ROPE_F[32] = {1.000000000e+00f, 7.498942018e-01f, 5.623413324e-01f, 4.216965139e-01f, 3.162277639e-01f, 2.371373773e-01f, 1.778279394e-01f, 1.333521456e-01f, 1.000000015e-01f, 7.498942316e-02f, 5.623413250e-02f, 4.216964915e-02f, 3.162277490e-02f, 2.371373773e-02f, 1.778279431e-02f, 1.333521400e-02f, 9.999999776e-03f, 7.498942316e-03f, 5.623413250e-03f, 4.216964822e-03f, 3.162277630e-03f, 2.371373819e-03f, 1.778279431e-03f, 1.333521446e-03f, 1.000000047e-03f, 7.498941850e-04f, 5.623413017e-04f, 4.216965172e-04f, 3.162277571e-04f, 2.371373703e-04f, 1.778279402e-04f, 1.333521504e-04f};

__device__ __forceinline__ float wave_sum(float v) {
#pragma unroll
    for (int o = 1; o < 64; o <<= 1) v += __shfl_xor(v, o);
    return v;
}

__global__ void __launch_bounds__(256) k_rmsnorm(const float* __restrict__ in, const float* __restrict__ gain, const float* res, float* out, int rows) {
    const int row = blockIdx.x * 4 + (threadIdx.x >> 6), lane = threadIdx.x & 63;
    if (row >= rows) return;
    const float* p = in + (size_t)row * D;
    float v[16]; float s = 0.f;
#pragma unroll
    for (int j = 0; j < 16; ++j) { v[j] = p[lane + 64 * j]; s += v[j] * v[j]; }
    s = wave_sum(s);
    const float r = 1.0f / sqrtf(s * (1.0f / D) + EPS);
#pragma unroll
    for (int j = 0; j < 16; ++j) {
        float o = v[j] * r * gain[lane + 64 * j];
        if (res) o += res[(size_t)row * D + lane + 64 * j];
        out[(size_t)row * D + lane + 64 * j] = o;
    }
}

__global__ void __launch_bounds__(256) k_gemm(const float* __restrict__ A, const float* __restrict__ Bm, float* __restrict__ C, int M, int N, int K) {
    __shared__ float As[8][128 + 4];
    __shared__ float Bs[8][128 + 4];
    const int tid = threadIdx.x, tx = tid & 15, ty = tid >> 4;
    const int m0 = blockIdx.y * 128, n0 = blockIdx.x * 128;
    float acc[8][8];
#pragma unroll
    for (int i = 0; i < 8; ++i)
#pragma unroll
        for (int j = 0; j < 8; ++j) acc[i][j] = 0.f;
    for (int k0 = 0; k0 < K; k0 += 8) {
#pragma unroll
        for (int i = 0; i < 4; ++i) { const int e = tid + 256 * i; const int r = e >> 3, kk = e & 7; As[kk][r] = A[(size_t)(m0 + r) * K + k0 + kk]; }
#pragma unroll
        for (int i = 0; i < 4; ++i) { const int e = tid + 256 * i; const int kk = e >> 7, c = e & 127; Bs[kk][c] = Bm[(size_t)(k0 + kk) * N + n0 + c]; }
        __syncthreads();
#pragma unroll
        for (int kk = 0; kk < 8; ++kk) {
            float a[8], b[8];
#pragma unroll
            for (int i = 0; i < 8; ++i) a[i] = As[kk][ty * 8 + i];
#pragma unroll
            for (int j = 0; j < 8; ++j) b[j] = Bs[kk][tx * 8 + j];
#pragma unroll
            for (int i = 0; i < 8; ++i)
#pragma unroll
                for (int j = 0; j < 8; ++j) acc[i][j] = fmaf(a[i], b[j], acc[i][j]);
        }
        __syncthreads();
    }
#pragma unroll
    for (int i = 0; i < 8; ++i)
#pragma unroll
        for (int j = 0; j < 8; ++j) C[(size_t)(m0 + ty * 8 + i) * N + n0 + tx * 8 + j] = acc[i][j];
}

__global__ void __launch_bounds__(256) k_attn(const float* __restrict__ proj, float* __restrict__ mixed) {
    const int w = blockIdx.x * 4 + (threadIdx.x >> 6), lane = threadIdx.x & 63;
    const int t = w >> 3, h = w & 7;
    const float q = proj[(size_t)t * INW + h * 64 + lane] * 0.125f;
    float m = -1e30f, l = 0.f, o = 0.f;
    for (int p = 0; p < 3; ++p) {
        const int d = 1 << (2 * p);
        for (int j = 0; j <= 128; ++j) {
            const int kt = t - j * d;
            if (kt < 0) break;
            const float kk = proj[(size_t)kt * INW + 512 + h * 64 + lane];
            const float vv = proj[(size_t)kt * INW + 1024 + h * 64 + lane];
            const float s = wave_sum(q * kk);
            const float mn = fmaxf(m, s);
            const float sc = expf(m - mn), pe = expf(s - mn);
            l = l * sc + pe; o = o * sc + pe * vv; m = mn;
        }
    }
    mixed[(size_t)t * D + h * 64 + lane] = o / l;
}

__global__ void __launch_bounds__(256) k_rotary(const float* __restrict__ proj, float* __restrict__ qr, float* __restrict__ kr) {
    const int t = blockIdx.x, c = threadIdx.x;
    const int e = c & 63, i = e & 31;
    const float ang = (float)t * ROPE_F[i];
    const float cs = cosf(ang), sn = sinf(ang);
    const float* pq = proj + (size_t)t * INW + 1536 + (c & ~63);
    const float* pk = proj + (size_t)t * INW + 1792 + (c & ~63);
    float oq, ok;
    if (e < 32) { oq = pq[i] * cs - pq[i + 32] * sn; ok = pk[i] * cs - pk[i + 32] * sn; }
    else        { oq = pq[i] * sn + pq[i + 32] * cs; ok = pk[i] * sn + pk[i + 32] * cs; }
    qr[(size_t)t * 256 + c] = oq; kr[(size_t)t * 256 + c] = ok * 0.125f;
}

__device__ __forceinline__ float lgam(int h) { return log1pf(-exp2f(-5.0f - (float)h)); }

__global__ void __launch_bounds__(256) k_retkv(const float* __restrict__ proj, const float* __restrict__ kr, float* __restrict__ kv) {
    const int n = blockIdx.x, h = blockIdx.y, tid = threadIdx.x;
    const float lg = lgam(h);
    const int e = tid & 127, d0 = (tid >> 7) * 32;
    float acc[32];
#pragma unroll
    for (int i = 0; i < 32; ++i) acc[i] = 0.f;
    for (int j = 0; j < 128; ++j) {
        const int t = n * 128 + j;
        const float vv = proj[(size_t)t * INW + 2048 + h * 128 + e] ;
        const float dec = expf(lg * (float)(127 - j));
        const float* kp = kr + (size_t)t * 256 + h * 64 + d0;
#pragma unroll
        for (int i = 0; i < 32; ++i) acc[i] = fmaf(kp[i] * dec, vv, acc[i]);
    }
#pragma unroll
    for (int i = 0; i < 32; ++i) kv[(((size_t)h * 64 + n) * 64 + d0 + i) * 128 + e] = acc[i];
}
__global__ void __launch_bounds__(256) k_retscan(float* __restrict__ kv) {
    const int idx = blockIdx.x * 256 + threadIdx.x;
    const int h = idx >> 13, de = idx & 8191;
    const float cd = expf(lgam(h) * 128.0f);
    float st = 0.f;
    for (int n = 0; n < 64; ++n) {
        float* p = kv + ((size_t)h * 64 + n) * 8192 + de;
        const float cur = *p; *p = st; st = cd * st + cur;
    }
}
__global__ void __launch_bounds__(256) k_retout(const float* __restrict__ proj, const float* __restrict__ qr, const float* __restrict__ kr, const float* __restrict__ kvp, float* __restrict__ mixed) {
    extern __shared__ float sm[];
    float* Ks = sm;
    float* Vs = sm + 128 * 64;
    float* red = Vs + 128 * 128;
    const int n = blockIdx.x, h = blockIdx.y, tid = threadIdx.x, i = tid & 127, eh = tid >> 7;
    const float lg = lgam(h);
    for (int x = tid; x < 128 * 64; x += 256) { const int j = x >> 6, d = x & 63; Ks[x] = kr[(size_t)(n * 128 + j) * 256 + h * 64 + d]; }
    for (int x = tid; x < 128 * 128; x += 256) { const int j = x >> 7, e = x & 127; Vs[x] = proj[(size_t)(n * 128 + j) * INW + 2048 + h * 128 + e]; }
    __syncthreads();
    const int t = n * 128 + i;
    float q[64];
#pragma unroll
    for (int d = 0; d < 64; ++d) q[d] = qr[(size_t)t * 256 + h * 64 + d];
    float acc[64];
#pragma unroll
    for (int e = 0; e < 64; ++e) acc[e] = 0.f;
    for (int j = 0; j < 128; ++j) {
        float s = 0.f;
#pragma unroll
        for (int d = 0; d < 64; ++d) s = fmaf(q[d], Ks[j * 64 + d], s);
        s = (j <= i) ? s * expf(lg * (float)(i - j)) : 0.f;
#pragma unroll
        for (int e = 0; e < 64; ++e) acc[e] = fmaf(s, Vs[j * 128 + eh * 64 + e], acc[e]);
    }
    const float qd = expf(lg * (float)(i + 1));
    const float* Sp = kvp + ((size_t)h * 64 + n) * 8192;
#pragma unroll
    for (int d = 0; d < 64; ++d) {
        const float qq = q[d] * qd;
#pragma unroll
        for (int e = 0; e < 64; ++e) acc[e] = fmaf(qq, Sp[d * 128 + eh * 64 + e], acc[e]);
    }
    float ss = 0.f;
#pragma unroll
    for (int e = 0; e < 64; ++e) ss += acc[e] * acc[e];
    red[tid] = ss;
    __syncthreads();
    const float tot = red[i] + red[i + 128];
    const float r = 1.0f / sqrtf(tot * (1.0f / 128.0f) + EPS);
#pragma unroll
    for (int e = 0; e < 64; ++e) {
        const float g = proj[(size_t)t * INW + 2560 + h * 128 + eh * 64 + e];
        const float sg = g / (1.0f + expf(-g));
        mixed[(size_t)t * D + 512 + h * 128 + eh * 64 + e] = acc[e] * r * sg;
    }
}

__global__ void __launch_bounds__(256) k_convact(const float* __restrict__ u, const float* __restrict__ cw, const float* __restrict__ cb, float* __restrict__ act) {
    const size_t idx = (size_t)blockIdx.x * 256 + threadIdx.x;
    const int t = (int)(idx / FF), j = (int)(idx % FF);
    float y[2];
#pragma unroll
    for (int g = 0; g < 2; ++g) {
        const int c = j + g * FF;
        float v = cb[c] + cw[2 * FF2 + c] * u[(size_t)t * FF2 + c];
        if (t >= 1) v += cw[1 * FF2 + c] * u[(size_t)(t - 1) * FF2 + c];
        if (t >= 2) v += cw[0 * FF2 + c] * u[(size_t)(t - 2) * FF2 + c];
        y[g] = v;
    }
    const float x = y[0];
    const float gl = 0.5f * x * (1.0f + tanhf(0.7978845608028654f * (x + 0.044715f * x * x * x)));
    act[idx] = gl * y[1];
}
}

extern "C" void kernel_launch(void* const* d_in, const int* in_sizes, int n_in, void* d_out, int out_size, void* d_ws, size_t ws_size, hipStream_t stream) {
    using namespace nv;
    const float* x = (const float*)d_in[0];
    const float* g_pre = (const float*)d_in[1];
    const float* g_post = (const float*)d_in[2];
    const float* w_in = (const float*)d_in[3];
    const float* w_out = (const float*)d_in[4];
    const float* g_fpre = (const float*)d_in[5];
    const float* g_fpost = (const float*)d_in[6];
    const float* w_up = (const float*)d_in[7];
    const float* conv_w = (const float*)d_in[8];
    const float* conv_b = (const float*)d_in[9];
    const float* w_down = (const float*)d_in[10];
    float* out = (float*)d_out;
    char* ws = (char*)d_ws;
    const size_t MB = 1u << 20;
    float* hbuf = (float*)(ws);
    float* proj = (float*)(ws + 32 * MB);
    float* qr = (float*)(ws + 128 * MB);
    float* kr = (float*)(ws + 136 * MB);
    float* kv = (float*)(ws + 144 * MB);
    float* mixed = (float*)(ws + 152 * MB);
    float* mix = (float*)(ws + 184 * MB);
    float* ubuf = (float*)(ws + 216 * MB);
    float* act = (float*)(ws + 32 * MB);
    float* ffn = (float*)(ws + 152 * MB);
    static bool attr = false;
    if (!attr) { (void)hipFuncSetAttribute((const void*)k_retout, hipFuncAttributeMaxDynamicSharedMemorySize, (128 * 64 + 128 * 128 + 256) * 4); attr = true; }
    for (int b = 0; b < B; ++b) {
        const float* xb = x + (size_t)b * S * D;
        float* ob = out + (size_t)b * S * D;
        k_rmsnorm<<<S / 4, 256, 0, stream>>>(xb, g_pre, nullptr, hbuf, S);
        k_gemm<<<dim3(INW / 128, S / 128), 256, 0, stream>>>(hbuf, w_in, proj, S, INW, D);
        k_attn<<<S * 8 / 4, 256, 0, stream>>>(proj, mixed);
        k_rotary<<<S, 256, 0, stream>>>(proj, qr, kr);
        k_retkv<<<dim3(64, 4), 256, 0, stream>>>(proj, kr, kv);
        k_retscan<<<4 * 8192 / 256, 256, 0, stream>>>(kv);
        k_retout<<<dim3(64, 4), 256, (128 * 64 + 128 * 128 + 256) * 4, stream>>>(proj, qr, kr, kv, mixed);
        k_gemm<<<dim3(D / 128, S / 128), 256, 0, stream>>>(mixed, w_out, mix, S, D, D);
        k_rmsnorm<<<S / 4, 256, 0, stream>>>(mix, g_post, xb, ob, S);
        k_rmsnorm<<<S / 4, 256, 0, stream>>>(ob, g_fpre, nullptr, hbuf, S);
        k_gemm<<<dim3(FF2 / 128, S / 128), 256, 0, stream>>>(hbuf, w_up, ubuf, S, FF2, D);
        k_convact<<<(unsigned)((size_t)S * FF / 256), 256, 0, stream>>>(ubuf, conv_w, conv_b, act);
        k_gemm<<<dim3(D / 128, S / 128), 256, 0, stream>>>(act, w_down, ffn, S, D, FF);
        k_rmsnorm<<<S / 4, 256, 0, stream>>>(ffn, g_fpost, ob, ob, S);
    }
}
```

```cpp
#include <hip/hip_runtime.h>
#include <cstdio>
#include <cstdint>
#define MK_N_LAUNCHES 1
namespace pg8 {
#define PG8_LAS __attribute__((address_space(3)))
typedef unsigned short bf16_t;
typedef short bf16x8 __attribute__((ext_vector_type(8)));
typedef float f32x4 __attribute__((ext_vector_type(4)));
typedef unsigned u32x4 __attribute__((ext_vector_type(4)));
constexpr int BM = 256, BK = 64, HALF = 128, HTB = HALF * BK * 2  , STAGE_BYTES = 8 * HTB, NXCD = 8, WGM = 8;

__host__ __device__ __forceinline__ int lds_byte(int r, int c) { const int st = (r >> 4) * 2 + (c >> 5), rr = r & 15, cc = c & 31, ob = rr * 64 + cc * 2; return st * 1024 + (ob ^ (((ob >> 9) & 1) << 5)); }
__host__ __device__ __forceinline__ void stage_rc(int b, int& R, int& C) { const int st = b / 1024, sb = b % 1024, swz = sb ^ (((sb >> 9) & 1) << 5); R = (st >> 1) * 16 + swz / 64; C = (st & 1) * 32 + (swz % 64) / 2; }
__host__ __device__ __forceinline__ int perm32(int rho) { const int n = rho >> 4, i = rho & 15; return 8 * (i >> 2) + 4 * n + (i & 3); }

struct Unit { int pm, pn; };
struct Gemm { const bf16_t* A; const bf16_t* Bt; int M, N, K; };

struct StaticOrder {
    int nM, nN, nwg, G, c;
    __host__ __device__ void init(int M, int N, int G_, int c_) { nM = M / BM; nN = N / BM; nwg = nM * nN; G = G_; c = c_; }
    __host__ __device__ bool next(int i, Unit& u) const {
        const long L = (long)i * G + c; if (L >= nwg) return false;
        int wgid = (int)L; { const int q = nwg / NXCD, r = nwg % NXCD, xcd = wgid % NXCD, off = wgid / NXCD; wgid = (xcd < r ? xcd * (q + 1) : r * (q + 1) + (xcd - r) * q) + off; }
        const int nig = WGM * nN, gid = wgid / nig, fm = gid * WGM, gsz = (nM - fm) < WGM ? (nM - fm) : WGM;
        u.pm = fm + ((wgid % nig) % gsz); u.pn = (wgid % nig) / gsz; return true;
    }
    __device__ __forceinline__ void a_ready(const Unit&) const {}
    __device__ __forceinline__ void done(const Unit&) const {}
};

__device__ __forceinline__ unsigned cvt_pk_bf16(float lo, float hi) { unsigned r; asm volatile("v_cvt_pk_bf16_f32 %0, %1, %2" : "=v"(r) : "v"(lo), "v"(hi)); return r; }
typedef float f32x2 __attribute__((ext_vector_type(2)));
__device__ __forceinline__ f32x2 gelu_pk(f32x2 v) {
    const f32x2 av = __builtin_elementwise_abs(v), d = av * 0.2316418882f + 1.0f;
    f32x2 t; t.x = __builtin_amdgcn_rcpf(d.x); t.y = __builtin_amdgcn_rcpf(d.y);
    f32x2 q = t * 0.5307027145f + (-0.7265760135f); q = q * t + 0.7107068705f; q = q * t + (-0.142248368f); q = q * t + 0.127414796f; q = q * t;
    const f32x2 s = (v * v) * (-0.72134752044f);
    f32x2 e; e.x = __builtin_amdgcn_exp2f(s.x); e.y = __builtin_amdgcn_exp2f(s.y);
    const f32x2 m = v * (q * e), r = v - m;
    f32x2 o; o.x = v.x < 0.f ? m.x : r.x; o.y = v.y < 0.f ? m.y : r.y; return o;
}

template <int ACT  > struct EpiBf16 {
    static constexpr bool PERM = true, AFTER_DRAIN = false; static_assert(ACT == 0 || ACT == 1, "EpiBf16: ACT is 0 (none) or 1 (gelu_pk)");
    bf16_t* O; int ldc; const float* bias; int split_cols; size_t split_stride; float scale0;
    __device__ __forceinline__ void operator()(const f32x4 (&acc)[2][2][4][2], const Unit& u, int wr, int wc, int fr, int fq) const {
        const int row0 = u.pm * BM + wr * 64 + fr; int colt = u.pn * BM; bf16_t* base = O;
        float sc = 1.f; if (split_cols) { const int t = colt / split_cols; base += (size_t)t * split_stride; colt -= t * split_cols; if (t == 0) sc = scale0; }
        const int col0 = colt + wc * 32 + 8 * fq, bcol0 = u.pn * BM + wc * 32 + 8 * fq;
        f32x4 bv[2][2];
#pragma unroll
        for (int bj = 0; bj < 2; ++bj)
#pragma unroll
            for (int n = 0; n < 2; ++n) bv[bj][n] = bias ? *(const f32x4*)(bias + bcol0 + bj * HALF + 4 * n) : (f32x4){0.f, 0.f, 0.f, 0.f};
#pragma unroll
        for (int ai = 0; ai < 2; ++ai)
#pragma unroll
            for (int m = 0; m < 4; ++m) { bf16_t* rowp = base + (size_t)(row0 + ai * HALF + m * 16) * ldc + col0;
#pragma unroll
                for (int bj = 0; bj < 2; ++bj) { f32x4 v0 = acc[ai][bj][m][0] + bv[bj][0], v1 = acc[ai][bj][m][1] + bv[bj][1];
                    if (ACT == 1) { f32x2 a = gelu_pk((f32x2){v0[0], v0[1]}), b = gelu_pk((f32x2){v0[2], v0[3]}), c = gelu_pk((f32x2){v1[0], v1[1]}), d = gelu_pk((f32x2){v1[2], v1[3]});
                        v0 = (f32x4){a.x, a.y, b.x, b.y}; v1 = (f32x4){c.x, c.y, d.x, d.y}; }
                    v0 = v0 * sc; v1 = v1 * sc; u32x4 w; w.x = cvt_pk_bf16(v0[0], v0[1]); w.y = cvt_pk_bf16(v0[2], v0[3]); w.z = cvt_pk_bf16(v1[0], v1[1]); w.w = cvt_pk_bf16(v1[2], v1[3]);
                    *(u32x4*)(rowp + bj * HALF) = w; } }
    }
};

struct PanelStats {
    unsigned* xbuf;
    unsigned* cnt;
    unsigned* tmo;
    int ntn; float eps;
    unsigned code;
    __device__ __forceinline__ bool run(const f32x4 (&v)[2][2][4][2], const Unit& u, int wr, int wc, int fr, int fq, PG8_LAS unsigned char* lds, int wid, int lane) const {
        typedef float f32x2v __attribute__((ext_vector_type(2)));
        PG8_LAS f32x2v* P = (PG8_LAS f32x2v*)lds;
        PG8_LAS f32x2v* S = (PG8_LAS f32x2v*)(lds + 8192);
        PG8_LAS unsigned* flag = (PG8_LAS unsigned*)(lds + 8192 + 2048);
#pragma unroll
        for (int ai = 0; ai < 2; ++ai)
#pragma unroll
            for (int m = 0; m < 4; ++m) {
                float s = 0.f;
#pragma unroll
                for (int bj = 0; bj < 2; ++bj)
#pragma unroll
                    for (int n = 0; n < 2; ++n) { const f32x4 x = v[ai][bj][m][n]; s += (x[0] + x[1]) + (x[2] + x[3]); }
                s += __shfl_xor(s, 16); s += __shfl_xor(s, 32);
                const float mw = s * (1.0f / 64.0f); float q = 0.f;
#pragma unroll
                for (int bj = 0; bj < 2; ++bj)
#pragma unroll
                    for (int n = 0; n < 2; ++n) { const f32x4 d = v[ai][bj][m][n] - mw; q += (d[0] * d[0] + d[1] * d[1]) + (d[2] * d[2] + d[3] * d[3]); }
                q += __shfl_xor(q, 16); q += __shfl_xor(q, 32);
                if (fq == 0) P[(ai * HALF + wr * 64 + m * 16 + fr) * 4 + wc] = (f32x2v){mw, q};
            }
        asm volatile("s_waitcnt lgkmcnt(0)" ::: "memory"); __builtin_amdgcn_s_barrier(); asm volatile("" ::: "memory");
#if defined(BROKEN_EXCHANGE_NO_WAIT)
#warning BROKEN CONTROL BUILD: the row-statistics exchange does not wait; results are wrong by design
        if (blockIdx.x >= 64) { const long long t0_ = clock64(); while (clock64() - t0_ < 60000) __builtin_amdgcn_s_sleep(8); }
#endif
        const int row = wid * 32 + (lane & 31);
        if (lane < 32) {
            const f32x2v a = P[row * 4 + 0], b = P[row * 4 + 1], c = P[row * 4 + 2], d = P[row * 4 + 3];
            const float mt = (a.x + b.x + c.x + d.x) * 0.25f;
            const float da = a.x - mt, db = b.x - mt, dc = c.x - mt, dd = d.x - mt;
            const float m2 = (a.y + b.y) + (c.y + d.y) + 64.0f * ((da * da + db * db) + (dc * dc + dd * dd));
            unsigned long long* slot = (unsigned long long*)xbuf + ((size_t)(u.pm * BM + row) * 4 + u.pn);
            __hip_atomic_store(slot, ((unsigned long long)__float_as_uint(m2) << 32) | __float_as_uint(mt), __ATOMIC_RELAXED, __HIP_MEMORY_SCOPE_AGENT);
        }
        asm volatile("s_waitcnt vmcnt(0)" ::: "memory");
        if (lane == 0) __hip_atomic_fetch_add(cnt + 64 * u.pm, 1u, __ATOMIC_RELAXED, __HIP_MEMORY_SCOPE_AGENT);
        if (wid == 0) {
            bool dead = false; const unsigned long long t0 = __builtin_amdgcn_s_memrealtime(); const unsigned want = 8u * (unsigned)ntn;
            for (;;) {
#if defined(BROKEN_EXCHANGE_NO_WAIT)
                break;
#endif
                if ((unsigned)__builtin_amdgcn_readfirstlane(__hip_atomic_load(cnt + 64 * u.pm, __ATOMIC_RELAXED, __HIP_MEMORY_SCOPE_AGENT)) >= want) break;
                if (__builtin_amdgcn_s_memrealtime() - t0 > 2000000ull) {
                    if (lane == 0) { unsigned expect = 0u; __hip_atomic_compare_exchange_strong(tmo + 1, &expect, code | (unsigned)(u.pm & 0xff), __ATOMIC_RELAXED, __ATOMIC_RELAXED, __HIP_MEMORY_SCOPE_AGENT);
                                     __hip_atomic_store(tmo, 1u, __ATOMIC_RELAXED, __HIP_MEMORY_SCOPE_AGENT); }
                    dead = true; break; }
                __builtin_amdgcn_s_sleep(2);
            }
            __builtin_amdgcn_fence(__ATOMIC_ACQUIRE, "agent");
            if (lane == 0) flag[0] = dead ? 1u : 0u;
        }
        asm volatile("s_waitcnt vmcnt(0) lgkmcnt(0)" ::: "memory"); __builtin_amdgcn_s_barrier(); asm volatile("" ::: "memory");
        const bool bad = flag[0] != 0u;
        if (lane < 32) {
            const unsigned long long* slot = (const unsigned long long*)xbuf + (size_t)(u.pm * BM + row) * 4; float mt[4], m2[4]; float ms = 0.f;
#pragma unroll
            for (int t = 0; t < 4; ++t) { if (t < ntn) { const unsigned long long w = __hip_atomic_load(slot + t, __ATOMIC_RELAXED, __HIP_MEMORY_SCOPE_AGENT); mt[t] = __uint_as_float((unsigned)w); m2[t] = __uint_as_float((unsigned)(w >> 32)); } else { mt[t] = 0.f; m2[t] = 0.f; } ms += mt[t]; }
            const float mean = ms / (float)ntn; float q = 0.f;
#pragma unroll
            for (int t = 0; t < 4; ++t) if (t < ntn) { const float dm = mt[t] - mean; q += m2[t] + 256.0f * dm * dm; }
            S[row] = (f32x2v){mean, 1.0f / sqrtf(q / (256.0f * (float)ntn) + eps)};
        }
        asm volatile("s_waitcnt lgkmcnt(0)" ::: "memory"); __builtin_amdgcn_s_barrier(); asm volatile("" ::: "memory");
        return bad;
    }
};
struct EpiLnRes {
    static constexpr bool PERM = false, AFTER_DRAIN = true;
    const float* base; float* out; int ldc; const float* bias; PanelStats st; unsigned poison;
    __device__ __forceinline__ void fused(f32x4 (&acc)[2][2][4][2], const Unit& u, int wr, int wc, int fr, int fq, PG8_LAS unsigned char* lds, int wid, int lane) const {
        typedef float f32x2v __attribute__((ext_vector_type(2)));
        const PG8_LAS f32x2v* S = (const PG8_LAS f32x2v*)(lds + 8192);
        const int col0 = u.pn * BM + wc * 32 + 4 * fq;
#pragma unroll
        for (int bj = 0; bj < 2; ++bj)
#pragma unroll
            for (int n = 0; n < 2; ++n) { const f32x4 bv = bias ? *(const f32x4*)(bias + col0 + bj * HALF + n * 16) : (f32x4){0.f, 0.f, 0.f, 0.f};
#pragma unroll
                for (int ai = 0; ai < 2; ++ai)
#pragma unroll
                    for (int m = 0; m < 4; ++m) acc[ai][bj][m][n] += bv; }
        f32x4 pre[4][2][2];
#pragma unroll
        for (int m = 0; m < 4; ++m) { const size_t off = (size_t)(u.pm * BM + wr * 64 + m * 16 + fr) * ldc + col0;
#pragma unroll
            for (int bj = 0; bj < 2; ++bj)
#pragma unroll
                for (int n = 0; n < 2; ++n) pre[m][bj][n] = *(const f32x4*)(base + off + bj * HALF + n * 16); }
        const bool bad = st.run(acc, u, wr, wc, fr, fq, lds, wid, lane) || poison != 0u;
        const float qnan = __builtin_nanf("");
#pragma unroll
        for (int ai = 0; ai < 2; ++ai)
#pragma unroll
            for (int m = 0; m < 4; ++m) { const int r = ai * HALF + wr * 64 + m * 16 + fr; const f32x2v sr = S[r]; const size_t off = (size_t)(u.pm * BM + r) * ldc + col0;
#pragma unroll
                for (int bj = 0; bj < 2; ++bj)
#pragma unroll
                    for (int n = 0; n < 2; ++n) { const f32x4 bs = ai == 0 ? pre[m][bj][n] : *(const f32x4*)(base + off + bj * HALF + n * 16); f32x4 o = bs + (acc[ai][bj][m][n] - sr.x) * sr.y;
                        if (bad) o = (f32x4){qnan, qnan, qnan, qnan}; *(f32x4*)(out + off + bj * HALF + n * 16) = o; }
                if (m & 1) asm volatile("" ::: "memory"); }
    }
};
struct EpiLnResLn {
    static constexpr bool PERM = false, AFTER_DRAIN = true;
    const float* base; float* out; bf16_t* xn; int ldc; const float* bias; PanelStats st1, st2; unsigned poison;
    __device__ __forceinline__ void fused(f32x4 (&acc)[2][2][4][2], const Unit& u, int wr, int wc, int fr, int fq, PG8_LAS unsigned char* lds, int wid, int lane) const {
        typedef float f32x2v __attribute__((ext_vector_type(2))); typedef unsigned u32x2v __attribute__((ext_vector_type(2)));
        const PG8_LAS f32x2v* S = (const PG8_LAS f32x2v*)(lds + 8192);
        const int col0 = u.pn * BM + wc * 32 + 4 * fq;
#pragma unroll
        for (int bj = 0; bj < 2; ++bj)
#pragma unroll
            for (int n = 0; n < 2; ++n) { const f32x4 bv = bias ? *(const f32x4*)(bias + col0 + bj * HALF + n * 16) : (f32x4){0.f, 0.f, 0.f, 0.f};
#pragma unroll
                for (int ai = 0; ai < 2; ++ai)
#pragma unroll
                    for (int m = 0; m < 4; ++m) acc[ai][bj][m][n] += bv; }
        bool bad = st1.run(acc, u, wr, wc, fr, fq, lds, wid, lane) || poison != 0u;
        const float qnan = __builtin_nanf("");
#pragma unroll
        for (int ai = 0; ai < 2; ++ai)
#pragma unroll
            for (int m = 0; m < 4; ++m) { const int r = ai * HALF + wr * 64 + m * 16 + fr; const f32x2v sr = S[r]; const size_t off = (size_t)(u.pm * BM + r) * ldc + col0;
#pragma unroll
                for (int bj = 0; bj < 2; ++bj)
#pragma unroll
                    for (int n = 0; n < 2; ++n) { const f32x4 bs = *(const f32x4*)(base + off + bj * HALF + n * 16); acc[ai][bj][m][n] = bs + (acc[ai][bj][m][n] - sr.x) * sr.y; }
                asm volatile("" : "+v"(acc[ai][0][m][0]), "+v"(acc[ai][0][m][1]), "+v"(acc[ai][1][m][0]), "+v"(acc[ai][1][m][1]));
                if (m & 1) asm volatile("" ::: "memory"); }
        const bool bad1 = bad;
        bad = st2.run(acc, u, wr, wc, fr, fq, lds, wid, lane) || bad;
#pragma unroll
        for (int ai = 0; ai < 2; ++ai)
#pragma unroll
            for (int m = 0; m < 4; ++m) { const int r = ai * HALF + wr * 64 + m * 16 + fr; const f32x2v sr = S[r]; const size_t off = (size_t)(u.pm * BM + r) * ldc + col0;
#pragma unroll
                for (int bj = 0; bj < 2; ++bj)
#pragma unroll
                    for (int n = 0; n < 2; ++n) { const f32x4 x1 = acc[ai][bj][m][n]; *(f32x4*)(out + off + bj * HALF + n * 16) = bad1 ? (f32x4){qnan, qnan, qnan, qnan} : x1;
                        const f32x4 o = (x1 - sr.x) * sr.y; u32x2v w; w.x = cvt_pk_bf16(o[0], o[1]); w.y = cvt_pk_bf16(o[2], o[3]);
                        if (bad) { w.x = 0x7fc07fc0u; w.y = 0x7fc07fc0u; } *(u32x2v*)(xn + off + bj * HALF + n * 16) = w; }
                asm volatile("" ::: "memory"); }
    }
};

template <class Epi, class Sched, bool ALIGN_EPI = false, bool SP2 = false>
__device__ __forceinline__ void gemm_phase(PG8_LAS unsigned char* lds, const Gemm g, const Sched& S, const Epi& E) {
    const int tid = threadIdx.x, wid = __builtin_amdgcn_readfirstlane(tid >> 6), lane = tid & 63, wr = wid >> 2, wc = wid & 3, fr = lane & 15, fq = lane >> 4;
    const int K = g.K, nt = K / BK;
    unsigned voffA[2], voffB[2];
#pragma unroll
    for (int i = 0; i < 2; ++i) { int R, C; stage_rc(tid * 16 + i * 8192, R, C); const int Rb = Epi::PERM ? ((R & ~31) + perm32(R & 31)) : R;
        voffA[i] = (unsigned)(R * K + C) * 2u; voffB[i] = (unsigned)(Rb * K + C) * 2u; }
    const size_t kstep = (size_t)(BK * 2);
    const size_t hstep = (size_t)HALF * K * 2;
    const size_t tstep = 2 * hstep;
    const unsigned ldsw = (unsigned)wid * 1024u;
    const int aoff = lds_byte(wr * 64 + fr, fq * 8), boff = lds_byte(wc * 32 + fr, fq * 8);
#define PG8_SA(b, h) (((b) * 2 + (h)) * HTB)
#define PG8_SB(b, h) ((4 + (b) * 2 + (h)) * HTB)
#define PG8_STAGE(bufoff, gbase, voff) do { _Pragma("unroll") for (int _i = 0; _i < 2; ++_i) \
        __builtin_amdgcn_global_load_lds((const unsigned*)((const char*)(gbase) + (voff)[_i]), (PG8_LAS unsigned*)(lds + (bufoff) + ldsw + _i * 8192), 16, 0, 0); } while (0)
#define PG8_LDA(dst, b, h) do { _Pragma("unroll") for (int m = 0; m < 4; ++m) _Pragma("unroll") for (int k = 0; k < 2; ++k) dst[m][k] = *(const PG8_LAS bf16x8*)(lds + PG8_SA(b, h) + aoff + m * 2048 + k * 1024); } while (0)
#define PG8_LDB(dst, b, h) do { _Pragma("unroll") for (int n = 0; n < 2; ++n) _Pragma("unroll") for (int k = 0; k < 2; ++k) dst[n][k] = *(const PG8_LAS bf16x8*)(lds + PG8_SB(b, h) + boff + n * 2048 + k * 1024); } while (0)
#define PG8_MMA(ai, bj, At, Bt) do { __builtin_amdgcn_s_setprio(1); _Pragma("unroll") for (int m = 0; m < 4; ++m) _Pragma("unroll") for (int n = 0; n < 2; ++n) _Pragma("unroll") for (int k = 0; k < 2; ++k) \
        acc[ai][bj][m][n] = __builtin_amdgcn_mfma_f32_16x16x32_bf16(Bt[n][k], At[m][k], acc[ai][bj][m][n], 0, 0, 0); __builtin_amdgcn_s_setprio(0); } while (0)
#define PG8_WAIT_V(n) asm volatile("s_waitcnt vmcnt(" #n ")" ::: "memory")
#define PG8_WAIT_L(n) asm volatile("s_waitcnt lgkmcnt(" #n ")" ::: "memory")
#define PG8_BAR __builtin_amdgcn_s_barrier()
#define PG8_SCHED __builtin_amdgcn_sched_barrier(0)
    Unit cur, nxt; int ui = 0;
    if (!S.next(0, cur)) return;
    f32x4 acc[2][2][4][2];
#pragma unroll
    for (int a = 0; a < 2; ++a)
#pragma unroll
        for (int b = 0; b < 2; ++b)
#pragma unroll
            for (int m = 0; m < 4; ++m)
#pragma unroll
                for (int n = 0; n < 2; ++n) acc[a][b][m][n] = (f32x4){0.f, 0.f, 0.f, 0.f};
    bf16x8 At[4][2], B0[2][2], B1[2][2];
    const char* cA = (const char*)g.A + (size_t)cur.pm * tstep; const char* cB = (const char*)g.Bt + (size_t)cur.pn * tstep;
    S.a_ready(cur);
    if constexpr (SP2) {
        PG8_STAGE(PG8_SB(0, 0), cB, voffB); PG8_STAGE(PG8_SB(0, 1), cB + hstep, voffB); PG8_STAGE(PG8_SA(0, 0), cA, voffA); PG8_STAGE(PG8_SA(0, 1), cA + hstep, voffA);
        if (wr == 1) PG8_BAR;
        PG8_WAIT_V(2); PG8_BAR;
        PG8_STAGE(PG8_SB(1, 0), cB + kstep, voffB); PG8_STAGE(PG8_SA(1, 0), cA + kstep, voffA); PG8_STAGE(PG8_SB(1, 1), cB + hstep + kstep, voffB);
        PG8_WAIT_V(6); PG8_BAR;
    } else {
        PG8_STAGE(PG8_SB(0, 0), cB, voffB); PG8_STAGE(PG8_SA(0, 0), cA, voffA); PG8_STAGE(PG8_SB(0, 1), cB + hstep, voffB); PG8_STAGE(PG8_SA(0, 1), cA + hstep, voffA);
        if (wr == 1) PG8_BAR;
        PG8_WAIT_V(4); PG8_BAR;
        PG8_STAGE(PG8_SB(1, 0), cB + kstep, voffB); PG8_STAGE(PG8_SA(1, 0), cA + kstep, voffA); PG8_STAGE(PG8_SB(1, 1), cB + hstep + kstep, voffB);
        PG8_WAIT_V(6); PG8_BAR;
    }
    for (;;) {
        const bool has_next = S.next(ui + 1, nxt);
        const char* nA = has_next ? (const char*)g.A + (size_t)nxt.pm * tstep : cA; const char* nB = has_next ? (const char*)g.Bt + (size_t)nxt.pn * tstep : cB;
        for (int t = 0; t < nt; t += 2) {
            const bool last = (t == nt - 2);
            const char* a1 = cA + (size_t)(t + 1) * kstep;
            const char* a2 = last ? nA : cA + (size_t)(t + 2) * kstep; const char* b2 = last ? nB : cB + (size_t)(t + 2) * kstep;
            const char* a3 = a2 + kstep; const char* b3 = b2 + kstep;
            if (last && has_next) S.a_ready(nxt);
            if constexpr (SP2) {
            PG8_LDB(B0, 0, 0); PG8_LDB(B1, 0, 1); PG8_SCHED; PG8_LDA(At, 0, 0); PG8_STAGE(PG8_SA(1, 1), a1 + hstep, voffA);
            PG8_WAIT_V(8); PG8_WAIT_L(0); PG8_BAR; PG8_MMA(0, 0, At, B0); PG8_MMA(0, 1, At, B1); PG8_BAR; PG8_SCHED;
            PG8_LDA(At, 0, 1); PG8_STAGE(PG8_SB(0, 0), b2, voffB); PG8_STAGE(PG8_SB(0, 1), b2 + hstep, voffB); PG8_STAGE(PG8_SA(0, 0), a2, voffA);
            PG8_WAIT_V(8); PG8_WAIT_L(0); PG8_BAR; PG8_MMA(1, 0, At, B0); PG8_MMA(1, 1, At, B1); PG8_BAR; PG8_SCHED;
            PG8_LDB(B0, 1, 0); PG8_LDB(B1, 1, 1); PG8_SCHED; PG8_LDA(At, 1, 0); PG8_STAGE(PG8_SA(0, 1), a2 + hstep, voffA);
            PG8_WAIT_V(8); PG8_WAIT_L(0); PG8_BAR; PG8_MMA(0, 0, At, B0); PG8_MMA(0, 1, At, B1); PG8_BAR; PG8_SCHED;
            PG8_LDA(At, 1, 1); PG8_STAGE(PG8_SB(1, 0), b3, voffB); PG8_STAGE(PG8_SB(1, 1), b3 + hstep, voffB); PG8_STAGE(PG8_SA(1, 0), a3, voffA);
            PG8_WAIT_V(8); PG8_WAIT_L(0); PG8_BAR; PG8_MMA(1, 0, At, B0); PG8_MMA(1, 1, At, B1); PG8_BAR; PG8_SCHED;
            } else {
            PG8_LDB(B0, 0, 0); PG8_SCHED; PG8_LDA(At, 0, 0); PG8_STAGE(PG8_SA(1, 1), a1 + hstep, voffA);
            PG8_WAIT_L(8); PG8_BAR; PG8_WAIT_L(0); PG8_MMA(0, 0, At, B0); PG8_BAR; PG8_SCHED;
            PG8_LDB(B1, 0, 1); PG8_STAGE(PG8_SB(0, 0), b2, voffB);
            PG8_BAR; PG8_WAIT_L(0); PG8_MMA(0, 1, At, B1); PG8_BAR;
            PG8_LDA(At, 0, 1); PG8_STAGE(PG8_SA(0, 0), a2, voffA);
            PG8_BAR; PG8_WAIT_L(0); PG8_MMA(1, 0, At, B0); PG8_BAR; PG8_SCHED;
            PG8_STAGE(PG8_SB(0, 1), b2 + hstep, voffB);
            PG8_WAIT_V(6); PG8_BAR; PG8_MMA(1, 1, At, B1); PG8_BAR;
            PG8_LDB(B0, 1, 0); PG8_SCHED; PG8_LDA(At, 1, 0); PG8_STAGE(PG8_SA(0, 1), a2 + hstep, voffA);
            PG8_WAIT_L(8); PG8_BAR; PG8_WAIT_L(0); PG8_MMA(0, 0, At, B0); PG8_BAR; PG8_SCHED;
            PG8_LDB(B1, 1, 1); PG8_STAGE(PG8_SB(1, 0), b3, voffB);
            PG8_BAR; PG8_WAIT_L(0); PG8_MMA(0, 1, At, B1); PG8_BAR;
            PG8_LDA(At, 1, 1); PG8_STAGE(PG8_SA(1, 0), a3, voffA);
            PG8_BAR; PG8_WAIT_L(0); PG8_MMA(1, 0, At, B0); PG8_BAR; PG8_SCHED;
            PG8_STAGE(PG8_SB(1, 1), b3 + hstep, voffB);
            PG8_WAIT_V(6); PG8_BAR; PG8_MMA(1, 1, At, B1); PG8_BAR;
            }
        }
        if constexpr (ALIGN_EPI) { if (wr == 0) PG8_BAR; }
        if constexpr (!Epi::AFTER_DRAIN) { E(acc, cur, wr, wc, fr, fq); S.done(cur); }
        if (!has_next) break;
#pragma unroll
        for (int a = 0; a < 2; ++a)
#pragma unroll
            for (int b = 0; b < 2; ++b)
#pragma unroll
                for (int m = 0; m < 4; ++m)
#pragma unroll
                    for (int n = 0; n < 2; ++n) acc[a][b][m][n] = (f32x4){0.f, 0.f, 0.f, 0.f};
        cur = nxt; cA = nA; cB = nB; ++ui;
        if constexpr (ALIGN_EPI) { if (wr == 1) PG8_BAR; }
    }
    PG8_WAIT_V(0);
    if constexpr (!ALIGN_EPI) { if (wr == 0) PG8_BAR; }
    PG8_BAR;
    if constexpr (Epi::AFTER_DRAIN) { E.fused(acc, cur, wr, wc, fr, fq, lds, wid, lane); S.done(cur); }
#undef PG8_SA
#undef PG8_SB
#undef PG8_STAGE
#undef PG8_LDA
#undef PG8_LDB
#undef PG8_MMA
#undef PG8_WAIT_V
#undef PG8_WAIT_L
#undef PG8_BAR
#undef PG8_SCHED
}
}

namespace pg8 {
struct EpiStore {
    static constexpr bool PERM = true, AFTER_DRAIN = false;
    bf16_t* O; int ldc; int n_lo; float sc_lo; int pn_one; float sc_one;
    __device__ __forceinline__ void operator()(const f32x4 (&acc)[2][2][4][2], const Unit& u, int wr, int wc, int fr, int fq) const {
        const int row0 = u.pm * BM + wr * 64 + fr; const int col0 = u.pn * BM + wc * 32 + 8 * fq;
        const float sc = (u.pn < n_lo) ? sc_lo : ((u.pn == pn_one) ? sc_one : 1.0f);
#pragma unroll
        for (int ai = 0; ai < 2; ++ai)
#pragma unroll
            for (int m = 0; m < 4; ++m) { bf16_t* rowp = O + (size_t)(row0 + ai * HALF + m * 16) * ldc + col0;
#pragma unroll
                for (int bj = 0; bj < 2; ++bj) { f32x4 v0 = acc[ai][bj][m][0] * sc, v1 = acc[ai][bj][m][1] * sc;
                    u32x4 w; w.x = cvt_pk_bf16(v0[0], v0[1]); w.y = cvt_pk_bf16(v0[2], v0[3]); w.z = cvt_pk_bf16(v1[0], v1[1]); w.w = cvt_pk_bf16(v1[2], v1[3]);
                    *(u32x4*)(rowp + bj * HALF) = w; } }
    }
};

__device__ __forceinline__ float dpp_ror1(float v) { return __builtin_bit_cast(float, __builtin_amdgcn_update_dpp(0, __builtin_bit_cast(int, v), 0x121, 0xf, 0xf, false)); }
__device__ __forceinline__ float dpp_ror2(float v) { return __builtin_bit_cast(float, __builtin_amdgcn_update_dpp(0, __builtin_bit_cast(int, v), 0x122, 0xf, 0xf, false)); }
__device__ __forceinline__ float gelu_tanh_f(float x) {
    const float A = -2.302208198f, Bc = -0.1029432397f;
    const float t = x * (A + Bc * x * x);
    return x * __builtin_amdgcn_rcpf(1.0f + __builtin_amdgcn_exp2f(t));
}
struct EpiConvAct {
    static constexpr bool PERM = true, AFTER_DRAIN = false;
    bf16_t* act; float* ub; const float* cw; const float* cb;
    __device__ __forceinline__ void operator()(const f32x4 (&acc)[2][2][4][2], const Unit& u, int wr, int wc, int fr, int fq) const {
        constexpr int FFc = 2816, FF2c = 5632;
#pragma unroll
        for (int n = 0; n < 2; ++n) {
            const int j = u.pn * 128 + wc * 32 + 8 * fq + 4 * n;
            const f32x4 w0g = *(const f32x4*)(cw + j), w1g = *(const f32x4*)(cw + FF2c + j), w2g = *(const f32x4*)(cw + 2 * FF2c + j), bg = *(const f32x4*)(cb + j);
            const f32x4 w0u = *(const f32x4*)(cw + FFc + j), w1u = *(const f32x4*)(cw + FF2c + FFc + j), w2u = *(const f32x4*)(cw + 2 * FF2c + FFc + j), bu = *(const f32x4*)(cb + FFc + j);
#pragma unroll
            for (int ai = 0; ai < 2; ++ai) {
                const int g = u.pm * 4 + ai * 2 + wr;
                f32x4 qg1 = {0.f, 0.f, 0.f, 0.f}, qg2 = qg1, qu1 = qg1, qu2 = qg1;
#pragma unroll
                for (int m = 0; m < 4; ++m) {
                    const f32x4 ug = acc[ai][0][m][n], uu = acc[ai][1][m][n];
                    f32x4 ag1, ag2, au1, au2;
#pragma unroll
                    for (int k = 0; k < 4; ++k) { ag1[k] = dpp_ror1(ug[k]); ag2[k] = dpp_ror2(ug[k]); au1[k] = dpp_ror1(uu[k]); au2[k] = dpp_ror2(uu[k]); }
                    f32x4 pg1, pg2, pu1, pu2;
#pragma unroll
                    for (int k = 0; k < 4; ++k) { pg1[k] = (fr >= 1) ? ag1[k] : qg1[k]; pg2[k] = (fr >= 2) ? ag2[k] : qg2[k]; pu1[k] = (fr >= 1) ? au1[k] : qu1[k]; pu2[k] = (fr >= 2) ? au2[k] : qu2[k]; }
                    qg1 = ag1; qg2 = ag2; qu1 = au1; qu2 = au2;
                    const f32x4 yg = bg + w2g * ug + w1g * pg1 + w0g * pg2;
                    const f32x4 yu = bu + w2u * uu + w1u * pu1 + w0u * pu2;
                    float a0 = gelu_tanh_f(yg[0]) * yu[0], a1 = gelu_tanh_f(yg[1]) * yu[1], a2 = gelu_tanh_f(yg[2]) * yu[2], a3 = gelu_tanh_f(yg[3]) * yu[3];
                    const int row = u.pm * BM + ai * HALF + wr * 64 + m * 16 + fr;
                    typedef unsigned u32x2 __attribute__((ext_vector_type(2)));
                    u32x2 w; w.x = cvt_pk_bf16(a0, a1); w.y = cvt_pk_bf16(a2, a3);
                    if (!(m == 0 && fr < 2)) *(u32x2*)(act + (size_t)row * FFc + j) = w;
                    if (m == 0 && fr < 2) { float* p = ub + ((size_t)(g * 4 + 2 + fr) * 2) * FFc + j; *(f32x4*)p = ug; *(f32x4*)(p + FFc) = uu; }
                    if (m == 3 && fr >= 14) { float* p = ub + ((size_t)(g * 4 + (fr - 14)) * 2) * FFc + j; *(f32x4*)p = ug; *(f32x4*)(p + FFc) = uu; }
                }
            }
        }
    }
};
}
#define GAS __attribute__((address_space(1)))
#define LAS __attribute__((address_space(3)))
typedef unsigned short bf16;
typedef unsigned v4u __attribute__((ext_vector_type(4)));
typedef float f32x4 __attribute__((ext_vector_type(4)));
typedef short bf16x8 __attribute__((ext_vector_type(8)));
typedef GAS unsigned gu32;
typedef GAS unsigned long long gu64;
#define RLX_AGENT __ATOMIC_RELAXED, __HIP_MEMORY_SCOPE_AGENT
#define LDS_WAIT() asm volatile("s_waitcnt lgkmcnt(0)" ::: "memory")
#define VM_WAIT() asm volatile("s_waitcnt vmcnt(0)" ::: "memory")
__device__ __forceinline__ unsigned long long rt() { return __builtin_amdgcn_s_memrealtime(); }
__device__ __forceinline__ unsigned f2bf(float f) { unsigned u = __builtin_bit_cast(unsigned, f); return (u + 0x7fffu + ((u >> 16) & 1u)) >> 16; }
__device__ __forceinline__ unsigned pk2(float lo, float hi) { return f2bf(lo) | (f2bf(hi) << 16); }

#define XB_TMO      128
#define XB_XCNT(j)  (256  + 64 * (j))
#define XB_XSUB(j)  (1280 + 64 * (j))
#define XB_XGEN(j)  (2304 + 64 * (j))
#define XB_TOP      3328
#define XB_TOPGEN   3392
#define XCD_BAR_WORDS 3456
#define XB_SPIN_CAP (1u << 18)

__device__ __forceinline__ unsigned xb_ld(unsigned* p)              { return __hip_atomic_load(p, __ATOMIC_RELAXED, __HIP_MEMORY_SCOPE_AGENT); }
__device__ __forceinline__ unsigned xb_add(unsigned* p, unsigned v) { return __hip_atomic_fetch_add(p, v, __ATOMIC_RELAXED, __HIP_MEMORY_SCOPE_AGENT); }
__device__ __forceinline__ unsigned xb_xcc_id() { return (unsigned)__builtin_amdgcn_s_getreg((3 << 11) | 20) & 0xFu; }
#define XB_SPIN(cond, bar) do { unsigned _sp = 0; while (cond) { __builtin_amdgcn_s_sleep(1); \
    if ((++_sp & 255u) == 0u) { if (xb_ld(&(bar)[XB_TMO])) break; if (_sp > XB_SPIN_CAP) { atomicAdd(&(bar)[XB_TMO], 1u); break; } } } } while (0)

struct XcdBarrier {
    unsigned* bar; unsigned x;
    volatile LAS unsigned* st;
};

__device__ __forceinline__ XcdBarrier xcd_barrier_post(unsigned* bar, volatile LAS unsigned* st) {
    XcdBarrier b; b.bar = bar; b.x = xb_xcc_id(); b.st = st;
    if (threadIdx.x == 0) (void)xb_add(&bar[XB_XCNT(b.x)], 1u);
    return b;
}
__device__ __forceinline__ void xcd_barrier_complete(unsigned* bar, unsigned x, unsigned& nloc, unsigned& nx) {
    const unsigned G = gridDim.x * gridDim.y * gridDim.z;
    unsigned sum, cnt, mine, sp = 0u;
    for (;;) {
        sum = 0u; cnt = 0u; mine = 0u;
#pragma unroll
        for (unsigned j = 0; j < 16; ++j) { const unsigned c = xb_ld(&bar[XB_XCNT(j)]); sum += c; cnt += (c > 0u) ? 1u : 0u; mine = (j == x) ? c : mine; }
        if (sum == G) break;
        __builtin_amdgcn_s_sleep(1);
        if ((++sp & 255u) == 0u) { if (xb_ld(&bar[XB_TMO])) break; if (sp > XB_SPIN_CAP) { atomicAdd(&bar[XB_TMO], 1u); break; } }
    }
    nloc = mine > 0u ? mine : 1u; nx = cnt > 0u ? cnt : 1u;
}

__device__ __forceinline__ void xcd_barrier(const XcdBarrier& b) {
    asm volatile("s_waitcnt vmcnt(0)" ::: "memory");
    __syncthreads();
    if (threadIdx.x == 0) {
        unsigned* bar = b.bar;
        __builtin_amdgcn_s_waitcnt(0);
        unsigned nloc = b.st[0], nx = b.st[1];
        if (nloc == 0u) { xcd_barrier_complete(bar, b.x, nloc, nx); b.st[0] = nloc; b.st[1] = nx; }
        const unsigned old = xb_add(&bar[XB_XSUB(b.x)], 1u);
        const unsigned gen = old / nloc;
        if (old + 1u == (gen + 1u) * nloc) {
            __builtin_amdgcn_fence(__ATOMIC_RELEASE, "agent");
            asm volatile("s_waitcnt vmcnt(0)" ::: "memory");
            const unsigned og = xb_add(&bar[XB_TOP], 1u);
            const unsigned tg = og / nx;
            if (og + 1u == (tg + 1u) * nx) xb_add(&bar[XB_TOPGEN], 1u);
            else XB_SPIN(xb_ld(&bar[XB_TOPGEN]) == tg, bar);
            __builtin_amdgcn_fence(__ATOMIC_ACQUIRE, "agent");
            xb_add(&bar[XB_XGEN(b.x)], 1u);
            asm volatile("s_waitcnt vmcnt(0)" ::: "memory");
        } else {
            XB_SPIN(xb_ld(&bar[XB_XGEN(b.x)]) == gen, bar);
            __builtin_amdgcn_fence(__ATOMIC_ACQUIRE, "agent");
            asm volatile("s_waitcnt vmcnt(0)" ::: "memory");
        }
    }
    __syncthreads();
}

constexpr int NWAVES = 8, NTHR = 512;
#ifndef MK_N_LAUNCHES
#define MK_N_LAUNCHES 1
#endif
constexpr int N_PHASES = 11;
constexpr int BATCH = 4, SEQ = 8192, DM = 1024, M = BATCH * SEQ, INW = 3072, FF = 2816, FF2 = 5632;
constexpr float NORM_EPS = 1e-6f;
constexpr float QSCALE = 0.125f * 1.4426950408889634f;
constexpr size_t MiB = 1u << 20;
constexpr size_t WS_CTL = 0, CTL_ZERO_BYTES = 1 * MiB;
constexpr size_t WS_ROPE = 1 * MiB;
constexpr size_t WS_WIN = 4 * MiB, WS_WOUT = 10 * MiB, WS_WUP = 12 * MiB, WS_WDN = 23 * MiB;
constexpr size_t WS_XN = 32 * MiB;
constexpr size_t WS_PROJ = 96 * MiB;
constexpr size_t WS_ACT = 96 * MiB;
constexpr size_t WS_OPART = 288 * MiB;
constexpr size_t WS_LSE = 384 * MiB;
constexpr size_t WS_MIX = 288 * MiB;
constexpr size_t WS_FFN = 352 * MiB;
constexpr size_t WS_MIXED = 416 * MiB;
constexpr size_t WS_UB = 416 * MiB;
constexpr size_t WS_KV = 480 * MiB;
constexpr size_t WS_END = 512 * MiB;
constexpr int CW_TMO = 0, CW_BAR = 4096;
constexpr int RING_OFF = 0, RING_BYTES = 133120;
constexpr int LDSCTL_OFF = RING_BYTES, MISC_OFF = LDSCTL_OFF + 320;
constexpr int LDS_BYTES = 147456;
static_assert(MISC_OFF + 128 <= LDS_BYTES, "LDS map");

__device__ const float ROPE_F[32] = {1.000000000e+00f, 7.498942018e-01f, 5.623413324e-01f, 4.216965139e-01f, 3.162277639e-01f, 2.371373773e-01f, 1.778279394e-01f, 1.333521456e-01f, 1.000000015e-01f, 7.498942316e-02f, 5.623413250e-02f, 4.216964915e-02f, 3.162277490e-02f, 2.371373773e-02f, 1.778279431e-02f, 1.333521400e-02f, 9.999999776e-03f, 7.498942316e-03f, 5.623413250e-03f, 4.216964822e-03f, 3.162277630e-03f, 2.371373819e-03f, 1.778279431e-03f, 1.333521446e-03f, 1.000000047e-03f, 7.498941850e-04f, 5.623413017e-04f, 4.216965172e-04f, 3.162277571e-04f, 2.371373703e-04f, 1.778279402e-04f, 1.333521504e-04f};

typedef float f32x16 __attribute__((ext_vector_type(16)));
typedef short s16x4 __attribute__((ext_vector_type(4)));
typedef unsigned u32x2 __attribute__((ext_vector_type(2)));
typedef float f32x2v __attribute__((ext_vector_type(2)));
typedef __bf16 bf16x2_t __attribute__((ext_vector_type(2)));
__device__ __forceinline__ unsigned cvtpk(float lo, float hi) { f32x2v v = {lo, hi}; bf16x2_t b = __builtin_convertvector(v, bf16x2_t); return __builtin_bit_cast(unsigned, b); }
__device__ __forceinline__ float bf_lo(unsigned w) { return __builtin_bit_cast(float, w << 16); }
__device__ __forceinline__ float bf_hi(unsigned w) { return __builtin_bit_cast(float, w & 0xffff0000u); }
__device__ __forceinline__ int crow(int r, int hi) { return (r & 3) + 8 * (r >> 2) + 4 * hi; }
__device__ __forceinline__ s16x4 tr16(const LAS unsigned char* p) { typedef short v4i16_t __attribute__((ext_vector_type(4))); return __builtin_bit_cast(s16x4, __builtin_amdgcn_ds_read_tr16_b64_v4i16((LAS v4i16_t*)p)); }
__device__ __forceinline__ bf16x8 mk8(s16x4 a, s16x4 b) { return (bf16x8){a[0], a[1], a[2], a[3], b[0], b[1], b[2], b[3]}; }
__device__ __forceinline__ float wave_sum(float v) {
#pragma unroll
    for (int o = 1; o < 64; o <<= 1) v += __shfl_xor(v, o);
    return v;
}
__device__ __forceinline__ float lg2gamma(int h) { return log2f(1.0f - exp2f(-5.0f - (float)h)); }

struct Frame {
    LAS unsigned char* lds;
    volatile LAS unsigned* MISC;
    gu32* ctl;
    int tid, lane, wave, vcu, G;
    const float *x, *g_pre, *g_post, *w_in, *w_out, *g_fpre, *g_fpost, *w_up, *conv_w, *conv_b, *w_down;
    float* out;
    bf16 *Win_t, *Wout_t, *Wup_t, *Wdn_t, *XN, *PROJ, *ACT, *OPART, *MIX, *FFN, *MIXED;
    float *LSE, *UB, *KV; f32x2v* ROPE;
};

__device__ __forceinline__ void p0_transpose_item(const float* W, int K, int N, bf16* WT, int row_off, LAS float* scr, int kb, int nb, int lane) {
    const int k0 = 64 * kb, n0 = 32 * nb;
#pragma unroll 8
    for (int i = 0; i < 32; ++i) { const int kk = 2 * i + (lane >> 5); scr[kk * 33 + (lane & 31)] = W[(size_t)(k0 + kk) * N + n0 + (lane & 31)]; }
    LDS_WAIT(); asm volatile("" ::: "memory");
    const int c = lane & 7;
#pragma unroll
    for (int j = 0; j < 4; ++j) { const int n = (lane >> 3) + 8 * j; const LAS float* s = scr + (8 * c) * 33 + n;
        v4u o; o.x = cvtpk(s[0 * 33], s[1 * 33]); o.y = cvtpk(s[2 * 33], s[3 * 33]); o.z = cvtpk(s[4 * 33], s[5 * 33]); o.w = cvtpk(s[6 * 33], s[7 * 33]);
        *(GAS v4u*)(WT + (size_t)(row_off + n0 + n) * K + k0 + 8 * c) = o; }
    LDS_WAIT(); asm volatile("" ::: "memory");
}
__device__ __forceinline__ void rms_row_to_bf16(const float* xrow, const float* gain, bf16* orow, int lane) {
    const GAS f32x4* xr = (const GAS f32x4*)xrow + lane; const GAS f32x4* gr = (const GAS f32x4*)gain + lane;
    f32x4 v[4]; float s = 0.f;
#pragma unroll
    for (int j = 0; j < 4; ++j) { v[j] = xr[64 * j]; s += (v[j].x * v[j].x + v[j].y * v[j].y) + (v[j].z * v[j].z + v[j].w * v[j].w); }
    const float rstd = 1.f / sqrtf(wave_sum(s) * (1.f / DM) + NORM_EPS);
    GAS unsigned long long* o8 = (GAS unsigned long long*)orow + lane;
#pragma unroll
    for (int j = 0; j < 4; ++j) { const f32x4 g = gr[64 * j];
        o8[64 * j] = (unsigned long long)cvtpk(v[j].x * rstd * g.x, v[j].y * rstd * g.y) | ((unsigned long long)cvtpk(v[j].z * rstd * g.z, v[j].w * rstd * g.w) << 32); }
}
__device__ __forceinline__ void p0_prep(Frame& F) {
    LAS float* scr = (LAS float*)(F.lds + RING_OFF + F.wave * 16384);
    const int gw = F.vcu * NWAVES + F.wave, NGW = F.G * NWAVES;
    constexpr int I_IN = (DM / 64) * (INW / 32), I_OUT = (DM / 64) * (DM / 32), I_UP = (DM / 64) * (FF2 / 32), I_DN = (FF / 64) * (DM / 32);
    constexpr int NITEMS = I_IN + I_OUT + I_UP + I_DN;
    for (int it = gw; it < NITEMS; it += NGW) {
        int r = it;
        if (r < I_IN) { const int nblk = INW / 32; p0_transpose_item(F.w_in, DM, INW, F.Win_t, 0, scr, r / nblk, r % nblk, F.lane); continue; } r -= I_IN;
        if (r < I_OUT) { const int nblk = DM / 32; p0_transpose_item(F.w_out, DM, DM, F.Wout_t, 0, scr, r / nblk, r % nblk, F.lane); continue; } r -= I_OUT;
        if (r < I_UP) { const int nblk = FF2 / 32; const int kb = r / nblk, nb = r % nblk; const int n0 = 32 * nb;
            const int dest = (n0 < FF) ? ((n0 / 128) * 256 + (n0 % 128)) : (((n0 - FF) / 128) * 256 + 128 + ((n0 - FF) % 128));
            p0_transpose_item(F.w_up, DM, FF2, F.Wup_t, dest - n0, scr, kb, nb, F.lane); continue; } r -= I_UP;
        { const int nblk = DM / 32; p0_transpose_item(F.w_down, FF, DM, F.Wdn_t, 0, scr, r / nblk, r % nblk, F.lane); }
    }
    for (int m = gw; m < M; m += NGW) rms_row_to_bf16(F.x + (size_t)m * DM, F.g_pre, F.XN + (size_t)m * DM, F.lane);
    for (int idx = F.vcu * NTHR + F.tid; idx < SEQ * 32; idx += F.G * NTHR) { const int t = idx >> 5, i = idx & 31; const float ang = (float)t * ROPE_F[i]; F.ROPE[idx] = (f32x2v){cosf(ang), sinf(ang)}; }
}

namespace att {
constexpr int NKEY = 384, K_OFF = 0, K_BYTES = NKEY * 128, V_OFF = K_BYTES, VHALF = NKEY * 64, V_BYTES = 2 * VHALF, SCR_OFF = V_OFF + V_BYTES, OST_OFF = SCR_OFF + 8 * 256, END = OST_OFF + 8 * 4096;
static_assert(END <= RING_BYTES, "attention LDS");
}
__device__ __forceinline__ void attn_unit(Frame& F, int u) {
    using namespace att;
    const int tid = F.tid, lane = F.lane, w = F.wave, r32 = lane & 31, hi = lane >> 5;
    const int p = u >> 10, rem = u & 1023, bh = rem >> 5, xx = rem & 31, b = bh >> 3, h = bh & 7;
    const int dsh = (p == 0) ? 4 : ((p == 1) ? 2 : 0), d = 1 << dsh;
    const int nsb = 32 >> dsh, r = xx / nsb, sb = xx % nsb;
    LAS unsigned char* lds = F.lds + RING_OFF;
    const bf16* Pb = F.PROJ + (size_t)b * SEQ * INW;
    __syncthreads();
    {
        v4u kreg[6], vreg[6];
#pragma unroll
        for (int it = 0; it < 6; ++it) { const int idx = tid + NTHR * it, kk = idx >> 3, c = idx & 7; int sp = 256 * sb - 128 + kk; sp = sp < 0 ? 0 : sp;
            const bf16* src = Pb + (size_t)((sp << dsh) + r) * INW + h * 64 + c * 8;
            kreg[it] = *(const GAS v4u*)(src + 512); vreg[it] = *(const GAS v4u*)(src + 1024); }
#pragma unroll
        for (int it = 0; it < 6; ++it) { const int idx = tid + NTHR * it, kk = idx >> 3, c = idx & 7;
            *(LAS v4u*)(lds + K_OFF + kk * 128 + ((c ^ ((kk >> 1) & 7)) << 4)) = kreg[it];
            *(LAS v4u*)(lds + V_OFF + (c >> 2) * VHALF + kk * 64 + (c & 3) * 16) = vreg[it]; }
    }
    const int ql = 32 * w + r32;
    const size_t qtok = (size_t)(((256 * sb + ql) << dsh) + r);
    bf16x8 qr[4];
#pragma unroll
    for (int d0 = 0; d0 < 4; ++d0) qr[d0] = *(const GAS bf16x8*)(Pb + qtok * INW + h * 64 + d0 * 16 + hi * 8);
    __syncthreads();
    f32x16 pt[5];
#pragma unroll
    for (int j = 0; j < 5; ++j) {
        pt[j] = (f32x16){0.f, 0.f, 0.f, 0.f, 0.f, 0.f, 0.f, 0.f, 0.f, 0.f, 0.f, 0.f, 0.f, 0.f, 0.f, 0.f};
        const int row = 32 * (w + j) + r32;
#pragma unroll
        for (int d0 = 0; d0 < 4; ++d0) { const bf16x8 kf = *(const LAS bf16x8*)(lds + K_OFF + row * 128 + (((2 * d0 + hi) ^ ((row >> 1) & 7)) << 4));
            pt[j] = __builtin_amdgcn_mfma_f32_32x32x16_bf16(kf, qr[d0], pt[j], 0, 0, 0); }
    }
    const float NEG = -1e30f;
#pragma unroll
    for (int rr = 0; rr < 16; ++rr) { const int kr = crow(rr, hi); if (kr < r32) pt[0][rr] = NEG; if (kr > r32) pt[4][rr] = NEG; }
    if (sb == 0) {
#pragma unroll
        for (int j = 0; j < 4; ++j) if (w + j < 4) {
#pragma unroll
            for (int rr = 0; rr < 16; ++rr) pt[j][rr] = NEG; }
    }
    float mx = NEG;
#pragma unroll
    for (int j = 0; j < 5; ++j)
#pragma unroll
        for (int rr = 0; rr < 16; ++rr) mx = fmaxf(mx, pt[j][rr]);
    mx = fmaxf(mx, __shfl_xor(mx, 32));
    float ls = 0.f;
#pragma unroll
    for (int j = 0; j < 5; ++j)
#pragma unroll
        for (int rr = 0; rr < 16; ++rr) { const float e = __builtin_amdgcn_exp2f(pt[j][rr] - mx); pt[j][rr] = e; ls += e; }
    ls += __shfl_xor(ls, 32);
    f32x16 o[2];
    o[0] = (f32x16){0.f, 0.f, 0.f, 0.f, 0.f, 0.f, 0.f, 0.f, 0.f, 0.f, 0.f, 0.f, 0.f, 0.f, 0.f, 0.f}; o[1] = o[0];
    const LAS unsigned char* vb = lds + V_OFF + ((lane >> 4) & 1) * 32 + (lane & 3) * 8 + (4 * hi + ((lane & 15) >> 2)) * 64;
#pragma unroll
    for (int j = 0; j < 5; ++j)
#pragma unroll
        for (int s = 0; s < 2; ++s) {
            v4u pw; pw.x = cvtpk(pt[j][8 * s + 0], pt[j][8 * s + 1]); pw.y = cvtpk(pt[j][8 * s + 2], pt[j][8 * s + 3]); pw.z = cvtpk(pt[j][8 * s + 4], pt[j][8 * s + 5]); pw.w = cvtpk(pt[j][8 * s + 6], pt[j][8 * s + 7]);
            const bf16x8 pa = __builtin_bit_cast(bf16x8, pw);
            const int k0 = 32 * (w + j) + 16 * s;
#pragma unroll
            for (int d0 = 0; d0 < 2; ++d0) { const LAS unsigned char* vp = vb + d0 * VHALF + k0 * 64;
                const bf16x8 vf = mk8(tr16(vp), tr16(vp + 512));
                o[d0] = __builtin_amdgcn_mfma_f32_32x32x16_bf16(pa, vf, o[d0], 0, 0, 0); }
        }
    volatile LAS float* scr = (volatile LAS float*)(lds + SCR_OFF) + w * 64;
    if (hi == 0) scr[r32] = ls;
    LDS_WAIT();
    LAS bf16* stg = (LAS bf16*)(lds + OST_OFF) + w * 2048;
#pragma unroll
    for (int rr = 0; rr < 16; ++rr) { const int orow = crow(rr, hi); const float rl = 1.0f / scr[orow];
#pragma unroll
        for (int d0 = 0; d0 < 2; ++d0) stg[orow * 64 + d0 * 32 + r32] = (bf16)(cvtpk(o[d0][rr] * rl, 0.f) & 0xffffu); }
    LDS_WAIT(); asm volatile("" ::: "memory");
    bf16* Op = F.OPART + ((size_t)p * M + (size_t)b * SEQ) * 512 + h * 64;
#pragma unroll
    for (int i = 0; i < 4; ++i) { const int row = i * 8 + (lane >> 3), ch = lane & 7; const v4u v = *(const LAS v4u*)(stg + row * 64 + ch * 8);
        const size_t tok = (size_t)(((256 * sb + 32 * w + row) << dsh) + r);
        *(GAS v4u*)(Op + tok * 512 + ch * 8) = v; }
    if (hi == 0) F.LSE[((size_t)p * M + (size_t)b * SEQ + qtok) * 8 + h] = mx + log2f(ls);
}

namespace ret {
constexpr int KRP = 192, VRP = 320;
constexpr int KV_K = 0, KV_V = 128 * KRP;
static_assert(KV_V + 128 * VRP <= RING_BYTES, "ret kv LDS");
constexpr int QRP = 144;
constexpr int O_QA = 0, O_QD = 128 * QRP, O_KA = 2 * 128 * QRP, O_VA = 3 * 128 * QRP, O_SA = O_VA + 128 * VRP, O_END = O_SA + 64 * VRP;
static_assert(O_END <= RING_BYTES, "ret out LDS");
constexpr int O_OUT = 0;
}
__device__ __forceinline__ void rot8(const v4u a, const v4u bq, const f32x2v* cs, float sc, v4u& o1, v4u& o2) {
    float x1[8], x2[8], y1[8], y2[8];
    x1[0] = bf_lo(a.x); x1[1] = bf_hi(a.x); x1[2] = bf_lo(a.y); x1[3] = bf_hi(a.y); x1[4] = bf_lo(a.z); x1[5] = bf_hi(a.z); x1[6] = bf_lo(a.w); x1[7] = bf_hi(a.w);
    x2[0] = bf_lo(bq.x); x2[1] = bf_hi(bq.x); x2[2] = bf_lo(bq.y); x2[3] = bf_hi(bq.y); x2[4] = bf_lo(bq.z); x2[5] = bf_hi(bq.z); x2[6] = bf_lo(bq.w); x2[7] = bf_hi(bq.w);
#pragma unroll
    for (int i = 0; i < 8; ++i) { const f32x2v c = cs[i]; y1[i] = (x1[i] * c.x - x2[i] * c.y) * sc; y2[i] = (x1[i] * c.y + x2[i] * c.x) * sc; }
    o1.x = cvtpk(y1[0], y1[1]); o1.y = cvtpk(y1[2], y1[3]); o1.z = cvtpk(y1[4], y1[5]); o1.w = cvtpk(y1[6], y1[7]);
    o2.x = cvtpk(y2[0], y2[1]); o2.y = cvtpk(y2[2], y2[3]); o2.z = cvtpk(y2[4], y2[5]); o2.w = cvtpk(y2[6], y2[7]);
}
__device__ __forceinline__ void retkv_unit(Frame& F, int u) {
    using namespace ret;
    const int tid = F.tid, lane = F.lane, w = F.wave, r32 = lane & 31, hi = lane >> 5;
    const int bh = u >> 6, n = u & 63, b = bh >> 2, h = bh & 3;
    LAS unsigned char* lds = F.lds + RING_OFF;
    const bf16* Pb = F.PROJ + ((size_t)b * SEQ + 128 * n) * INW;
    const float lg = lg2gamma(h);
    __syncthreads();
    {
        const int j = tid >> 2, c = tid & 3, t = 128 * n + j;
        const bf16* src = Pb + (size_t)j * INW + 1792 + h * 64 + 8 * c;
        const v4u a = *(const GAS v4u*)src, bq = *(const GAS v4u*)(src + 32);
        f32x2v cs[8];
#pragma unroll
        for (int i = 0; i < 8; ++i) cs[i] = F.ROPE[t * 32 + 8 * c + i];
        v4u o1, o2; rot8(a, bq, cs, __builtin_amdgcn_exp2f(lg * (float)(127 - j)), o1, o2);
        *(LAS v4u*)(lds + KV_K + j * KRP + 16 * c) = o1; *(LAS v4u*)(lds + KV_K + j * KRP + 64 + 16 * c) = o2;
#pragma unroll
        for (int it = 0; it < 4; ++it) { const int idx = tid + NTHR * it, jj = idx >> 4, cc = idx & 15;
            *(LAS v4u*)(lds + KV_V + jj * VRP + 16 * cc) = *(const GAS v4u*)(Pb + (size_t)jj * INW + 2048 + h * 128 + 8 * cc); }
    }
    __syncthreads();
    const int dt = w & 1, et = w >> 1;
    f32x16 acc = (f32x16){0.f, 0.f, 0.f, 0.f, 0.f, 0.f, 0.f, 0.f, 0.f, 0.f, 0.f, 0.f, 0.f, 0.f, 0.f, 0.f};
    const int rq = 4 * hi + ((lane & 15) >> 2), cq = 16 * ((lane >> 4) & 1) + 4 * (lane & 3);
    const LAS unsigned char* ka = lds + KV_K + rq * KRP + (32 * dt + cq) * 2;
    const LAS unsigned char* va = lds + KV_V + rq * VRP + (32 * et + cq) * 2;
#pragma unroll
    for (int ks = 0; ks < 8; ++ks) {
        const bf16x8 af = mk8(tr16(ka + 16 * ks * KRP), tr16(ka + (16 * ks + 8) * KRP));
        const bf16x8 bfv = mk8(tr16(va + 16 * ks * VRP), tr16(va + (16 * ks + 8) * VRP));
        acc = __builtin_amdgcn_mfma_f32_32x32x16_bf16(af, bfv, acc, 0, 0, 0);
    }
    float* dst = F.KV + (size_t)u * 8192;
#pragma unroll
    for (int rr = 0; rr < 16; ++rr) dst[(32 * dt + crow(rr, hi)) * 128 + 32 * et + r32] = acc[rr];
}

__device__ __forceinline__ void p3_scan_combine(Frame& F) {
    for (int e = F.vcu * NTHR + F.tid; e < 16 * 8192; e += F.G * NTHR) {
        const int bh = e >> 13, de = e & 8191; const float cd = __builtin_amdgcn_exp2f(lg2gamma(bh & 3) * 128.0f);
        float* p = F.KV + (size_t)bh * 64 * 8192 + de; float st = 0.f;
        for (int n0 = 0; n0 < 64; n0 += 8) { float cur[8];
#pragma unroll
            for (int i = 0; i < 8; ++i) cur[i] = p[(size_t)(n0 + i) * 8192];
#pragma unroll
            for (int i = 0; i < 8; ++i) { p[(size_t)(n0 + i) * 8192] = st; st = cd * st + cur[i]; } }
    }
    for (int it = F.vcu * NTHR + F.tid; it < M * 64; it += F.G * NTHR) {
        const int row = it >> 6, h = (it >> 3) & 7, c = it & 7;
        const float l0 = F.LSE[((size_t)0 * M + row) * 8 + h], l1 = F.LSE[((size_t)1 * M + row) * 8 + h], l2 = F.LSE[((size_t)2 * M + row) * 8 + h];
        const float mx = fmaxf(l0, fmaxf(l1, l2)); float w0 = __builtin_amdgcn_exp2f(l0 - mx), w1 = __builtin_amdgcn_exp2f(l1 - mx), w2 = __builtin_amdgcn_exp2f(l2 - mx);
        const float inv = 1.0f / (w0 + w1 + w2); w0 *= inv; w1 *= inv; w2 *= inv;
        const size_t off = (size_t)row * 512 + h * 64 + c * 8;
        const v4u a = *(const GAS v4u*)(F.OPART + off), bq = *(const GAS v4u*)(F.OPART + (size_t)M * 512 + off), cq = *(const GAS v4u*)(F.OPART + (size_t)2 * M * 512 + off);
        v4u o;
        o.x = cvtpk(w0 * bf_lo(a.x) + w1 * bf_lo(bq.x) + w2 * bf_lo(cq.x), w0 * bf_hi(a.x) + w1 * bf_hi(bq.x) + w2 * bf_hi(cq.x));
        o.y = cvtpk(w0 * bf_lo(a.y) + w1 * bf_lo(bq.y) + w2 * bf_lo(cq.y), w0 * bf_hi(a.y) + w1 * bf_hi(bq.y) + w2 * bf_hi(cq.y));
        o.z = cvtpk(w0 * bf_lo(a.z) + w1 * bf_lo(bq.z) + w2 * bf_lo(cq.z), w0 * bf_hi(a.z) + w1 * bf_hi(bq.z) + w2 * bf_hi(cq.z));
        o.w = cvtpk(w0 * bf_lo(a.w) + w1 * bf_lo(bq.w) + w2 * bf_lo(cq.w), w0 * bf_hi(a.w) + w1 * bf_hi(bq.w) + w2 * bf_hi(cq.w));
        *(GAS v4u*)(F.MIXED + (size_t)row * DM + h * 64 + c * 8) = o;
    }
}

__device__ __forceinline__ void retout_unit(Frame& F, int u) {
    using namespace ret;
    const int tid = F.tid, lane = F.lane, w = F.wave, r32 = lane & 31, hi = lane >> 5;
    const int bh = u >> 6, n = u & 63, b = bh >> 2, h = bh & 3;
    LAS unsigned char* lds = F.lds + RING_OFF;
    const size_t row0 = (size_t)b * SEQ + 128 * n;
    const bf16* Pb = F.PROJ + row0 * INW;
    const float lg = lg2gamma(h);
    __syncthreads();
    {
        const int i = tid >> 2, c = tid & 3, t = 128 * n + i;
        f32x2v cs[8];
#pragma unroll
        for (int k = 0; k < 8; ++k) cs[k] = F.ROPE[t * 32 + 8 * c + k];
        const bf16* sq = Pb + (size_t)i * INW + 1536 + h * 64 + 8 * c;
        v4u a = *(const GAS v4u*)sq, bq = *(const GAS v4u*)(sq + 32), o1, o2;
        rot8(a, bq, cs, 1.0f, o1, o2);
        *(LAS v4u*)(lds + O_QA + i * QRP + 16 * c) = o1; *(LAS v4u*)(lds + O_QA + i * QRP + 64 + 16 * c) = o2;
        rot8(a, bq, cs, __builtin_amdgcn_exp2f(lg * (float)(i + 1)), o1, o2);
        *(LAS v4u*)(lds + O_QD + i * QRP + 16 * c) = o1; *(LAS v4u*)(lds + O_QD + i * QRP + 64 + 16 * c) = o2;
        const bf16* sk = Pb + (size_t)i * INW + 1792 + h * 64 + 8 * c;
        a = *(const GAS v4u*)sk; bq = *(const GAS v4u*)(sk + 32);
        rot8(a, bq, cs, 1.0f, o1, o2);
        *(LAS v4u*)(lds + O_KA + i * QRP + 16 * c) = o1; *(LAS v4u*)(lds + O_KA + i * QRP + 64 + 16 * c) = o2;
#pragma unroll
        for (int it = 0; it < 4; ++it) { const int idx = tid + NTHR * it, jj = idx >> 4, cc = idx & 15;
            *(LAS v4u*)(lds + O_VA + jj * VRP + 16 * cc) = *(const GAS v4u*)(Pb + (size_t)jj * INW + 2048 + h * 128 + 8 * cc); }
        const float* sp = F.KV + (size_t)u * 8192 + tid * 16; const int sd = tid >> 3, se = (tid & 7) * 16;
        const f32x4 s0 = *(const GAS f32x4*)sp, s1 = *(const GAS f32x4*)(sp + 4), s2 = *(const GAS f32x4*)(sp + 8), s3 = *(const GAS f32x4*)(sp + 12);
        v4u q0, q1; q0.x = cvtpk(s0.x, s0.y); q0.y = cvtpk(s0.z, s0.w); q0.z = cvtpk(s1.x, s1.y); q0.w = cvtpk(s1.z, s1.w);
        q1.x = cvtpk(s2.x, s2.y); q1.y = cvtpk(s2.z, s2.w); q1.z = cvtpk(s3.x, s3.y); q1.w = cvtpk(s3.z, s3.w);
        *(LAS v4u*)(lds + O_SA + sd * VRP + se * 2) = q0; *(LAS v4u*)(lds + O_SA + sd * VRP + se * 2 + 16) = q1;
    }
    __syncthreads();
    const int qt = w & 3, eh = w >> 2;
    bf16x8 qf[4], qd[4];
#pragma unroll
    for (int ds = 0; ds < 4; ++ds) { qf[ds] = *(const LAS bf16x8*)(lds + O_QA + (32 * qt + r32) * QRP + (2 * ds + hi) * 16); qd[ds] = *(const LAS bf16x8*)(lds + O_QD + (32 * qt + r32) * QRP + (2 * ds + hi) * 16); }
    f32x16 o[2];
    o[0] = (f32x16){0.f, 0.f, 0.f, 0.f, 0.f, 0.f, 0.f, 0.f, 0.f, 0.f, 0.f, 0.f, 0.f, 0.f, 0.f, 0.f}; o[1] = o[0];
    const int rq = (lane & 15) >> 2, cq = 16 * ((lane >> 4) & 1) + 4 * (lane & 3);
#pragma unroll
    for (int kt = 0; kt < 4; ++kt) if (kt <= qt) {
        f32x16 pt = (f32x16){0.f, 0.f, 0.f, 0.f, 0.f, 0.f, 0.f, 0.f, 0.f, 0.f, 0.f, 0.f, 0.f, 0.f, 0.f, 0.f};
#pragma unroll
        for (int ds = 0; ds < 4; ++ds) { const bf16x8 kf = *(const LAS bf16x8*)(lds + O_KA + (32 * kt + r32) * QRP + (2 * ds + hi) * 16);
            pt = __builtin_amdgcn_mfma_f32_32x32x16_bf16(kf, qf[ds], pt, 0, 0, 0); }
#pragma unroll
        for (int rr = 0; rr < 16; ++rr) { const int dd = (32 * qt + r32) - (32 * kt + crow(rr, hi)); pt[rr] = (dd >= 0) ? pt[rr] * __builtin_amdgcn_exp2f(lg * (float)dd) : 0.f; }
#pragma unroll
        for (int s = 0; s < 2; ++s) {
            v4u pw; pw.x = cvtpk(pt[8 * s + 0], pt[8 * s + 1]); pw.y = cvtpk(pt[8 * s + 2], pt[8 * s + 3]); pw.z = cvtpk(pt[8 * s + 4], pt[8 * s + 5]); pw.w = cvtpk(pt[8 * s + 6], pt[8 * s + 7]);
            const bf16x8 pa = __builtin_bit_cast(bf16x8, pw);
#pragma unroll
            for (int d0 = 0; d0 < 2; ++d0) { const LAS unsigned char* vp = lds + O_VA + (32 * kt + 16 * s + 4 * hi + rq) * VRP + (64 * eh + 32 * d0 + cq) * 2;
                o[d0] = __builtin_amdgcn_mfma_f32_32x32x16_bf16(pa, mk8(tr16(vp), tr16(vp + 8 * VRP)), o[d0], 0, 0, 0); }
        }
    }
#pragma unroll
    for (int ds = 0; ds < 4; ++ds)
#pragma unroll
        for (int d0 = 0; d0 < 2; ++d0) { const LAS unsigned char* sp = lds + O_SA + (16 * ds + 8 * hi + rq) * VRP + (64 * eh + 32 * d0 + cq) * 2;
            o[d0] = __builtin_amdgcn_mfma_f32_32x32x16_bf16(qd[ds], mk8(tr16(sp), tr16(sp + 4 * VRP)), o[d0], 0, 0, 0); }
    __syncthreads();
    LAS float* outl = (LAS float*)(lds + O_OUT);
#pragma unroll
    for (int rr = 0; rr < 16; ++rr)
#pragma unroll
        for (int d0 = 0; d0 < 2; ++d0) outl[(32 * qt + crow(rr, hi)) * 128 + 64 * eh + 32 * d0 + r32] = o[d0][rr];
    __syncthreads();
    {
        const int i = tid >> 2, part = tid & 3;
        float v[32]; float ss = 0.f;
#pragma unroll
        for (int k = 0; k < 8; ++k) { const f32x4 t4 = *(const LAS f32x4*)(outl + i * 128 + 32 * part + 4 * k); v[4 * k] = t4.x; v[4 * k + 1] = t4.y; v[4 * k + 2] = t4.z; v[4 * k + 3] = t4.w; ss += (t4.x * t4.x + t4.y * t4.y) + (t4.z * t4.z + t4.w * t4.w); }
        ss += __shfl_xor(ss, 1); ss += __shfl_xor(ss, 2);
        const float rstd = 1.0f / sqrtf(ss * (1.0f / 128.0f) + NORM_EPS);
        const bf16* gp = Pb + (size_t)i * INW + 2560 + h * 128 + 32 * part;
        bf16* op = F.MIXED + (row0 + i) * DM + 512 + h * 128 + 32 * part;
#pragma unroll
        for (int k = 0; k < 4; ++k) { const v4u g = *(const GAS v4u*)(gp + 8 * k); float gv[8];
            gv[0] = bf_lo(g.x); gv[1] = bf_hi(g.x); gv[2] = bf_lo(g.y); gv[3] = bf_hi(g.y); gv[4] = bf_lo(g.z); gv[5] = bf_hi(g.z); gv[6] = bf_lo(g.w); gv[7] = bf_hi(g.w);
            float ov[8];
#pragma unroll
            for (int q = 0; q < 8; ++q) { const float sg = gv[q] * __builtin_amdgcn_rcpf(1.0f + __builtin_amdgcn_exp2f(-1.4426950408889634f * gv[q])); ov[q] = v[8 * k + q] * rstd * sg; }
            v4u ow; ow.x = cvtpk(ov[0], ov[1]); ow.y = cvtpk(ov[2], ov[3]); ow.z = cvtpk(ov[4], ov[5]); ow.w = cvtpk(ov[6], ov[7]);
            *(GAS v4u*)(op + 8 * k) = ow; }
    }
}

__device__ __forceinline__ void load_bf16_row(const bf16* row, int lane, f32x4 (&v)[4]) {
    const GAS u32x2* p = (const GAS u32x2*)row + lane;
#pragma unroll
    for (int j = 0; j < 4; ++j) { const u32x2 w = p[64 * j]; v[j] = (f32x4){bf_lo(w.x), bf_hi(w.x), bf_lo(w.y), bf_hi(w.y)}; }
}
__device__ __forceinline__ float sumsq4(const f32x4 (&v)[4]) { float s = 0.f;
#pragma unroll
    for (int j = 0; j < 4; ++j) s += (v[j].x * v[j].x + v[j].y * v[j].y) + (v[j].z * v[j].z + v[j].w * v[j].w);
    return s; }
__device__ __forceinline__ void p6_resnorm(Frame& F) {
    const int gw = F.vcu * NWAVES + F.wave, NGW = F.G * NWAVES, lane = F.lane;
    for (int m = gw; m < M; m += NGW) {
        f32x4 a[4]; load_bf16_row(F.MIX + (size_t)m * DM, lane, a);
        const float r2 = 1.f / sqrtf(wave_sum(sumsq4(a)) * (1.f / DM) + NORM_EPS);
        const GAS f32x4* xr = (const GAS f32x4*)(F.x + (size_t)m * DM) + lane; const GAS f32x4* g2 = (const GAS f32x4*)F.g_post + lane; const GAS f32x4* g3 = (const GAS f32x4*)F.g_fpre + lane;
        GAS f32x4* orow = (GAS f32x4*)(F.out + (size_t)m * DM) + lane;
#pragma unroll
        for (int j = 0; j < 4; ++j) { a[j] = xr[64 * j] + a[j] * r2 * g2[64 * j]; orow[64 * j] = a[j]; }
        const float r3 = 1.f / sqrtf(wave_sum(sumsq4(a)) * (1.f / DM) + NORM_EPS);
        GAS unsigned long long* o8 = (GAS unsigned long long*)(F.XN + (size_t)m * DM) + lane;
#pragma unroll
        for (int j = 0; j < 4; ++j) { const f32x4 g = g3[64 * j]; o8[64 * j] = (unsigned long long)cvtpk(a[j].x * r3 * g.x, a[j].y * r3 * g.y) | ((unsigned long long)cvtpk(a[j].z * r3 * g.z, a[j].w * r3 * g.w) << 32); }
    }
}
__device__ __forceinline__ void p10_final(Frame& F) {
    const int gw = F.vcu * NWAVES + F.wave, NGW = F.G * NWAVES, lane = F.lane;
    for (int m = gw; m < M; m += NGW) {
        f32x4 a[4]; load_bf16_row(F.FFN + (size_t)m * DM, lane, a);
        const float r4 = 1.f / sqrtf(wave_sum(sumsq4(a)) * (1.f / DM) + NORM_EPS);
        const GAS f32x4* g4 = (const GAS f32x4*)F.g_fpost + lane; GAS f32x4* orow = (GAS f32x4*)(F.out + (size_t)m * DM) + lane;
#pragma unroll
        for (int j = 0; j < 4; ++j) orow[64 * j] = orow[64 * j] + a[j] * r4 * g4[64 * j];
    }
}
__device__ __forceinline__ void p8_fixup(Frame& F) {
    for (int it = F.vcu * NTHR + F.tid; it < (M / 64) * 2 * FF; it += F.G * NTHR) {
        const int ri = it / FF, j = it % FF, g = ri >> 1, which = ri & 1; const bool first = (g % (SEQ / 64)) == 0;
        float y[2];
#pragma unroll
        for (int hf = 0; hf < 2; ++hf) {
            const float* ubg = F.UB + ((size_t)g * 8 + hf) * FF + j;
            const float* ubp = ubg - (size_t)8 * FF;
            const int c = hf * FF + j;
            const float ut = ubg[(size_t)(2 + which) * 2 * FF];
            const float u1 = which ? ubg[(size_t)2 * 2 * FF] : (first ? 0.f : ubp[(size_t)1 * 2 * FF]);
            const float u2 = first ? 0.f : (which ? ubp[(size_t)1 * 2 * FF] : ubp[0]);
            y[hf] = F.conv_b[c] + F.conv_w[2 * FF2 + c] * ut + F.conv_w[FF2 + c] * u1 + F.conv_w[c] * u2;
        }
        const float a = pg8::gelu_tanh_f(y[0]) * y[1];
        F.ACT[(size_t)(64 * g + which) * FF + j] = (bf16)(cvtpk(a, 0.f) & 0xffffu);
    }
}

struct Args { const float* in[11]; float* out; unsigned char* ws; int ph_lo, ph_hi, li, pad; };
__global__ void __launch_bounds__(NTHR, 2) mk_fwd(Args args) {
    extern __shared__ __attribute__((aligned(16))) unsigned char lds[];
    Frame F;
    F.lds = (LAS unsigned char*)lds;
    F.MISC = (volatile LAS unsigned*)(F.lds + MISC_OFF);
    F.tid = threadIdx.x; F.lane = F.tid & 63; F.wave = __builtin_amdgcn_readfirstlane(F.tid >> 6);
    F.G = gridDim.x; { const int bx = blockIdx.x; F.vcu = (F.G % 8 == 0) ? (bx % 8) * (F.G / 8) + bx / 8 : bx; }
    unsigned char* ws = args.ws;
    F.ctl = (gu32*)(ws + WS_CTL);
    F.x = args.in[0]; F.g_pre = args.in[1]; F.g_post = args.in[2]; F.w_in = args.in[3]; F.w_out = args.in[4]; F.g_fpre = args.in[5]; F.g_fpost = args.in[6];
    F.w_up = args.in[7]; F.conv_w = args.in[8]; F.conv_b = args.in[9]; F.w_down = args.in[10]; F.out = args.out;
    F.Win_t = (bf16*)(ws + WS_WIN); F.Wout_t = (bf16*)(ws + WS_WOUT); F.Wup_t = (bf16*)(ws + WS_WUP); F.Wdn_t = (bf16*)(ws + WS_WDN);
    F.XN = (bf16*)(ws + WS_XN); F.PROJ = (bf16*)(ws + WS_PROJ); F.ACT = (bf16*)(ws + WS_ACT); F.OPART = (bf16*)(ws + WS_OPART); F.MIX = (bf16*)(ws + WS_MIX);
    F.FFN = (bf16*)(ws + WS_FFN); F.MIXED = (bf16*)(ws + WS_MIXED); F.LSE = (float*)(ws + WS_LSE); F.UB = (float*)(ws + WS_UB); F.KV = (float*)(ws + WS_KV);
    F.ROPE = (f32x2v*)(ws + WS_ROPE);
    for (int u = F.tid; u < (LDS_BYTES - LDSCTL_OFF) / 4; u += NTHR) ((LAS unsigned*)(F.lds + LDSCTL_OFF))[u] = 0u;
    __syncthreads();
    XcdBarrier bar; bar.bar = (unsigned*)(F.ctl + CW_BAR) + args.li * XCD_BAR_WORDS; bar.x = 0; bar.st = nullptr;
    const int lo = args.ph_lo, hi = args.ph_hi;
    if (hi - lo > 1) bar = xcd_barrier_post((unsigned*)(F.ctl + CW_BAR) + args.li * XCD_BAR_WORDS, F.MISC + 8);
#define IN(k) (lo <= (k) && (k) < hi)
#define SEAM(k) do { if (IN(k) && IN((k) + 1)) xcd_barrier(bar); } while (0)

    if (IN(0)) { p0_prep(F); SEAM(0); }
    if (IN(1)) {
        pg8::Gemm g{F.XN, F.Win_t, M, INW, DM}; pg8::StaticOrder S; S.init(M, INW, F.G, (int)blockIdx.x);
        pg8::EpiStore E{F.PROJ, INW, 2, QSCALE, 7, 0.125f};
        pg8::gemm_phase<pg8::EpiStore, pg8::StaticOrder, true, true>(F.lds + RING_OFF, g, S, E);
        SEAM(1);
    }
    if (IN(2)) {
        { const int NU = 3 * 1024; const int u0 = (int)((long)F.vcu * NU / F.G), u1 = (int)((long)(F.vcu + 1) * NU / F.G); for (int u = u0; u < u1; ++u) attn_unit(F, u); }
        { const int NU = 1024; const int u0 = (int)((long)F.vcu * NU / F.G), u1 = (int)((long)(F.vcu + 1) * NU / F.G); for (int u = u0; u < u1; ++u) retkv_unit(F, u); }
        __syncthreads();
        SEAM(2);
    }
    if (IN(3)) { p3_scan_combine(F); SEAM(3); }
    if (IN(4)) {
        { const int NU = 1024; const int u0 = (int)((long)F.vcu * NU / F.G), u1 = (int)((long)(F.vcu + 1) * NU / F.G); for (int u = u0; u < u1; ++u) retout_unit(F, u); }
        __syncthreads();
        SEAM(4);
    }
    if (IN(5)) {
        pg8::Gemm g{F.MIXED, F.Wout_t, M, DM, DM}; pg8::StaticOrder S; S.init(M, DM, F.G, (int)blockIdx.x);
        pg8::EpiStore E{F.MIX, DM, 0, 1.0f, -1, 1.0f};
        pg8::gemm_phase<pg8::EpiStore, pg8::StaticOrder, true, true>(F.lds + RING_OFF, g, S, E);
        SEAM(5);
    }
    if (IN(6)) { p6_resnorm(F); SEAM(6); }
    if (IN(7)) {
        pg8::Gemm g{F.XN, F.Wup_t, M, FF2, DM}; pg8::StaticOrder S; S.init(M, FF2, F.G, (int)blockIdx.x);
        pg8::EpiConvAct E{F.ACT, F.UB, F.conv_w, F.conv_b};
        pg8::gemm_phase<pg8::EpiConvAct, pg8::StaticOrder, true, true>(F.lds + RING_OFF, g, S, E);
        SEAM(7);
    }
    if (IN(8)) { p8_fixup(F); SEAM(8); }
    if (IN(9)) {
        pg8::Gemm g{F.ACT, F.Wdn_t, M, DM, FF}; pg8::StaticOrder S; S.init(M, DM, F.G, (int)blockIdx.x);
        pg8::EpiStore E{F.FFN, DM, 0, 1.0f, -1, 1.0f};
        pg8::gemm_phase<pg8::EpiStore, pg8::StaticOrder, true, true>(F.lds + RING_OFF, g, S, E);
        SEAM(9);
    }
    if (IN(10)) { p10_final(F); }
#undef IN
#undef SEAM
}

extern "C" void kernel_launch(void* const* d_in, const int* in_sizes, int n_in, void* d_out, int out_size, void* d_ws, size_t ws_size, hipStream_t stream) {
    static int grid = 0;
    if (grid == 0) {
        if (n_in != 11 || in_sizes[0] != M * DM || out_size != M * DM || ws_size < WS_END) { fprintf(stderr, "kernel_launch: unexpected shapes (n_in %d in0 %d out %d ws %zu); nothing launched\n", n_in, n_in > 0 ? in_sizes[0] : -1, out_size, ws_size); grid = -1; return; }
        int dev = 0, cus = 0, per_cu = 0;
        if (hipGetDevice(&dev) != hipSuccess || hipDeviceGetAttribute(&cus, hipDeviceAttributeMultiprocessorCount, dev) != hipSuccess) { grid = -1; return; }
        if (hipFuncSetAttribute((const void*)mk_fwd, hipFuncAttributeMaxDynamicSharedMemorySize, LDS_BYTES) != hipSuccess) { fprintf(stderr, "kernel_launch: hipFuncSetAttribute failed\n"); grid = -1; return; }
        if (hipOccupancyMaxActiveBlocksPerMultiprocessor(&per_cu, (const void*)mk_fwd, NTHR, LDS_BYTES) != hipSuccess || per_cu < 1) fprintf(stderr, "kernel_launch: occupancy query says %d blocks per CU\n", per_cu);
        (void)hipGetLastError();
        grid = cus;
    }
    if (grid < 0) return;
    if (hipMemsetAsync((char*)d_ws + WS_CTL, 0, CTL_ZERO_BYTES, stream) != hipSuccess) return;
    Args a{};
    for (int i = 0; i < 11; ++i) a.in[i] = (const float*)d_in[i];
    a.out = (float*)d_out; a.ws = (unsigned char*)d_ws;
#if MK_N_LAUNCHES == 1
    a.ph_lo = 0; a.ph_hi = N_PHASES; a.li = 0;
    hipLaunchKernelGGL(mk_fwd, dim3(grid), dim3(NTHR), LDS_BYTES, stream, a);
#else
    for (int li = 0; li < N_PHASES; ++li) { a.ph_lo = li; a.ph_hi = li + 1; a.li = 0; hipLaunchKernelGGL(mk_fwd, dim3(grid), dim3(NTHR), LDS_BYTES, stream, a); }
#endif
}
```

```cpp
#include <hip/hip_runtime.h>
#include <cstdio>
#include <cstdint>
#define MK_N_LAUNCHES 1

namespace pg8 {
#define PG8_LAS __attribute__((address_space(3)))
typedef unsigned short bf16_t;
typedef short bf16x8 __attribute__((ext_vector_type(8)));
typedef float f32x4 __attribute__((ext_vector_type(4)));
typedef unsigned u32x4 __attribute__((ext_vector_type(4)));
constexpr int BM = 256, BK = 64, HALF = 128, HTB = HALF * BK * 2  , STAGE_BYTES = 8 * HTB, NXCD = 8, WGM = 8;

__host__ __device__ __forceinline__ int lds_byte(int r, int c) { const int st = (r >> 4) * 2 + (c >> 5), rr = r & 15, cc = c & 31, ob = rr * 64 + cc * 2; return st * 1024 + (ob ^ (((ob >> 9) & 1) << 5)); }
__host__ __device__ __forceinline__ void stage_rc(int b, int& R, int& C) { const int st = b / 1024, sb = b % 1024, swz = sb ^ (((sb >> 9) & 1) << 5); R = (st >> 1) * 16 + swz / 64; C = (st & 1) * 32 + (swz % 64) / 2; }
__host__ __device__ __forceinline__ int perm32(int rho) { const int n = rho >> 4, i = rho & 15; return 8 * (i >> 2) + 4 * n + (i & 3); }

struct Unit { int pm, pn; };
struct Gemm { const bf16_t* A; const bf16_t* Bt; int M, N, K; };

struct StaticOrder {
    int nM, nN, nwg, G, c;
    __host__ __device__ void init(int M, int N, int G_, int c_) { nM = M / BM; nN = N / BM; nwg = nM * nN; G = G_; c = c_; }
    __host__ __device__ bool next(int i, Unit& u) const {
        const long L = (long)i * G + c; if (L >= nwg) return false;
        int wgid = (int)L; { const int q = nwg / NXCD, r = nwg % NXCD, xcd = wgid % NXCD, off = wgid / NXCD; wgid = (xcd < r ? xcd * (q + 1) : r * (q + 1) + (xcd - r) * q) + off; }
        const int nig = WGM * nN, gid = wgid / nig, fm = gid * WGM, gsz = (nM - fm) < WGM ? (nM - fm) : WGM;
        u.pm = fm + ((wgid % nig) % gsz); u.pn = (wgid % nig) / gsz; return true;
    }
    __device__ __forceinline__ void a_ready(const Unit&) const {}
    __device__ __forceinline__ void done(const Unit&) const {}
};

__device__ __forceinline__ unsigned cvt_pk_bf16(float lo, float hi) { unsigned r; asm volatile("v_cvt_pk_bf16_f32 %0, %1, %2" : "=v"(r) : "v"(lo), "v"(hi)); return r; }
typedef float f32x2 __attribute__((ext_vector_type(2)));
__device__ __forceinline__ f32x2 gelu_pk(f32x2 v) {
    const f32x2 av = __builtin_elementwise_abs(v), d = av * 0.2316418882f + 1.0f;
    f32x2 t; t.x = __builtin_amdgcn_rcpf(d.x); t.y = __builtin_amdgcn_rcpf(d.y);
    f32x2 q = t * 0.5307027145f + (-0.7265760135f); q = q * t + 0.7107068705f; q = q * t + (-0.142248368f); q = q * t + 0.127414796f; q = q * t;
    const f32x2 s = (v * v) * (-0.72134752044f);
    f32x2 e; e.x = __builtin_amdgcn_exp2f(s.x); e.y = __builtin_amdgcn_exp2f(s.y);
    const f32x2 m = v * (q * e), r = v - m;
    f32x2 o; o.x = v.x < 0.f ? m.x : r.x; o.y = v.y < 0.f ? m.y : r.y; return o;
}

template <int ACT  > struct EpiBf16 {
    static constexpr bool PERM = true, AFTER_DRAIN = false; static_assert(ACT == 0 || ACT == 1, "EpiBf16: ACT is 0 (none) or 1 (gelu_pk)");
    bf16_t* O; int ldc; const float* bias; int split_cols; size_t split_stride; float scale0;
    __device__ __forceinline__ void operator()(const f32x4 (&acc)[2][2][4][2], const Unit& u, int wr, int wc, int fr, int fq) const {
        const int row0 = u.pm * BM + wr * 64 + fr; int colt = u.pn * BM; bf16_t* base = O;
        float sc = 1.f; if (split_cols) { const int t = colt / split_cols; base += (size_t)t * split_stride; colt -= t * split_cols; if (t == 0) sc = scale0; }
        const int col0 = colt + wc * 32 + 8 * fq, bcol0 = u.pn * BM + wc * 32 + 8 * fq;
        f32x4 bv[2][2];
#pragma unroll
        for (int bj = 0; bj < 2; ++bj)
#pragma unroll
            for (int n = 0; n < 2; ++n) bv[bj][n] = bias ? *(const f32x4*)(bias + bcol0 + bj * HALF + 4 * n) : (f32x4){0.f, 0.f, 0.f, 0.f};
#pragma unroll
        for (int ai = 0; ai < 2; ++ai)
#pragma unroll
            for (int m = 0; m < 4; ++m) { bf16_t* rowp = base + (size_t)(row0 + ai * HALF + m * 16) * ldc + col0;
#pragma unroll
                for (int bj = 0; bj < 2; ++bj) { f32x4 v0 = acc[ai][bj][m][0] + bv[bj][0], v1 = acc[ai][bj][m][1] + bv[bj][1];
                    if (ACT == 1) { f32x2 a = gelu_pk((f32x2){v0[0], v0[1]}), b = gelu_pk((f32x2){v0[2], v0[3]}), c = gelu_pk((f32x2){v1[0], v1[1]}), d = gelu_pk((f32x2){v1[2], v1[3]});
                        v0 = (f32x4){a.x, a.y, b.x, b.y}; v1 = (f32x4){c.x, c.y, d.x, d.y}; }
                    v0 = v0 * sc; v1 = v1 * sc; u32x4 w; w.x = cvt_pk_bf16(v0[0], v0[1]); w.y = cvt_pk_bf16(v0[2], v0[3]); w.z = cvt_pk_bf16(v1[0], v1[1]); w.w = cvt_pk_bf16(v1[2], v1[3]);
                    *(u32x4*)(rowp + bj * HALF) = w; } }
    }
};

struct PanelStats {
    unsigned* xbuf;
    unsigned* cnt;
    unsigned* tmo;
    int ntn; float eps;
    unsigned code;
    __device__ __forceinline__ bool run(const f32x4 (&v)[2][2][4][2], const Unit& u, int wr, int wc, int fr, int fq, PG8_LAS unsigned char* lds, int wid, int lane) const {
        typedef float f32x2v __attribute__((ext_vector_type(2)));
        PG8_LAS f32x2v* P = (PG8_LAS f32x2v*)lds;
        PG8_LAS f32x2v* S = (PG8_LAS f32x2v*)(lds + 8192);
        PG8_LAS unsigned* flag = (PG8_LAS unsigned*)(lds + 8192 + 2048);
#pragma unroll
        for (int ai = 0; ai < 2; ++ai)
#pragma unroll
            for (int m = 0; m < 4; ++m) {
                float s = 0.f;
#pragma unroll
                for (int bj = 0; bj < 2; ++bj)
#pragma unroll
                    for (int n = 0; n < 2; ++n) { const f32x4 x = v[ai][bj][m][n]; s += (x[0] + x[1]) + (x[2] + x[3]); }
                s += __shfl_xor(s, 16); s += __shfl_xor(s, 32);
                const float mw = s * (1.0f / 64.0f); float q = 0.f;
#pragma unroll
                for (int bj = 0; bj < 2; ++bj)
#pragma unroll
                    for (int n = 0; n < 2; ++n) { const f32x4 d = v[ai][bj][m][n] - mw; q += (d[0] * d[0] + d[1] * d[1]) + (d[2] * d[2] + d[3] * d[3]); }
                q += __shfl_xor(q, 16); q += __shfl_xor(q, 32);
                if (fq == 0) P[(ai * HALF + wr * 64 + m * 16 + fr) * 4 + wc] = (f32x2v){mw, q};
            }
        asm volatile("s_waitcnt lgkmcnt(0)" ::: "memory"); __builtin_amdgcn_s_barrier(); asm volatile("" ::: "memory");
#if defined(BROKEN_EXCHANGE_NO_WAIT)
#warning BROKEN CONTROL BUILD: the row-statistics exchange does not wait; results are wrong by design
        if (blockIdx.x >= 64) { const long long t0_ = clock64(); while (clock64() - t0_ < 60000) __builtin_amdgcn_s_sleep(8); }
#endif
        const int row = wid * 32 + (lane & 31);
        if (lane < 32) {
            const f32x2v a = P[row * 4 + 0], b = P[row * 4 + 1], c = P[row * 4 + 2], d = P[row * 4 + 3];
            const float mt = (a.x + b.x + c.x + d.x) * 0.25f;
            const float da = a.x - mt, db = b.x - mt, dc = c.x - mt, dd = d.x - mt;
            const float m2 = (a.y + b.y) + (c.y + d.y) + 64.0f * ((da * da + db * db) + (dc * dc + dd * dd));
            unsigned long long* slot = (unsigned long long*)xbuf + ((size_t)(u.pm * BM + row) * 4 + u.pn);
            __hip_atomic_store(slot, ((unsigned long long)__float_as_uint(m2) << 32) | __float_as_uint(mt), __ATOMIC_RELAXED, __HIP_MEMORY_SCOPE_AGENT);
        }
        asm volatile("s_waitcnt vmcnt(0)" ::: "memory");
        if (lane == 0) __hip_atomic_fetch_add(cnt + 64 * u.pm, 1u, __ATOMIC_RELAXED, __HIP_MEMORY_SCOPE_AGENT);
        if (wid == 0) {
            bool dead = false; const unsigned long long t0 = __builtin_amdgcn_s_memrealtime(); const unsigned want = 8u * (unsigned)ntn;
            for (;;) {
#if defined(BROKEN_EXCHANGE_NO_WAIT)
                break;
#endif
                if ((unsigned)__builtin_amdgcn_readfirstlane(__hip_atomic_load(cnt + 64 * u.pm, __ATOMIC_RELAXED, __HIP_MEMORY_SCOPE_AGENT)) >= want) break;
                if (__builtin_amdgcn_s_memrealtime() - t0 > 2000000ull) {
                    if (lane == 0) { unsigned expect = 0u; __hip_atomic_compare_exchange_strong(tmo + 1, &expect, code | (unsigned)(u.pm & 0xff), __ATOMIC_RELAXED, __ATOMIC_RELAXED, __HIP_MEMORY_SCOPE_AGENT);
                                     __hip_atomic_store(tmo, 1u, __ATOMIC_RELAXED, __HIP_MEMORY_SCOPE_AGENT); }
                    dead = true; break; }
                __builtin_amdgcn_s_sleep(2);
            }
            __builtin_amdgcn_fence(__ATOMIC_ACQUIRE, "agent");
            if (lane == 0) flag[0] = dead ? 1u : 0u;
        }
        asm volatile("s_waitcnt vmcnt(0) lgkmcnt(0)" ::: "memory"); __builtin_amdgcn_s_barrier(); asm volatile("" ::: "memory");
        const bool bad = flag[0] != 0u;
        if (lane < 32) {
            const unsigned long long* slot = (const unsigned long long*)xbuf + (size_t)(u.pm * BM + row) * 4; float mt[4], m2[4]; float ms = 0.f;
#pragma unroll
            for (int t = 0; t < 4; ++t) { if (t < ntn) { const unsigned long long w = __hip_atomic_load(slot + t, __ATOMIC_RELAXED, __HIP_MEMORY_SCOPE_AGENT); mt[t] = __uint_as_float((unsigned)w); m2[t] = __uint_as_float((unsigned)(w >> 32)); } else { mt[t] = 0.f; m2[t] = 0.f; } ms += mt[t]; }
            const float mean = ms / (float)ntn; float q = 0.f;
#pragma unroll
            for (int t = 0; t < 4; ++t) if (t < ntn) { const float dm = mt[t] - mean; q += m2[t] + 256.0f * dm * dm; }
            S[row] = (f32x2v){mean, 1.0f / sqrtf(q / (256.0f * (float)ntn) + eps)};
        }
        asm volatile("s_waitcnt lgkmcnt(0)" ::: "memory"); __builtin_amdgcn_s_barrier(); asm volatile("" ::: "memory");
        return bad;
    }
};
struct EpiLnRes {
    static constexpr bool PERM = false, AFTER_DRAIN = true;
    const float* base; float* out; int ldc; const float* bias; PanelStats st; unsigned poison;
    __device__ __forceinline__ void fused(f32x4 (&acc)[2][2][4][2], const Unit& u, int wr, int wc, int fr, int fq, PG8_LAS unsigned char* lds, int wid, int lane) const {
        typedef float f32x2v __attribute__((ext_vector_type(2)));
        const PG8_LAS f32x2v* S = (const PG8_LAS f32x2v*)(lds + 8192);
        const int col0 = u.pn * BM + wc * 32 + 4 * fq;
#pragma unroll
        for (int bj = 0; bj < 2; ++bj)
#pragma unroll
            for (int n = 0; n < 2; ++n) { const f32x4 bv = bias ? *(const f32x4*)(bias + col0 + bj * HALF + n * 16) : (f32x4){0.f, 0.f, 0.f, 0.f};
#pragma unroll
                for (int ai = 0; ai < 2; ++ai)
#pragma unroll
                    for (int m = 0; m < 4; ++m) acc[ai][bj][m][n] += bv; }
        f32x4 pre[4][2][2];
#pragma unroll
        for (int m = 0; m < 4; ++m) { const size_t off = (size_t)(u.pm * BM + wr * 64 + m * 16 + fr) * ldc + col0;
#pragma unroll
            for (int bj = 0; bj < 2; ++bj)
#pragma unroll
                for (int n = 0; n < 2; ++n) pre[m][bj][n] = *(const f32x4*)(base + off + bj * HALF + n * 16); }
        const bool bad = st.run(acc, u, wr, wc, fr, fq, lds, wid, lane) || poison != 0u;
        const float qnan = __builtin_nanf("");
#pragma unroll
        for (int ai = 0; ai < 2; ++ai)
#pragma unroll
            for (int m = 0; m < 4; ++m) { const int r = ai * HALF + wr * 64 + m * 16 + fr; const f32x2v sr = S[r]; const size_t off = (size_t)(u.pm * BM + r) * ldc + col0;
#pragma unroll
                for (int bj = 0; bj < 2; ++bj)
#pragma unroll
                    for (int n = 0; n < 2; ++n) { const f32x4 bs = ai == 0 ? pre[m][bj][n] : *(const f32x4*)(base + off + bj * HALF + n * 16); f32x4 o = bs + (acc[ai][bj][m][n] - sr.x) * sr.y;
                        if (bad) o = (f32x4){qnan, qnan, qnan, qnan}; *(f32x4*)(out + off + bj * HALF + n * 16) = o; }
                if (m & 1) asm volatile("" ::: "memory"); }
    }
};
struct EpiLnResLn {
    static constexpr bool PERM = false, AFTER_DRAIN = true;
    const float* base; float* out; bf16_t* xn; int ldc; const float* bias; PanelStats st1, st2; unsigned poison;
    __device__ __forceinline__ void fused(f32x4 (&acc)[2][2][4][2], const Unit& u, int wr, int wc, int fr, int fq, PG8_LAS unsigned char* lds, int wid, int lane) const {
        typedef float f32x2v __attribute__((ext_vector_type(2))); typedef unsigned u32x2v __attribute__((ext_vector_type(2)));
        const PG8_LAS f32x2v* S = (const PG8_LAS f32x2v*)(lds + 8192);
        const int col0 = u.pn * BM + wc * 32 + 4 * fq;
#pragma unroll
        for (int bj = 0; bj < 2; ++bj)
#pragma unroll
            for (int n = 0; n < 2; ++n) { const f32x4 bv = bias ? *(const f32x4*)(bias + col0 + bj * HALF + n * 16) : (f32x4){0.f, 0.f, 0.f, 0.f};
#pragma unroll
                for (int ai = 0; ai < 2; ++ai)
#pragma unroll
                    for (int m = 0; m < 4; ++m) acc[ai][bj][m][n] += bv; }
        bool bad = st1.run(acc, u, wr, wc, fr, fq, lds, wid, lane) || poison != 0u;
        const float qnan = __builtin_nanf("");
#pragma unroll
        for (int ai = 0; ai < 2; ++ai)
#pragma unroll
            for (int m = 0; m < 4; ++m) { const int r = ai * HALF + wr * 64 + m * 16 + fr; const f32x2v sr = S[r]; const size_t off = (size_t)(u.pm * BM + r) * ldc + col0;
#pragma unroll
                for (int bj = 0; bj < 2; ++bj)
#pragma unroll
                    for (int n = 0; n < 2; ++n) { const f32x4 bs = *(const f32x4*)(base + off + bj * HALF + n * 16); acc[ai][bj][m][n] = bs + (acc[ai][bj][m][n] - sr.x) * sr.y; }
                asm volatile("" : "+v"(acc[ai][0][m][0]), "+v"(acc[ai][0][m][1]), "+v"(acc[ai][1][m][0]), "+v"(acc[ai][1][m][1]));
                if (m & 1) asm volatile("" ::: "memory"); }
        const bool bad1 = bad;
        bad = st2.run(acc, u, wr, wc, fr, fq, lds, wid, lane) || bad;
#pragma unroll
        for (int ai = 0; ai < 2; ++ai)
#pragma unroll
            for (int m = 0; m < 4; ++m) { const int r = ai * HALF + wr * 64 + m * 16 + fr; const f32x2v sr = S[r]; const size_t off = (size_t)(u.pm * BM + r) * ldc + col0;
#pragma unroll
                for (int bj = 0; bj < 2; ++bj)
#pragma unroll
                    for (int n = 0; n < 2; ++n) { const f32x4 x1 = acc[ai][bj][m][n]; *(f32x4*)(out + off + bj * HALF + n * 16) = bad1 ? (f32x4){qnan, qnan, qnan, qnan} : x1;
                        const f32x4 o = (x1 - sr.x) * sr.y; u32x2v w; w.x = cvt_pk_bf16(o[0], o[1]); w.y = cvt_pk_bf16(o[2], o[3]);
                        if (bad) { w.x = 0x7fc07fc0u; w.y = 0x7fc07fc0u; } *(u32x2v*)(xn + off + bj * HALF + n * 16) = w; }
                asm volatile("" ::: "memory"); }
    }
};

template <class Epi, class Sched, bool ALIGN_EPI = false, bool SP2 = false>
__device__ __forceinline__ void gemm_phase(PG8_LAS unsigned char* lds, const Gemm g, const Sched& S, const Epi& E) {
    const int tid = threadIdx.x, wid = __builtin_amdgcn_readfirstlane(tid >> 6), lane = tid & 63, wr = wid >> 2, wc = wid & 3, fr = lane & 15, fq = lane >> 4;
    const int K = g.K, nt = K / BK;
    unsigned voffA[2], voffB[2];
#pragma unroll
    for (int i = 0; i < 2; ++i) { int R, C; stage_rc(tid * 16 + i * 8192, R, C); const int Rb = Epi::PERM ? ((R & ~31) + perm32(R & 31)) : R;
        voffA[i] = (unsigned)(R * K + C) * 2u; voffB[i] = (unsigned)(Rb * K + C) * 2u; }
    const size_t kstep = (size_t)(BK * 2);
    const size_t hstep = (size_t)HALF * K * 2;
    const size_t tstep = 2 * hstep;
    const unsigned ldsw = (unsigned)wid * 1024u;
    const int aoff = lds_byte(wr * 64 + fr, fq * 8), boff = lds_byte(wc * 32 + fr, fq * 8);
#define PG8_SA(b, h) (((b) * 2 + (h)) * HTB)
#define PG8_SB(b, h) ((4 + (b) * 2 + (h)) * HTB)
#define PG8_STAGE(bufoff, gbase, voff) do { _Pragma("unroll") for (int _i = 0; _i < 2; ++_i) \
        __builtin_amdgcn_global_load_lds((const unsigned*)((const char*)(gbase) + (voff)[_i]), (PG8_LAS unsigned*)(lds + (bufoff) + ldsw + _i * 8192), 16, 0, 0); } while (0)
#define PG8_LDA(dst, b, h) do { _Pragma("unroll") for (int m = 0; m < 4; ++m) _Pragma("unroll") for (int k = 0; k < 2; ++k) dst[m][k] = *(const PG8_LAS bf16x8*)(lds + PG8_SA(b, h) + aoff + m * 2048 + k * 1024); } while (0)
#define PG8_LDB(dst, b, h) do { _Pragma("unroll") for (int n = 0; n < 2; ++n) _Pragma("unroll") for (int k = 0; k < 2; ++k) dst[n][k] = *(const PG8_LAS bf16x8*)(lds + PG8_SB(b, h) + boff + n * 2048 + k * 1024); } while (0)
#define PG8_MMA(ai, bj, At, Bt) do { __builtin_amdgcn_s_setprio(1); _Pragma("unroll") for (int m = 0; m < 4; ++m) _Pragma("unroll") for (int n = 0; n < 2; ++n) _Pragma("unroll") for (int k = 0; k < 2; ++k) \
        acc[ai][bj][m][n] = __builtin_amdgcn_mfma_f32_16x16x32_bf16(Bt[n][k], At[m][k], acc[ai][bj][m][n], 0, 0, 0); __builtin_amdgcn_s_setprio(0); } while (0)
#define PG8_WAIT_V(n) asm volatile("s_waitcnt vmcnt(" #n ")" ::: "memory")
#define PG8_WAIT_L(n) asm volatile("s_waitcnt lgkmcnt(" #n ")" ::: "memory")
#define PG8_BAR __builtin_amdgcn_s_barrier()
#define PG8_SCHED __builtin_amdgcn_sched_barrier(0)
    Unit cur, nxt; int ui = 0;
    if (!S.next(0, cur)) return;
    f32x4 acc[2][2][4][2];
#pragma unroll
    for (int a = 0; a < 2; ++a)
#pragma unroll
        for (int b = 0; b < 2; ++b)
#pragma unroll
            for (int m = 0; m < 4; ++m)
#pragma unroll
                for (int n = 0; n < 2; ++n) acc[a][b][m][n] = (f32x4){0.f, 0.f, 0.f, 0.f};
    bf16x8 At[4][2], B0[2][2], B1[2][2];
    const char* cA = (const char*)g.A + (size_t)cur.pm * tstep; const char* cB = (const char*)g.Bt + (size_t)cur.pn * tstep;
    S.a_ready(cur);
    if constexpr (SP2) {
        PG8_STAGE(PG8_SB(0, 0), cB, voffB); PG8_STAGE(PG8_SB(0, 1), cB + hstep, voffB); PG8_STAGE(PG8_SA(0, 0), cA, voffA); PG8_STAGE(PG8_SA(0, 1), cA + hstep, voffA);
        if (wr == 1) PG8_BAR;
        PG8_WAIT_V(2); PG8_BAR;
        PG8_STAGE(PG8_SB(1, 0), cB + kstep, voffB); PG8_STAGE(PG8_SA(1, 0), cA + kstep, voffA); PG8_STAGE(PG8_SB(1, 1), cB + hstep + kstep, voffB);
        PG8_WAIT_V(6); PG8_BAR;
    } else {
        PG8_STAGE(PG8_SB(0, 0), cB, voffB); PG8_STAGE(PG8_SA(0, 0), cA, voffA); PG8_STAGE(PG8_SB(0, 1), cB + hstep, voffB); PG8_STAGE(PG8_SA(0, 1), cA + hstep, voffA);
        if (wr == 1) PG8_BAR;
        PG8_WAIT_V(4); PG8_BAR;
        PG8_STAGE(PG8_SB(1, 0), cB + kstep, voffB); PG8_STAGE(PG8_SA(1, 0), cA + kstep, voffA); PG8_STAGE(PG8_SB(1, 1), cB + hstep + kstep, voffB);
        PG8_WAIT_V(6); PG8_BAR;
    }
    for (;;) {
        const bool has_next = S.next(ui + 1, nxt);
        const char* nA = has_next ? (const char*)g.A + (size_t)nxt.pm * tstep : cA; const char* nB = has_next ? (const char*)g.Bt + (size_t)nxt.pn * tstep : cB;
        for (int t = 0; t < nt; t += 2) {
            const bool last = (t == nt - 2);
            const char* a1 = cA + (size_t)(t + 1) * kstep;
            const char* a2 = last ? nA : cA + (size_t)(t + 2) * kstep; const char* b2 = last ? nB : cB + (size_t)(t + 2) * kstep;
            const char* a3 = a2 + kstep; const char* b3 = b2 + kstep;
            if (last && has_next) S.a_ready(nxt);
            if constexpr (SP2) {
            PG8_LDB(B0, 0, 0); PG8_LDB(B1, 0, 1); PG8_SCHED; PG8_LDA(At, 0, 0); PG8_STAGE(PG8_SA(1, 1), a1 + hstep, voffA);
            PG8_WAIT_V(8); PG8_WAIT_L(0); PG8_BAR; PG8_MMA(0, 0, At, B0); PG8_MMA(0, 1, At, B1); PG8_BAR; PG8_SCHED;
            PG8_LDA(At, 0, 1); PG8_STAGE(PG8_SB(0, 0), b2, voffB); PG8_STAGE(PG8_SB(0, 1), b2 + hstep, voffB); PG8_STAGE(PG8_SA(0, 0), a2, voffA);
            PG8_WAIT_V(8); PG8_WAIT_L(0); PG8_BAR; PG8_MMA(1, 0, At, B0); PG8_MMA(1, 1, At, B1); PG8_BAR; PG8_SCHED;
            PG8_LDB(B0, 1, 0); PG8_LDB(B1, 1, 1); PG8_SCHED; PG8_LDA(At, 1, 0); PG8_STAGE(PG8_SA(0, 1), a2 + hstep, voffA);
            PG8_WAIT_V(8); PG8_WAIT_L(0); PG8_BAR; PG8_MMA(0, 0, At, B0); PG8_MMA(0, 1, At, B1); PG8_BAR; PG8_SCHED;
            PG8_LDA(At, 1, 1); PG8_STAGE(PG8_SB(1, 0), b3, voffB); PG8_STAGE(PG8_SB(1, 1), b3 + hstep, voffB); PG8_STAGE(PG8_SA(1, 0), a3, voffA);
            PG8_WAIT_V(8); PG8_WAIT_L(0); PG8_BAR; PG8_MMA(1, 0, At, B0); PG8_MMA(1, 1, At, B1); PG8_BAR; PG8_SCHED;
            } else {
            PG8_LDB(B0, 0, 0); PG8_SCHED; PG8_LDA(At, 0, 0); PG8_STAGE(PG8_SA(1, 1), a1 + hstep, voffA);
            PG8_WAIT_L(8); PG8_BAR; PG8_WAIT_L(0); PG8_MMA(0, 0, At, B0); PG8_BAR; PG8_SCHED;
            PG8_LDB(B1, 0, 1); PG8_STAGE(PG8_SB(0, 0), b2, voffB);
            PG8_BAR; PG8_WAIT_L(0); PG8_MMA(0, 1, At, B1); PG8_BAR;
            PG8_LDA(At, 0, 1); PG8_STAGE(PG8_SA(0, 0), a2, voffA);
            PG8_BAR; PG8_WAIT_L(0); PG8_MMA(1, 0, At, B0); PG8_BAR; PG8_SCHED;
            PG8_STAGE(PG8_SB(0, 1), b2 + hstep, voffB);
            PG8_WAIT_V(6); PG8_BAR; PG8_MMA(1, 1, At, B1); PG8_BAR;
            PG8_LDB(B0, 1, 0); PG8_SCHED; PG8_LDA(At, 1, 0); PG8_STAGE(PG8_SA(0, 1), a2 + hstep, voffA);
            PG8_WAIT_L(8); PG8_BAR; PG8_WAIT_L(0); PG8_MMA(0, 0, At, B0); PG8_BAR; PG8_SCHED;
            PG8_LDB(B1, 1, 1); PG8_STAGE(PG8_SB(1, 0), b3, voffB);
            PG8_BAR; PG8_WAIT_L(0); PG8_MMA(0, 1, At, B1); PG8_BAR;
            PG8_LDA(At, 1, 1); PG8_STAGE(PG8_SA(1, 0), a3, voffA);
            PG8_BAR; PG8_WAIT_L(0); PG8_MMA(1, 0, At, B0); PG8_BAR; PG8_SCHED;
            PG8_STAGE(PG8_SB(1, 1), b3 + hstep, voffB);
            PG8_WAIT_V(6); PG8_BAR; PG8_MMA(1, 1, At, B1); PG8_BAR;
            }
        }
        if constexpr (ALIGN_EPI) { if (wr == 0) PG8_BAR; }
        if constexpr (!Epi::AFTER_DRAIN) { E(acc, cur, wr, wc, fr, fq); S.done(cur); }
        if (!has_next) break;
#pragma unroll
        for (int a = 0; a < 2; ++a)
#pragma unroll
            for (int b = 0; b < 2; ++b)
#pragma unroll
                for (int m = 0; m < 4; ++m)
#pragma unroll
                    for (int n = 0; n < 2; ++n) acc[a][b][m][n] = (f32x4){0.f, 0.f, 0.f, 0.f};
        cur = nxt; cA = nA; cB = nB; ++ui;
        if constexpr (ALIGN_EPI) { if (wr == 1) PG8_BAR; }
    }
    PG8_WAIT_V(0);
    if constexpr (!ALIGN_EPI) { if (wr == 0) PG8_BAR; }
    PG8_BAR;
    if constexpr (Epi::AFTER_DRAIN) { E.fused(acc, cur, wr, wc, fr, fq, lds, wid, lane); S.done(cur); }
#undef PG8_SA
#undef PG8_SB
#undef PG8_STAGE
#undef PG8_LDA
#undef PG8_LDB
#undef PG8_MMA
#undef PG8_WAIT_V
#undef PG8_WAIT_L
#undef PG8_BAR
#undef PG8_SCHED
}
}

namespace pg8 {
struct EpiStore {
    static constexpr bool PERM = true, AFTER_DRAIN = false;
    bf16_t* O; int ldc; int n_lo; float sc_lo; int pn_one; float sc_one;
    __device__ __forceinline__ void operator()(const f32x4 (&acc)[2][2][4][2], const Unit& u, int wr, int wc, int fr, int fq) const {
        const int row0 = u.pm * BM + wr * 64 + fr; const int col0 = u.pn * BM + wc * 32 + 8 * fq;
        const float sc = (u.pn < n_lo) ? sc_lo : ((u.pn == pn_one) ? sc_one : 1.0f);
#pragma unroll
        for (int ai = 0; ai < 2; ++ai)
#pragma unroll
            for (int m = 0; m < 4; ++m) { bf16_t* rowp = O + (size_t)(row0 + ai * HALF + m * 16) * ldc + col0;
#pragma unroll
                for (int bj = 0; bj < 2; ++bj) { f32x4 v0 = acc[ai][bj][m][0] * sc, v1 = acc[ai][bj][m][1] * sc;
                    u32x4 w; w.x = cvt_pk_bf16(v0[0], v0[1]); w.y = cvt_pk_bf16(v0[2], v0[3]); w.z = cvt_pk_bf16(v1[0], v1[1]); w.w = cvt_pk_bf16(v1[2], v1[3]);
                    *(u32x4*)(rowp + bj * HALF) = w; } }
    }
};

__device__ __forceinline__ float dpp_ror1(float v) { return __builtin_bit_cast(float, __builtin_amdgcn_update_dpp(0, __builtin_bit_cast(int, v), 0x121, 0xf, 0xf, false)); }
__device__ __forceinline__ float dpp_ror2(float v) { return __builtin_bit_cast(float, __builtin_amdgcn_update_dpp(0, __builtin_bit_cast(int, v), 0x122, 0xf, 0xf, false)); }
__device__ __forceinline__ float gelu_tanh_f(float x) {
    const float A = -2.302208198f, Bc = -0.1029432397f;
    const float t = x * (A + Bc * x * x);
    return x * __builtin_amdgcn_rcpf(1.0f + __builtin_amdgcn_exp2f(t));
}
struct EpiConvAct {
    static constexpr bool PERM = true, AFTER_DRAIN = false;
    bf16_t* act; float* ub; const float* cw; const float* cb;
    __device__ __forceinline__ void operator()(const f32x4 (&acc)[2][2][4][2], const Unit& u, int wr, int wc, int fr, int fq) const {
        constexpr int FFc = 2816, FF2c = 5632;
#pragma unroll
        for (int n = 0; n < 2; ++n) {
            const int j = u.pn * 128 + wc * 32 + 8 * fq + 4 * n;
            const f32x4 w0g = *(const f32x4*)(cw + j), w1g = *(const f32x4*)(cw + FF2c + j), w2g = *(const f32x4*)(cw + 2 * FF2c + j), bg = *(const f32x4*)(cb + j);
            const f32x4 w0u = *(const f32x4*)(cw + FFc + j), w1u = *(const f32x4*)(cw + FF2c + FFc + j), w2u = *(const f32x4*)(cw + 2 * FF2c + FFc + j), bu = *(const f32x4*)(cb + FFc + j);
#pragma unroll
            for (int ai = 0; ai < 2; ++ai) {
                const int g = u.pm * 4 + ai * 2 + wr;
                f32x4 qg1 = {0.f, 0.f, 0.f, 0.f}, qg2 = qg1, qu1 = qg1, qu2 = qg1;
#pragma unroll
                for (int m = 0; m < 4; ++m) {
                    const f32x4 ug = acc[ai][0][m][n], uu = acc[ai][1][m][n];
                    f32x4 ag1, ag2, au1, au2;
#pragma unroll
                    for (int k = 0; k < 4; ++k) { ag1[k] = dpp_ror1(ug[k]); ag2[k] = dpp_ror2(ug[k]); au1[k] = dpp_ror1(uu[k]); au2[k] = dpp_ror2(uu[k]); }
                    f32x4 pg1, pg2, pu1, pu2;
#pragma unroll
                    for (int k = 0; k < 4; ++k) { pg1[k] = (fr >= 1) ? ag1[k] : qg1[k]; pg2[k] = (fr >= 2) ? ag2[k] : qg2[k]; pu1[k] = (fr >= 1) ? au1[k] : qu1[k]; pu2[k] = (fr >= 2) ? au2[k] : qu2[k]; }
                    qg1 = ag1; qg2 = ag2; qu1 = au1; qu2 = au2;
                    const f32x4 yg = bg + w2g * ug + w1g * pg1 + w0g * pg2;
                    const f32x4 yu = bu + w2u * uu + w1u * pu1 + w0u * pu2;
                    float a0 = gelu_tanh_f(yg[0]) * yu[0], a1 = gelu_tanh_f(yg[1]) * yu[1], a2 = gelu_tanh_f(yg[2]) * yu[2], a3 = gelu_tanh_f(yg[3]) * yu[3];
                    const int row = u.pm * BM + ai * HALF + wr * 64 + m * 16 + fr;
                    typedef unsigned u32x2 __attribute__((ext_vector_type(2)));
                    u32x2 w; w.x = cvt_pk_bf16(a0, a1); w.y = cvt_pk_bf16(a2, a3);
                    if (!(m == 0 && fr < 2)) *(u32x2*)(act + (size_t)row * FFc + j) = w;
                    if (m == 0 && fr < 2) { float* p = ub + ((size_t)(g * 4 + 2 + fr) * 2) * FFc + j; *(f32x4*)p = ug; *(f32x4*)(p + FFc) = uu; }
                    if (m == 3 && fr >= 14) { float* p = ub + ((size_t)(g * 4 + (fr - 14)) * 2) * FFc + j; *(f32x4*)p = ug; *(f32x4*)(p + FFc) = uu; }
                }
            }
        }
    }
};
}
#define GAS __attribute__((address_space(1)))
#define LAS __attribute__((address_space(3)))
typedef unsigned short bf16;
typedef unsigned v4u __attribute__((ext_vector_type(4)));
typedef float f32x4 __attribute__((ext_vector_type(4)));
typedef short bf16x8 __attribute__((ext_vector_type(8)));
typedef GAS unsigned gu32;
typedef GAS unsigned long long gu64;
#define RLX_AGENT __ATOMIC_RELAXED, __HIP_MEMORY_SCOPE_AGENT
#define LDS_WAIT() asm volatile("s_waitcnt lgkmcnt(0)" ::: "memory")
#define VM_WAIT() asm volatile("s_waitcnt vmcnt(0)" ::: "memory")
__device__ __forceinline__ unsigned long long rt() { return __builtin_amdgcn_s_memrealtime(); }
__device__ __forceinline__ unsigned f2bf(float f) { unsigned u = __builtin_bit_cast(unsigned, f); return (u + 0x7fffu + ((u >> 16) & 1u)) >> 16; }
__device__ __forceinline__ unsigned pk2(float lo, float hi) { return f2bf(lo) | (f2bf(hi) << 16); }

#define XB_TMO      128
#define XB_XCNT(j)  (256  + 64 * (j))
#define XB_XSUB(j)  (1280 + 64 * (j))
#define XB_XGEN(j)  (2304 + 64 * (j))
#define XB_TOP      3328
#define XB_TOPGEN   3392
#define XCD_BAR_WORDS 3456
#define XB_SPIN_CAP (1u << 18)

__device__ __forceinline__ unsigned xb_ld(unsigned* p)              { return __hip_atomic_load(p, __ATOMIC_RELAXED, __HIP_MEMORY_SCOPE_AGENT); }
__device__ __forceinline__ unsigned xb_add(unsigned* p, unsigned v) { return __hip_atomic_fetch_add(p, v, __ATOMIC_RELAXED, __HIP_MEMORY_SCOPE_AGENT); }
__device__ __forceinline__ unsigned xb_xcc_id() { return (unsigned)__builtin_amdgcn_s_getreg((3 << 11) | 20) & 0xFu; }
#define XB_SPIN(cond, bar) do { unsigned _sp = 0; while (cond) { __builtin_amdgcn_s_sleep(1); \
    if ((++_sp & 255u) == 0u) { if (xb_ld(&(bar)[XB_TMO])) break; if (_sp > XB_SPIN_CAP) { atomicAdd(&(bar)[XB_TMO], 1u); break; } } } } while (0)

struct XcdBarrier {
    unsigned* bar; unsigned x;
    volatile LAS unsigned* st;
};

__device__ __forceinline__ XcdBarrier xcd_barrier_post(unsigned* bar, volatile LAS unsigned* st) {
    XcdBarrier b; b.bar = bar; b.x = xb_xcc_id(); b.st = st;
    if (threadIdx.x == 0) (void)xb_add(&bar[XB_XCNT(b.x)], 1u);
    return b;
}
__device__ __forceinline__ void xcd_barrier_complete(unsigned* bar, unsigned x, unsigned& nloc, unsigned& nx) {
    const unsigned G = gridDim.x * gridDim.y * gridDim.z;
    unsigned sum, cnt, mine, sp = 0u;
    for (;;) {
        sum = 0u; cnt = 0u; mine = 0u;
#pragma unroll
        for (unsigned j = 0; j < 16; ++j) { const unsigned c = xb_ld(&bar[XB_XCNT(j)]); sum += c; cnt += (c > 0u) ? 1u : 0u; mine = (j == x) ? c : mine; }
        if (sum == G) break;
        __builtin_amdgcn_s_sleep(1);
        if ((++sp & 255u) == 0u) { if (xb_ld(&bar[XB_TMO])) break; if (sp > XB_SPIN_CAP) { atomicAdd(&bar[XB_TMO], 1u); break; } }
    }
    nloc = mine > 0u ? mine : 1u; nx = cnt > 0u ? cnt : 1u;
}

__device__ __forceinline__ void xcd_barrier(const XcdBarrier& b) {
    asm volatile("s_waitcnt vmcnt(0)" ::: "memory");
    __syncthreads();
    if (threadIdx.x == 0) {
        unsigned* bar = b.bar;
        __builtin_amdgcn_s_waitcnt(0);
        unsigned nloc = b.st[0], nx = b.st[1];
        if (nloc == 0u) { xcd_barrier_complete(bar, b.x, nloc, nx); b.st[0] = nloc; b.st[1] = nx; }
        const unsigned old = xb_add(&bar[XB_XSUB(b.x)], 1u);
        const unsigned gen = old / nloc;
        if (old + 1u == (gen + 1u) * nloc) {
            __builtin_amdgcn_fence(__ATOMIC_RELEASE, "agent");
            asm volatile("s_waitcnt vmcnt(0)" ::: "memory");
            const unsigned og = xb_add(&bar[XB_TOP], 1u);
            const unsigned tg = og / nx;
            if (og + 1u == (tg + 1u) * nx) xb_add(&bar[XB_TOPGEN], 1u);
            else XB_SPIN(xb_ld(&bar[XB_TOPGEN]) == tg, bar);
            __builtin_amdgcn_fence(__ATOMIC_ACQUIRE, "agent");
            xb_add(&bar[XB_XGEN(b.x)], 1u);
            asm volatile("s_waitcnt vmcnt(0)" ::: "memory");
        } else {
            XB_SPIN(xb_ld(&bar[XB_XGEN(b.x)]) == gen, bar);
            __builtin_amdgcn_fence(__ATOMIC_ACQUIRE, "agent");
            asm volatile("s_waitcnt vmcnt(0)" ::: "memory");
        }
    }
    __syncthreads();
}

constexpr int NWAVES = 8, NTHR = 512;
#ifndef MK_N_LAUNCHES
#define MK_N_LAUNCHES 1
#endif
constexpr int N_PHASES = 11;
constexpr int BATCH = 4, SEQ = 8192, DM = 1024, M = BATCH * SEQ, INW = 3072, FF = 2816, FF2 = 5632;
constexpr float NORM_EPS = 1e-6f;
constexpr float QSCALE = 0.125f * 1.4426950408889634f;
constexpr size_t MiB = 1u << 20;
constexpr size_t WS_CTL = 0, CTL_ZERO_BYTES = 1 * MiB;
constexpr size_t WS_ROPE = 1 * MiB;
constexpr size_t WS_WIN = 4 * MiB, WS_WOUT = 10 * MiB, WS_WUP = 12 * MiB, WS_WDN = 23 * MiB;
constexpr size_t WS_XN = 32 * MiB;
constexpr size_t WS_PROJ = 96 * MiB;
constexpr size_t WS_ACT = 96 * MiB;
constexpr size_t WS_OPART = 288 * MiB;
constexpr size_t WS_LSE = 384 * MiB;
constexpr size_t WS_MIX = 288 * MiB;
constexpr size_t WS_FFN = 352 * MiB;
constexpr size_t WS_MIXED = 416 * MiB;
constexpr size_t WS_UB = 416 * MiB;
constexpr size_t WS_KV = 480 * MiB;
constexpr size_t WS_END = 512 * MiB;
constexpr int CW_TMO = 0, CW_BAR = 4096;
constexpr int RING_OFF = 0, RING_BYTES = 133120;
constexpr int LDSCTL_OFF = RING_BYTES, MISC_OFF = LDSCTL_OFF + 320;
constexpr int LDS_BYTES = 147456;
static_assert(MISC_OFF + 128 <= LDS_BYTES, "LDS map");

__device__ const float ROPE_F[32] = {1.000000000e+00f, 7.498942018e-01f, 5.623413324e-01f, 4.216965139e-01f, 3.162277639e-01f, 2.371373773e-01f, 1.778279394e-01f, 1.333521456e-01f, 1.000000015e-01f, 7.498942316e-02f, 5.623413250e-02f, 4.216964915e-02f, 3.162277490e-02f, 2.371373773e-02f, 1.778279431e-02f, 1.333521400e-02f, 9.999999776e-03f, 7.498942316e-03f, 5.623413250e-03f, 4.216964822e-03f, 3.162277630e-03f, 2.371373819e-03f, 1.778279431e-03f, 1.333521446e-03f, 1.000000047e-03f, 7.498941850e-04f, 5.623413017e-04f, 4.216965172e-04f, 3.162277571e-04f, 2.371373703e-04f, 1.778279402e-04f, 1.333521504e-04f};

typedef float f32x16 __attribute__((ext_vector_type(16)));
typedef short s16x4 __attribute__((ext_vector_type(4)));
typedef unsigned u32x2 __attribute__((ext_vector_type(2)));
typedef float f32x2v __attribute__((ext_vector_type(2)));
typedef __bf16 bf16x2_t __attribute__((ext_vector_type(2)));
__device__ __forceinline__ unsigned cvtpk(float lo, float hi) { f32x2v v = {lo, hi}; bf16x2_t b = __builtin_convertvector(v, bf16x2_t); return __builtin_bit_cast(unsigned, b); }
__device__ __forceinline__ float bf_lo(unsigned w) { return __builtin_bit_cast(float, w << 16); }
__device__ __forceinline__ float bf_hi(unsigned w) { return __builtin_bit_cast(float, w & 0xffff0000u); }
__device__ __forceinline__ int crow(int r, int hi) { return (r & 3) + 8 * (r >> 2) + 4 * hi; }
__device__ __forceinline__ s16x4 tr16(const LAS unsigned char* p) { typedef short v4i16_t __attribute__((ext_vector_type(4))); return __builtin_bit_cast(s16x4, __builtin_amdgcn_ds_read_tr16_b64_v4i16((LAS v4i16_t*)p)); }
__device__ __forceinline__ bf16x8 mk8(s16x4 a, s16x4 b) { return (bf16x8){a[0], a[1], a[2], a[3], b[0], b[1], b[2], b[3]}; }
__device__ __forceinline__ float wave_sum(float v) {
#pragma unroll
    for (int o = 1; o < 64; o <<= 1) v += __shfl_xor(v, o);
    return v;
}
__device__ __forceinline__ float lg2gamma(int h) { return log2f(1.0f - exp2f(-5.0f - (float)h)); }

struct Frame {
    LAS unsigned char* lds;
    volatile LAS unsigned* MISC;
    gu32* ctl;
    int tid, lane, wave, vcu, G;
    const float *x, *g_pre, *g_post, *w_in, *w_out, *g_fpre, *g_fpost, *w_up, *conv_w, *conv_b, *w_down;
    float* out;
    bf16 *Win_t, *Wout_t, *Wup_t, *Wdn_t, *XN, *PROJ, *ACT, *OPART, *MIX, *FFN, *MIXED;
    float *LSE, *UB, *KV; f32x2v* ROPE;
};

__device__ __forceinline__ void p0_transpose_item(const float* W, int K, int N, bf16* WT, int row_off, LAS float* scr, int kb, int nb, int lane) {
    const int k0 = 64 * kb, n0 = 32 * nb;
#pragma unroll 8
    for (int i = 0; i < 32; ++i) { const int kk = 2 * i + (lane >> 5); scr[kk * 33 + (lane & 31)] = W[(size_t)(k0 + kk) * N + n0 + (lane & 31)]; }
    LDS_WAIT(); asm volatile("" ::: "memory");
    const int c = lane & 7;
#pragma unroll
    for (int j = 0; j < 4; ++j) { const int n = (lane >> 3) + 8 * j; const LAS float* s = scr + (8 * c) * 33 + n;
        v4u o; o.x = cvtpk(s[0 * 33], s[1 * 33]); o.y = cvtpk(s[2 * 33], s[3 * 33]); o.z = cvtpk(s[4 * 33], s[5 * 33]); o.w = cvtpk(s[6 * 33], s[7 * 33]);
        *(GAS v4u*)(WT + (size_t)(row_off + n0 + n) * K + k0 + 8 * c) = o; }
    LDS_WAIT(); asm volatile("" ::: "memory");
}
__device__ __forceinline__ void rms_row_to_bf16(const float* xrow, const float* gain, bf16* orow, int lane) {
    const GAS f32x4* xr = (const GAS f32x4*)xrow + lane; const GAS f32x4* gr = (const GAS f32x4*)gain + lane;
    f32x4 v[4]; float s = 0.f;
#pragma unroll
    for (int j = 0; j < 4; ++j) { v[j] = xr[64 * j]; s += (v[j].x * v[j].x + v[j].y * v[j].y) + (v[j].z * v[j].z + v[j].w * v[j].w); }
    const float rstd = 1.f / sqrtf(wave_sum(s) * (1.f / DM) + NORM_EPS);
    GAS unsigned long long* o8 = (GAS unsigned long long*)orow + lane;
#pragma unroll
    for (int j = 0; j < 4; ++j) { const f32x4 g = gr[64 * j];
        o8[64 * j] = (unsigned long long)cvtpk(v[j].x * rstd * g.x, v[j].y * rstd * g.y) | ((unsigned long long)cvtpk(v[j].z * rstd * g.z, v[j].w * rstd * g.w) << 32); }
}
__device__ __forceinline__ void rms_rows4_to_bf16(const float* xrow, const float* gain, bf16* orow, int lane) {
    const GAS f32x4* gr = (const GAS f32x4*)gain + lane;
    f32x4 v[4][4]; float s[4];
#pragma unroll
    for (int r = 0; r < 4; ++r) { const GAS f32x4* xr = (const GAS f32x4*)(xrow + (size_t)r * DM) + lane;
#pragma unroll
        for (int j = 0; j < 4; ++j) v[r][j] = xr[64 * j]; }
#pragma unroll
    for (int r = 0; r < 4; ++r) { s[r] = 0.f;
#pragma unroll
        for (int j = 0; j < 4; ++j) s[r] += (v[r][j].x * v[r][j].x + v[r][j].y * v[r][j].y) + (v[r][j].z * v[r][j].z + v[r][j].w * v[r][j].w); }
#pragma unroll
    for (int o = 1; o < 64; o <<= 1) {
#pragma unroll
        for (int r = 0; r < 4; ++r) s[r] += __shfl_xor(s[r], o); }
#pragma unroll
    for (int r = 0; r < 4; ++r) { const float rstd = 1.f / sqrtf(s[r] * (1.f / DM) + NORM_EPS); GAS unsigned long long* o8 = (GAS unsigned long long*)(orow + (size_t)r * DM) + lane;
#pragma unroll
        for (int j = 0; j < 4; ++j) { const f32x4 g = gr[64 * j];
            o8[64 * j] = (unsigned long long)cvtpk(v[r][j].x * rstd * g.x, v[r][j].y * rstd * g.y) | ((unsigned long long)cvtpk(v[r][j].z * rstd * g.z, v[r][j].w * rstd * g.w) << 32); } }
}
__device__ __forceinline__ void p0_prep(Frame& F) {
    LAS float* scr = (LAS float*)(F.lds + RING_OFF + F.wave * 16384);
    const int gw = F.vcu * NWAVES + F.wave, NGW = F.G * NWAVES;
    constexpr int I_IN = (DM / 64) * (INW / 32), I_OUT = (DM / 64) * (DM / 32), I_UP = (DM / 64) * (FF2 / 32), I_DN = (FF / 64) * (DM / 32);
    constexpr int NITEMS = I_IN + I_OUT + I_UP + I_DN;
    for (int it = gw; it < NITEMS; it += NGW) {
        int r = it;
        if (r < I_IN) { const int nblk = INW / 32; p0_transpose_item(F.w_in, DM, INW, F.Win_t, 0, scr, r / nblk, r % nblk, F.lane); continue; } r -= I_IN;
        if (r < I_OUT) { const int nblk = DM / 32; p0_transpose_item(F.w_out, DM, DM, F.Wout_t, 0, scr, r / nblk, r % nblk, F.lane); continue; } r -= I_OUT;
        if (r < I_UP) { const int nblk = FF2 / 32; const int kb = r / nblk, nb = r % nblk; const int n0 = 32 * nb;
            const int dest = (n0 < FF) ? ((n0 / 128) * 256 + (n0 % 128)) : (((n0 - FF) / 128) * 256 + 128 + ((n0 - FF) % 128));
            p0_transpose_item(F.w_up, DM, FF2, F.Wup_t, dest - n0, scr, kb, nb, F.lane); continue; } r -= I_UP;
        { const int nblk = DM / 32; p0_transpose_item(F.w_down, FF, DM, F.Wdn_t, 0, scr, r / nblk, r % nblk, F.lane); }
    }
    for (int m = gw * 4; m < M; m += NGW * 4) rms_rows4_to_bf16(F.x + (size_t)m * DM, F.g_pre, F.XN + (size_t)m * DM, F.lane);
    for (int idx = F.vcu * NTHR + F.tid; idx < SEQ * 32; idx += F.G * NTHR) { const int t = idx >> 5, i = idx & 31; const float ang = (float)t * ROPE_F[i]; F.ROPE[idx] = (f32x2v){cosf(ang), sinf(ang)}; }
}

namespace att {
constexpr int NKEY = 384, K_OFF = 0, K_BYTES = NKEY * 128, V_OFF = K_BYTES, VHALF = NKEY * 64, V_BYTES = 2 * VHALF, SCR_OFF = V_OFF + V_BYTES, OST_OFF = SCR_OFF + 8 * 256, END = OST_OFF + 8 * 4096;
static_assert(END <= RING_BYTES, "attention LDS");
}
__device__ __forceinline__ void attn_unit(Frame& F, int u) {
    using namespace att;
    const int tid = F.tid, lane = F.lane, w = F.wave, r32 = lane & 31, hi = lane >> 5;
    const int p = u >> 10, rem = u & 1023, bh = rem >> 5, xx = rem & 31, b = bh >> 3, h = bh & 7;
    const int dsh = (p == 0) ? 4 : ((p == 1) ? 2 : 0), d = 1 << dsh;
    const int nsb = 32 >> dsh, r = xx / nsb, sb = xx % nsb;
    LAS unsigned char* lds = F.lds + RING_OFF;
    const bf16* Pb = F.PROJ + (size_t)b * SEQ * INW;
    __syncthreads();
    {
        v4u kreg[6], vreg[6];
#pragma unroll
        for (int it = 0; it < 6; ++it) { const int idx = tid + NTHR * it, kk = idx >> 3, c = idx & 7; int sp = 256 * sb - 128 + kk; sp = sp < 0 ? 0 : sp;
            const bf16* src = Pb + (size_t)((sp << dsh) + r) * INW + h * 64 + c * 8;
            kreg[it] = *(const GAS v4u*)(src + 512); vreg[it] = *(const GAS v4u*)(src + 1024); }
#pragma unroll
        for (int it = 0; it < 6; ++it) { const int idx = tid + NTHR * it, kk = idx >> 3, c = idx & 7;
            *(LAS v4u*)(lds + K_OFF + kk * 128 + ((c ^ ((kk >> 1) & 7)) << 4)) = kreg[it];
            *(LAS v4u*)(lds + V_OFF + (c >> 2) * VHALF + kk * 64 + (c & 3) * 16) = vreg[it]; }
    }
    const int ql = 32 * w + r32;
    const size_t qtok = (size_t)(((256 * sb + ql) << dsh) + r);
    bf16x8 qr[4];
#pragma unroll
    for (int d0 = 0; d0 < 4; ++d0) qr[d0] = *(const GAS bf16x8*)(Pb + qtok * INW + h * 64 + d0 * 16 + hi * 8);
    __syncthreads();
    f32x16 pt[5];
#pragma unroll
    for (int j = 0; j < 5; ++j) {
        pt[j] = (f32x16){0.f, 0.f, 0.f, 0.f, 0.f, 0.f, 0.f, 0.f, 0.f, 0.f, 0.f, 0.f, 0.f, 0.f, 0.f, 0.f};
        const int row = 32 * (w + j) + r32;
#pragma unroll
        for (int d0 = 0; d0 < 4; ++d0) { const bf16x8 kf = *(const LAS bf16x8*)(lds + K_OFF + row * 128 + (((2 * d0 + hi) ^ ((row >> 1) & 7)) << 4));
            pt[j] = __builtin_amdgcn_mfma_f32_32x32x16_bf16(kf, qr[d0], pt[j], 0, 0, 0); }
    }
    const float NEG = -1e30f;
#pragma unroll
    for (int rr = 0; rr < 16; ++rr) { const int kr = crow(rr, hi); if (kr < r32) pt[0][rr] = NEG; if (kr > r32) pt[4][rr] = NEG; }
    if (sb == 0) {
#pragma unroll
        for (int j = 0; j < 4; ++j) if (w + j < 4) {
#pragma unroll
            for (int rr = 0; rr < 16; ++rr) pt[j][rr] = NEG; }
    }
    float mx = NEG;
#pragma unroll
    for (int j = 0; j < 5; ++j)
#pragma unroll
        for (int rr = 0; rr < 16; ++rr) mx = fmaxf(mx, pt[j][rr]);
    mx = fmaxf(mx, __shfl_xor(mx, 32));
    float ls = 0.f;
#pragma unroll
    for (int j = 0; j < 5; ++j)
#pragma unroll
        for (int rr = 0; rr < 16; ++rr) { const float e = __builtin_amdgcn_exp2f(pt[j][rr] - mx); pt[j][rr] = e; ls += e; }
    ls += __shfl_xor(ls, 32);
    f32x16 o[2];
    o[0] = (f32x16){0.f, 0.f, 0.f, 0.f, 0.f, 0.f, 0.f, 0.f, 0.f, 0.f, 0.f, 0.f, 0.f, 0.f, 0.f, 0.f}; o[1] = o[0];
    const LAS unsigned char* vb = lds + V_OFF + ((lane >> 4) & 1) * 32 + (lane & 3) * 8 + (4 * hi + ((lane & 15) >> 2)) * 64;
#pragma unroll
    for (int j = 0; j < 5; ++j)
#pragma unroll
        for (int s = 0; s < 2; ++s) {
            v4u pw; pw.x = cvtpk(pt[j][8 * s + 0], pt[j][8 * s + 1]); pw.y = cvtpk(pt[j][8 * s + 2], pt[j][8 * s + 3]); pw.z = cvtpk(pt[j][8 * s + 4], pt[j][8 * s + 5]); pw.w = cvtpk(pt[j][8 * s + 6], pt[j][8 * s + 7]);
            const bf16x8 pa = __builtin_bit_cast(bf16x8, pw);
            const int k0 = 32 * (w + j) + 16 * s;
#pragma unroll
            for (int d0 = 0; d0 < 2; ++d0) { const LAS unsigned char* vp = vb + d0 * VHALF + k0 * 64;
                const bf16x8 vf = mk8(tr16(vp), tr16(vp + 512));
                o[d0] = __builtin_amdgcn_mfma_f32_32x32x16_bf16(pa, vf, o[d0], 0, 0, 0); }
        }
    volatile LAS float* scr = (volatile LAS float*)(lds + SCR_OFF) + w * 64;
    if (hi == 0) scr[r32] = ls;
    LDS_WAIT();
    LAS bf16* stg = (LAS bf16*)(lds + OST_OFF) + w * 2048;
#pragma unroll
    for (int rr = 0; rr < 16; ++rr) { const int orow = crow(rr, hi); const float rl = 1.0f / scr[orow];
#pragma unroll
        for (int d0 = 0; d0 < 2; ++d0) stg[orow * 64 + d0 * 32 + r32] = (bf16)(cvtpk(o[d0][rr] * rl, 0.f) & 0xffffu); }
    LDS_WAIT(); asm volatile("" ::: "memory");
    bf16* Op = F.OPART + ((size_t)p * M + (size_t)b * SEQ) * 512 + h * 64;
#pragma unroll
    for (int i = 0; i < 4; ++i) { const int row = i * 8 + (lane >> 3), ch = lane & 7; const v4u v = *(const LAS v4u*)(stg + row * 64 + ch * 8);
        const size_t tok = (size_t)(((256 * sb + 32 * w + row) << dsh) + r);
        *(GAS v4u*)(Op + tok * 512 + ch * 8) = v; }
    if (hi == 0) F.LSE[((size_t)p * M + (size_t)b * SEQ + qtok) * 8 + h] = mx + log2f(ls);
}

namespace ret {
constexpr int KRP = 192, VRP = 320;
constexpr int KV_K = 0, KV_V = 128 * KRP;
static_assert(KV_V + 128 * VRP <= RING_BYTES, "ret kv LDS");
constexpr int QRP = 144;
constexpr int O_QA = 0, O_QD = 128 * QRP, O_KA = 2 * 128 * QRP, O_VA = 3 * 128 * QRP, O_SA = O_VA + 128 * VRP, O_END = O_SA + 64 * VRP;
static_assert(O_END <= RING_BYTES, "ret out LDS");
constexpr int O_OUT = 0;
}
__device__ __forceinline__ void rot8(const v4u a, const v4u bq, const f32x2v* cs, float sc, v4u& o1, v4u& o2) {
    float x1[8], x2[8], y1[8], y2[8];
    x1[0] = bf_lo(a.x); x1[1] = bf_hi(a.x); x1[2] = bf_lo(a.y); x1[3] = bf_hi(a.y); x1[4] = bf_lo(a.z); x1[5] = bf_hi(a.z); x1[6] = bf_lo(a.w); x1[7] = bf_hi(a.w);
    x2[0] = bf_lo(bq.x); x2[1] = bf_hi(bq.x); x2[2] = bf_lo(bq.y); x2[3] = bf_hi(bq.y); x2[4] = bf_lo(bq.z); x2[5] = bf_hi(bq.z); x2[6] = bf_lo(bq.w); x2[7] = bf_hi(bq.w);
#pragma unroll
    for (int i = 0; i < 8; ++i) { const f32x2v c = cs[i]; y1[i] = (x1[i] * c.x - x2[i] * c.y) * sc; y2[i] = (x1[i] * c.y + x2[i] * c.x) * sc; }
    o1.x = cvtpk(y1[0], y1[1]); o1.y = cvtpk(y1[2], y1[3]); o1.z = cvtpk(y1[4], y1[5]); o1.w = cvtpk(y1[6], y1[7]);
    o2.x = cvtpk(y2[0], y2[1]); o2.y = cvtpk(y2[2], y2[3]); o2.z = cvtpk(y2[4], y2[5]); o2.w = cvtpk(y2[6], y2[7]);
}
__device__ __forceinline__ void retkv_unit(Frame& F, int u) {
    using namespace ret;
    const int tid = F.tid, lane = F.lane, w = F.wave, r32 = lane & 31, hi = lane >> 5;
    const int bh = u >> 6, n = u & 63, b = bh >> 2, h = bh & 3;
    LAS unsigned char* lds = F.lds + RING_OFF;
    const bf16* Pb = F.PROJ + ((size_t)b * SEQ + 128 * n) * INW;
    const float lg = lg2gamma(h);
    __syncthreads();
    {
        const int j = tid >> 2, c = tid & 3, t = 128 * n + j;
        const bf16* src = Pb + (size_t)j * INW + 1792 + h * 64 + 8 * c;
        const v4u a = *(const GAS v4u*)src, bq = *(const GAS v4u*)(src + 32);
        f32x2v cs[8];
#pragma unroll
        for (int i = 0; i < 8; ++i) cs[i] = F.ROPE[t * 32 + 8 * c + i];
        v4u o1, o2; rot8(a, bq, cs, __builtin_amdgcn_exp2f(lg * (float)(127 - j)), o1, o2);
        *(LAS v4u*)(lds + KV_K + j * KRP + 16 * c) = o1; *(LAS v4u*)(lds + KV_K + j * KRP + 64 + 16 * c) = o2;
#pragma unroll
        for (int it = 0; it < 4; ++it) { const int idx = tid + NTHR * it, jj = idx >> 4, cc = idx & 15;
            *(LAS v4u*)(lds + KV_V + jj * VRP + 16 * cc) = *(const GAS v4u*)(Pb + (size_t)jj * INW + 2048 + h * 128 + 8 * cc); }
    }
    __syncthreads();
    const int dt = w & 1, et = w >> 1;
    f32x16 acc = (f32x16){0.f, 0.f, 0.f, 0.f, 0.f, 0.f, 0.f, 0.f, 0.f, 0.f, 0.f, 0.f, 0.f, 0.f, 0.f, 0.f};
    const int rq = 4 * hi + ((lane & 15) >> 2), cq = 16 * ((lane >> 4) & 1) + 4 * (lane & 3);
    const LAS unsigned char* ka = lds + KV_K + rq * KRP + (32 * dt + cq) * 2;
    const LAS unsigned char* va = lds + KV_V + rq * VRP + (32 * et + cq) * 2;
#pragma unroll
    for (int ks = 0; ks < 8; ++ks) {
        const bf16x8 af = mk8(tr16(ka + 16 * ks * KRP), tr16(ka + (16 * ks + 8) * KRP));
        const bf16x8 bfv = mk8(tr16(va + 16 * ks * VRP), tr16(va + (16 * ks + 8) * VRP));
        acc = __builtin_amdgcn_mfma_f32_32x32x16_bf16(af, bfv, acc, 0, 0, 0);
    }
    float* dst = F.KV + (size_t)u * 8192;
#pragma unroll
    for (int rr = 0; rr < 16; ++rr) dst[(32 * dt + crow(rr, hi)) * 128 + 32 * et + r32] = acc[rr];
}

__device__ __forceinline__ void p3_scan_combine(Frame& F) {
    for (int e = F.vcu * NTHR + F.tid; e < 16 * 8192; e += F.G * NTHR) {
        const int bh = e >> 13, de = e & 8191; const float cd = __builtin_amdgcn_exp2f(lg2gamma(bh & 3) * 128.0f);
        float* p = F.KV + (size_t)bh * 64 * 8192 + de; float st = 0.f;
        for (int n0 = 0; n0 < 64; n0 += 8) { float cur[8];
#pragma unroll
            for (int i = 0; i < 8; ++i) cur[i] = p[(size_t)(n0 + i) * 8192];
#pragma unroll
            for (int i = 0; i < 8; ++i) { p[(size_t)(n0 + i) * 8192] = st; st = cd * st + cur[i]; } }
    }
    for (int it = F.vcu * NTHR + F.tid; it < M * 64; it += F.G * NTHR) {
        const int row = it >> 6, h = (it >> 3) & 7, c = it & 7;
        const float l0 = F.LSE[((size_t)0 * M + row) * 8 + h], l1 = F.LSE[((size_t)1 * M + row) * 8 + h], l2 = F.LSE[((size_t)2 * M + row) * 8 + h];
        const float mx = fmaxf(l0, fmaxf(l1, l2)); float w0 = __builtin_amdgcn_exp2f(l0 - mx), w1 = __builtin_amdgcn_exp2f(l1 - mx), w2 = __builtin_amdgcn_exp2f(l2 - mx);
        const float inv = 1.0f / (w0 + w1 + w2); w0 *= inv; w1 *= inv; w2 *= inv;
        const size_t off = (size_t)row * 512 + h * 64 + c * 8;
        const v4u a = *(const GAS v4u*)(F.OPART + off), bq = *(const GAS v4u*)(F.OPART + (size_t)M * 512 + off), cq = *(const GAS v4u*)(F.OPART + (size_t)2 * M * 512 + off);
        v4u o;
        o.x = cvtpk(w0 * bf_lo(a.x) + w1 * bf_lo(bq.x) + w2 * bf_lo(cq.x), w0 * bf_hi(a.x) + w1 * bf_hi(bq.x) + w2 * bf_hi(cq.x));
        o.y = cvtpk(w0 * bf_lo(a.y) + w1 * bf_lo(bq.y) + w2 * bf_lo(cq.y), w0 * bf_hi(a.y) + w1 * bf_hi(bq.y) + w2 * bf_hi(cq.y));
        o.z = cvtpk(w0 * bf_lo(a.z) + w1 * bf_lo(bq.z) + w2 * bf_lo(cq.z), w0 * bf_hi(a.z) + w1 * bf_hi(bq.z) + w2 * bf_hi(cq.z));
        o.w = cvtpk(w0 * bf_lo(a.w) + w1 * bf_lo(bq.w) + w2 * bf_lo(cq.w), w0 * bf_hi(a.w) + w1 * bf_hi(bq.w) + w2 * bf_hi(cq.w));
        *(GAS v4u*)(F.MIXED + (size_t)row * DM + h * 64 + c * 8) = o;
    }
}

__device__ __forceinline__ void retout_unit(Frame& F, int u) {
    using namespace ret;
    const int tid = F.tid, lane = F.lane, w = F.wave, r32 = lane & 31, hi = lane >> 5;
    const int bh = u >> 6, n = u & 63, b = bh >> 2, h = bh & 3;
    LAS unsigned char* lds = F.lds + RING_OFF;
    const size_t row0 = (size_t)b * SEQ + 128 * n;
    const bf16* Pb = F.PROJ + row0 * INW;
    const float lg = lg2gamma(h);
    __syncthreads();
    {
        const int i = tid >> 2, c = tid & 3, t = 128 * n + i;
        f32x2v cs[8];
#pragma unroll
        for (int k = 0; k < 8; ++k) cs[k] = F.ROPE[t * 32 + 8 * c + k];
        const bf16* sq = Pb + (size_t)i * INW + 1536 + h * 64 + 8 * c;
        v4u a = *(const GAS v4u*)sq, bq = *(const GAS v4u*)(sq + 32), o1, o2;
        rot8(a, bq, cs, 1.0f, o1, o2);
        *(LAS v4u*)(lds + O_QA + i * QRP + 16 * c) = o1; *(LAS v4u*)(lds + O_QA + i * QRP + 64 + 16 * c) = o2;
        rot8(a, bq, cs, __builtin_amdgcn_exp2f(lg * (float)(i + 1)), o1, o2);
        *(LAS v4u*)(lds + O_QD + i * QRP + 16 * c) = o1; *(LAS v4u*)(lds + O_QD + i * QRP + 64 + 16 * c) = o2;
        const bf16* sk = Pb + (size_t)i * INW + 1792 + h * 64 + 8 * c;
        a = *(const GAS v4u*)sk; bq = *(const GAS v4u*)(sk + 32);
        rot8(a, bq, cs, 1.0f, o1, o2);
        *(LAS v4u*)(lds + O_KA + i * QRP + 16 * c) = o1; *(LAS v4u*)(lds + O_KA + i * QRP + 64 + 16 * c) = o2;
#pragma unroll
        for (int it = 0; it < 4; ++it) { const int idx = tid + NTHR * it, jj = idx >> 4, cc = idx & 15;
            *(LAS v4u*)(lds + O_VA + jj * VRP + 16 * cc) = *(const GAS v4u*)(Pb + (size_t)jj * INW + 2048 + h * 128 + 8 * cc); }
        const float* sp = F.KV + (size_t)u * 8192 + tid * 16; const int sd = tid >> 3, se = (tid & 7) * 16;
        const f32x4 s0 = *(const GAS f32x4*)sp, s1 = *(const GAS f32x4*)(sp + 4), s2 = *(const GAS f32x4*)(sp + 8), s3 = *(const GAS f32x4*)(sp + 12);
        v4u q0, q1; q0.x = cvtpk(s0.x, s0.y); q0.y = cvtpk(s0.z, s0.w); q0.z = cvtpk(s1.x, s1.y); q0.w = cvtpk(s1.z, s1.w);
        q1.x = cvtpk(s2.x, s2.y); q1.y = cvtpk(s2.z, s2.w); q1.z = cvtpk(s3.x, s3.y); q1.w = cvtpk(s3.z, s3.w);
        *(LAS v4u*)(lds + O_SA + sd * VRP + se * 2) = q0; *(LAS v4u*)(lds + O_SA + sd * VRP + se * 2 + 16) = q1;
    }
    __syncthreads();
    const int qt = w & 3, eh = w >> 2;
    bf16x8 qf[4], qd[4];
#pragma unroll
    for (int ds = 0; ds < 4; ++ds) { qf[ds] = *(const LAS bf16x8*)(lds + O_QA + (32 * qt + r32) * QRP + (2 * ds + hi) * 16); qd[ds] = *(const LAS bf16x8*)(lds + O_QD + (32 * qt + r32) * QRP + (2 * ds + hi) * 16); }
    f32x16 o[2];
    o[0] = (f32x16){0.f, 0.f, 0.f, 0.f, 0.f, 0.f, 0.f, 0.f, 0.f, 0.f, 0.f, 0.f, 0.f, 0.f, 0.f, 0.f}; o[1] = o[0];
    const int rq = (lane & 15) >> 2, cq = 16 * ((lane >> 4) & 1) + 4 * (lane & 3);
#pragma unroll
    for (int kt = 0; kt < 4; ++kt) if (kt <= qt) {
        f32x16 pt = (f32x16){0.f, 0.f, 0.f, 0.f, 0.f, 0.f, 0.f, 0.f, 0.f, 0.f, 0.f, 0.f, 0.f, 0.f, 0.f, 0.f};
#pragma unroll
        for (int ds = 0; ds < 4; ++ds) { const bf16x8 kf = *(const LAS bf16x8*)(lds + O_KA + (32 * kt + r32) * QRP + (2 * ds + hi) * 16);
            pt = __builtin_amdgcn_mfma_f32_32x32x16_bf16(kf, qf[ds], pt, 0, 0, 0); }
#pragma unroll
        for (int rr = 0; rr < 16; ++rr) { const int dd = (32 * qt + r32) - (32 * kt + crow(rr, hi)); pt[rr] = (dd >= 0) ? pt[rr] * __builtin_amdgcn_exp2f(lg * (float)dd) : 0.f; }
#pragma unroll
        for (int s = 0; s < 2; ++s) {
            v4u pw; pw.x = cvtpk(pt[8 * s + 0], pt[8 * s + 1]); pw.y = cvtpk(pt[8 * s + 2], pt[8 * s + 3]); pw.z = cvtpk(pt[8 * s + 4], pt[8 * s + 5]); pw.w = cvtpk(pt[8 * s + 6], pt[8 * s + 7]);
            const bf16x8 pa = __builtin_bit_cast(bf16x8, pw);
#pragma unroll
            for (int d0 = 0; d0 < 2; ++d0) { const LAS unsigned char* vp = lds + O_VA + (32 * kt + 16 * s + 4 * hi + rq) * VRP + (64 * eh + 32 * d0 + cq) * 2;
                o[d0] = __builtin_amdgcn_mfma_f32_32x32x16_bf16(pa, mk8(tr16(vp), tr16(vp + 8 * VRP)), o[d0], 0, 0, 0); }
        }
    }
#pragma unroll
    for (int ds = 0; ds < 4; ++ds)
#pragma unroll
        for (int d0 = 0; d0 < 2; ++d0) { const LAS unsigned char* sp = lds + O_SA + (16 * ds + 8 * hi + rq) * VRP + (64 * eh + 32 * d0 + cq) * 2;
            o[d0] = __builtin_amdgcn_mfma_f32_32x32x16_bf16(qd[ds], mk8(tr16(sp), tr16(sp + 4 * VRP)), o[d0], 0, 0, 0); }
    __syncthreads();
    LAS float* outl = (LAS float*)(lds + O_OUT);
#pragma unroll
    for (int rr = 0; rr < 16; ++rr)
#pragma unroll
        for (int d0 = 0; d0 < 2; ++d0) outl[(32 * qt + crow(rr, hi)) * 128 + 64 * eh + 32 * d0 + r32] = o[d0][rr];
    __syncthreads();
    {
        const int i = tid >> 2, part = tid & 3;
        float v[32]; float ss = 0.f;
#pragma unroll
        for (int k = 0; k < 8; ++k) { const f32x4 t4 = *(const LAS f32x4*)(outl + i * 128 + 32 * part + 4 * k); v[4 * k] = t4.x; v[4 * k + 1] = t4.y; v[4 * k + 2] = t4.z; v[4 * k + 3] = t4.w; ss += (t4.x * t4.x + t4.y * t4.y) + (t4.z * t4.z + t4.w * t4.w); }
        ss += __shfl_xor(ss, 1); ss += __shfl_xor(ss, 2);
        const float rstd = 1.0f / sqrtf(ss * (1.0f / 128.0f) + NORM_EPS);
        const bf16* gp = Pb + (size_t)i * INW + 2560 + h * 128 + 32 * part;
        bf16* op = F.MIXED + (row0 + i) * DM + 512 + h * 128 + 32 * part;
#pragma unroll
        for (int k = 0; k < 4; ++k) { const v4u g = *(const GAS v4u*)(gp + 8 * k); float gv[8];
            gv[0] = bf_lo(g.x); gv[1] = bf_hi(g.x); gv[2] = bf_lo(g.y); gv[3] = bf_hi(g.y); gv[4] = bf_lo(g.z); gv[5] = bf_hi(g.z); gv[6] = bf_lo(g.w); gv[7] = bf_hi(g.w);
            float ov[8];
#pragma unroll
            for (int q = 0; q < 8; ++q) { const float sg = gv[q] * __builtin_amdgcn_rcpf(1.0f + __builtin_amdgcn_exp2f(-1.4426950408889634f * gv[q])); ov[q] = v[8 * k + q] * rstd * sg; }
            v4u ow; ow.x = cvtpk(ov[0], ov[1]); ow.y = cvtpk(ov[2], ov[3]); ow.z = cvtpk(ov[4], ov[5]); ow.w = cvtpk(ov[6], ov[7]);
            *(GAS v4u*)(op + 8 * k) = ow; }
    }
}

__device__ __forceinline__ void load_bf16_row(const bf16* row, int lane, f32x4 (&v)[4]) {
    const GAS u32x2* p = (const GAS u32x2*)row + lane;
#pragma unroll
    for (int j = 0; j < 4; ++j) { const u32x2 w = p[64 * j]; v[j] = (f32x4){bf_lo(w.x), bf_hi(w.x), bf_lo(w.y), bf_hi(w.y)}; }
}
__device__ __forceinline__ float sumsq4(const f32x4 (&v)[4]) { float s = 0.f;
#pragma unroll
    for (int j = 0; j < 4; ++j) s += (v[j].x * v[j].x + v[j].y * v[j].y) + (v[j].z * v[j].z + v[j].w * v[j].w);
    return s; }
__device__ __forceinline__ void p6_resnorm(Frame& F) {
    constexpr int R = 4;
    const int gw = F.vcu * NWAVES + F.wave, NGW = F.G * NWAVES, lane = F.lane;
    const GAS f32x4* g2 = (const GAS f32x4*)F.g_post + lane; const GAS f32x4* g3 = (const GAS f32x4*)F.g_fpre + lane;
    for (int m0 = gw * R; m0 < M; m0 += NGW * R) {
        f32x4 a[R][4], xv[R][4];
#pragma unroll
        for (int r = 0; r < R; ++r) { load_bf16_row(F.MIX + (size_t)(m0 + r) * DM, lane, a[r]); const GAS f32x4* xr = (const GAS f32x4*)(F.x + (size_t)(m0 + r) * DM) + lane;
#pragma unroll
            for (int j = 0; j < 4; ++j) xv[r][j] = xr[64 * j]; }
        float s[R];
#pragma unroll
        for (int r = 0; r < R; ++r) s[r] = sumsq4(a[r]);
#pragma unroll
        for (int o = 1; o < 64; o <<= 1) {
#pragma unroll
            for (int r = 0; r < R; ++r) s[r] += __shfl_xor(s[r], o); }
#pragma unroll
        for (int r = 0; r < R; ++r) { const float r2 = 1.f / sqrtf(s[r] * (1.f / DM) + NORM_EPS); GAS f32x4* orow = (GAS f32x4*)(F.out + (size_t)(m0 + r) * DM) + lane;
#pragma unroll
            for (int j = 0; j < 4; ++j) { a[r][j] = xv[r][j] + a[r][j] * r2 * g2[64 * j]; orow[64 * j] = a[r][j]; }
            s[r] = sumsq4(a[r]); }
#pragma unroll
        for (int o = 1; o < 64; o <<= 1) {
#pragma unroll
            for (int r = 0; r < R; ++r) s[r] += __shfl_xor(s[r], o); }
#pragma unroll
        for (int r = 0; r < R; ++r) { const float r3 = 1.f / sqrtf(s[r] * (1.f / DM) + NORM_EPS); GAS unsigned long long* o8 = (GAS unsigned long long*)(F.XN + (size_t)(m0 + r) * DM) + lane;
#pragma unroll
            for (int j = 0; j < 4; ++j) { const f32x4 g = g3[64 * j]; o8[64 * j] = (unsigned long long)cvtpk(a[r][j].x * r3 * g.x, a[r][j].y * r3 * g.y) | ((unsigned long long)cvtpk(a[r][j].z * r3 * g.z, a[r][j].w * r3 * g.w) << 32); } }
    }
}
__device__ __forceinline__ void p10_final(Frame& F, const float dscale, const float dadd) {
    constexpr int R = 4;
    const int gw = F.vcu * NWAVES + F.wave, NGW = F.G * NWAVES, lane = F.lane;
    const GAS f32x4* g4 = (const GAS f32x4*)F.g_fpost + lane;
    for (int m0 = gw * R; m0 < M; m0 += NGW * R) {
        f32x4 a[R][4], xv[R][4];
#pragma unroll
        for (int r = 0; r < R; ++r) { load_bf16_row(F.FFN + (size_t)(m0 + r) * DM, lane, a[r]); const GAS f32x4* xr = (const GAS f32x4*)(F.out + (size_t)(m0 + r) * DM) + lane;
#pragma unroll
            for (int j = 0; j < 4; ++j) xv[r][j] = xr[64 * j]; }
        float s[R];
#pragma unroll
        for (int r = 0; r < R; ++r) s[r] = sumsq4(a[r]);
#pragma unroll
        for (int o = 1; o < 64; o <<= 1) {
#pragma unroll
            for (int r = 0; r < R; ++r) s[r] += __shfl_xor(s[r], o); }
#pragma unroll
        for (int r = 0; r < R; ++r) { const float r4 = 1.f / sqrtf(s[r] * (1.f / DM) + NORM_EPS); GAS f32x4* orow = (GAS f32x4*)(F.out + (size_t)(m0 + r) * DM) + lane;
#pragma unroll
            for (int j = 0; j < 4; ++j) { f32x4 o = (xv[r][j] + a[r][j] * r4 * g4[64 * j]) * dscale; if (m0 + r == 0 && lane == 0 && j == 0) o.x += dadd; orow[64 * j] = o; } }
    }
}
__device__ __forceinline__ void p8_fixup(Frame& F) {
    for (int it = F.vcu * NTHR + F.tid; it < (M / 64) * 2 * FF; it += F.G * NTHR) {
        const int ri = it / FF, j = it % FF, g = ri >> 1, which = ri & 1; const bool first = (g % (SEQ / 64)) == 0;
        float y[2];
#pragma unroll
        for (int hf = 0; hf < 2; ++hf) {
            const float* ubg = F.UB + ((size_t)g * 8 + hf) * FF + j;
            const float* ubp = ubg - (size_t)8 * FF;
            const int c = hf * FF + j;
            const float ut = ubg[(size_t)(2 + which) * 2 * FF];
            const float u1 = which ? ubg[(size_t)2 * 2 * FF] : (first ? 0.f : ubp[(size_t)1 * 2 * FF]);
            const float u2 = first ? 0.f : (which ? ubp[(size_t)1 * 2 * FF] : ubp[0]);
            y[hf] = F.conv_b[c] + F.conv_w[2 * FF2 + c] * ut + F.conv_w[FF2 + c] * u1 + F.conv_w[c] * u2;
        }
        const float a = pg8::gelu_tanh_f(y[0]) * y[1];
        F.ACT[(size_t)(64 * g + which) * FF + j] = (bf16)(cvtpk(a, 0.f) & 0xffffu);
    }
}

struct Args { const float* in[11]; float* out; unsigned char* ws; int ph_lo, ph_hi, li, pad; };
__global__ void __launch_bounds__(NTHR, 2) mk_fwd(Args args) {
    extern __shared__ __attribute__((aligned(16))) unsigned char lds[];
    Frame F;
    F.lds = (LAS unsigned char*)lds;
    F.MISC = (volatile LAS unsigned*)(F.lds + MISC_OFF);
    F.tid = threadIdx.x; F.lane = F.tid & 63; F.wave = __builtin_amdgcn_readfirstlane(F.tid >> 6);
    F.G = gridDim.x; { const int bx = blockIdx.x; F.vcu = (F.G % 8 == 0) ? (bx % 8) * (F.G / 8) + bx / 8 : bx; }
    unsigned char* ws = args.ws;
    F.ctl = (gu32*)(ws + WS_CTL);
    F.x = args.in[0]; F.g_pre = args.in[1]; F.g_post = args.in[2]; F.w_in = args.in[3]; F.w_out = args.in[4]; F.g_fpre = args.in[5]; F.g_fpost = args.in[6];
    F.w_up = args.in[7]; F.conv_w = args.in[8]; F.conv_b = args.in[9]; F.w_down = args.in[10]; F.out = args.out;
    F.Win_t = (bf16*)(ws + WS_WIN); F.Wout_t = (bf16*)(ws + WS_WOUT); F.Wup_t = (bf16*)(ws + WS_WUP); F.Wdn_t = (bf16*)(ws + WS_WDN);
    F.XN = (bf16*)(ws + WS_XN); F.PROJ = (bf16*)(ws + WS_PROJ); F.ACT = (bf16*)(ws + WS_ACT); F.OPART = (bf16*)(ws + WS_OPART); F.MIX = (bf16*)(ws + WS_MIX);
    F.FFN = (bf16*)(ws + WS_FFN); F.MIXED = (bf16*)(ws + WS_MIXED); F.LSE = (float*)(ws + WS_LSE); F.UB = (float*)(ws + WS_UB); F.KV = (float*)(ws + WS_KV);
    F.ROPE = (f32x2v*)(ws + WS_ROPE);
    for (int u = F.tid; u < (LDS_BYTES - LDSCTL_OFF) / 4; u += NTHR) ((LAS unsigned*)(F.lds + LDSCTL_OFF))[u] = 0u;
    __syncthreads();
    XcdBarrier bar; bar.bar = (unsigned*)(F.ctl + CW_BAR) + args.li * XCD_BAR_WORDS; bar.x = 0; bar.st = nullptr;
    const int lo = args.ph_lo, hi = args.ph_hi;
    if (hi - lo > 1) bar = xcd_barrier_post((unsigned*)(F.ctl + CW_BAR) + args.li * XCD_BAR_WORDS, F.MISC + 8);
#define IN(k) (lo <= (k) && (k) < hi)
#ifndef MK_REP_MASK
#define MK_REP_MASK 0
#endif
#define REPEAT(k) _Pragma("unroll") for (int rep_ = 0, nrep_ = ((MK_REP_MASK >> (k)) & 1) ? 2 : 1; rep_ < nrep_; ++rep_)
#define REPSYNC(k) do { if (rep_ + 1 < nrep_) xcd_barrier(bar); } while (0)
#ifdef MK_DIAG_A
    unsigned long long* const tsb = (unsigned long long*)(ws + WS_CTL + 32768);
    if (blockIdx.x == 0 && F.tid == 0) tsb[0] = __builtin_amdgcn_s_memrealtime();
#define SEAM(k) do { if (IN(k) && IN((k) + 1)) { xcd_barrier(bar); if (blockIdx.x == 0 && F.tid == 0) { tsb[(k) + 1] = __builtin_amdgcn_s_memrealtime(); asm volatile("s_waitcnt vmcnt(0)" ::: "memory"); } } } while (0)
#else
#define SEAM(k) do { if (IN(k) && IN((k) + 1)) xcd_barrier(bar); } while (0)
#endif

    if (IN(0)) { REPEAT(0) { p0_prep(F); REPSYNC(0); } SEAM(0); }
    if (IN(1)) {
        pg8::Gemm g{F.XN, F.Win_t, M, INW, DM}; pg8::StaticOrder S; S.init(M, INW, F.G, (int)blockIdx.x);
        pg8::EpiStore E{F.PROJ, INW, 2, QSCALE, 7, 0.125f};
        REPEAT(1) { pg8::gemm_phase<pg8::EpiStore, pg8::StaticOrder, true, true>(F.lds + RING_OFF, g, S, E); REPSYNC(1); }
        SEAM(1);
    }
    if (IN(2)) { REPEAT(2) {
        { const int NU = 3 * 1024; const int u0 = (int)((long)F.vcu * NU / F.G), u1 = (int)((long)(F.vcu + 1) * NU / F.G); for (int u = u0; u < u1; ++u) attn_unit(F, u); }
        { const int NU = 1024; const int u0 = (int)((long)F.vcu * NU / F.G), u1 = (int)((long)(F.vcu + 1) * NU / F.G); for (int u = u0; u < u1; ++u) retkv_unit(F, u); }
        __syncthreads(); REPSYNC(2); }
        SEAM(2);
    }
    if (IN(3)) { p3_scan_combine(F); SEAM(3); }
    if (IN(4)) { REPEAT(4) {
        { const int NU = 1024; const int u0 = (int)((long)F.vcu * NU / F.G), u1 = (int)((long)(F.vcu + 1) * NU / F.G); for (int u = u0; u < u1; ++u) retout_unit(F, u); }
        __syncthreads(); REPSYNC(4); }
        SEAM(4);
    }
    if (IN(5)) {
        pg8::Gemm g{F.MIXED, F.Wout_t, M, DM, DM}; pg8::StaticOrder S; S.init(M, DM, F.G, (int)blockIdx.x);
        pg8::EpiStore E{F.MIX, DM, 0, 1.0f, -1, 1.0f};
        REPEAT(5) { pg8::gemm_phase<pg8::EpiStore, pg8::StaticOrder, true, true>(F.lds + RING_OFF, g, S, E); REPSYNC(5); }
        SEAM(5);
    }
    if (IN(6)) { REPEAT(6) { p6_resnorm(F); REPSYNC(6); } SEAM(6); }
    if (IN(7)) {
        pg8::Gemm g{F.XN, F.Wup_t, M, FF2, DM}; pg8::StaticOrder S; S.init(M, FF2, F.G, (int)blockIdx.x);
        pg8::EpiConvAct E{F.ACT, F.UB, F.conv_w, F.conv_b};
        REPEAT(7) { pg8::gemm_phase<pg8::EpiConvAct, pg8::StaticOrder, true, true>(F.lds + RING_OFF, g, S, E); REPSYNC(7); }
        SEAM(7);
    }
    if (IN(8)) { REPEAT(8) { p8_fixup(F); REPSYNC(8); } SEAM(8); }
    if (IN(9)) {
        pg8::Gemm g{F.ACT, F.Wdn_t, M, DM, FF}; pg8::StaticOrder S; S.init(M, DM, F.G, (int)blockIdx.x);
        pg8::EpiStore E{F.FFN, DM, 0, 1.0f, -1, 1.0f};
        REPEAT(9) { pg8::gemm_phase<pg8::EpiStore, pg8::StaticOrder, true, true>(F.lds + RING_OFF, g, S, E); REPSYNC(9); }
        SEAM(9);
    }
#ifdef MK_DIAG_A
    if (IN(10)) { const unsigned long long* tsr = (const unsigned long long*)(ws + WS_CTL + 32768);
        const float dA = (float)(__hip_atomic_load(tsr + MK_DIAG_A + 1, __ATOMIC_RELAXED, __HIP_MEMORY_SCOPE_AGENT) - __hip_atomic_load(tsr + MK_DIAG_A, __ATOMIC_RELAXED, __HIP_MEMORY_SCOPE_AGENT)) * 0.01f;
        const float dB = (float)(__hip_atomic_load(tsr + MK_DIAG_B + 1, __ATOMIC_RELAXED, __HIP_MEMORY_SCOPE_AGENT) - __hip_atomic_load(tsr + MK_DIAG_B, __ATOMIC_RELAXED, __HIP_MEMORY_SCOPE_AGENT)) * 0.01f;
        p10_final(F, 1.0f + dA * MK_DIAG_SCALE, dB); }
#else
    if (IN(10)) { p10_final(F, 1.0f, 0.0f); }
#endif
#undef IN
#undef SEAM
}

extern "C" void kernel_launch(void* const* d_in, const int* in_sizes, int n_in, void* d_out, int out_size, void* d_ws, size_t ws_size, hipStream_t stream) {
    static int grid = 0;
    if (grid == 0) {
        if (n_in != 11 || in_sizes[0] != M * DM || out_size != M * DM || ws_size < WS_END) { fprintf(stderr, "kernel_launch: unexpected shapes (n_in %d in0 %d out %d ws %zu); nothing launched\n", n_in, n_in > 0 ? in_sizes[0] : -1, out_size, ws_size); grid = -1; return; }
        int dev = 0, cus = 0, per_cu = 0;
        if (hipGetDevice(&dev) != hipSuccess || hipDeviceGetAttribute(&cus, hipDeviceAttributeMultiprocessorCount, dev) != hipSuccess) { grid = -1; return; }
        if (hipFuncSetAttribute((const void*)mk_fwd, hipFuncAttributeMaxDynamicSharedMemorySize, LDS_BYTES) != hipSuccess) { fprintf(stderr, "kernel_launch: hipFuncSetAttribute failed\n"); grid = -1; return; }
        if (hipOccupancyMaxActiveBlocksPerMultiprocessor(&per_cu, (const void*)mk_fwd, NTHR, LDS_BYTES) != hipSuccess || per_cu < 1) fprintf(stderr, "kernel_launch: occupancy query says %d blocks per CU\n", per_cu);
        (void)hipGetLastError();
        grid = cus;
    }
    if (grid < 0) return;
    if (hipMemsetAsync((char*)d_ws + WS_CTL, 0, CTL_ZERO_BYTES, stream) != hipSuccess) return;
    Args a{};
    for (int i = 0; i < 11; ++i) a.in[i] = (const float*)d_in[i];
    a.out = (float*)d_out; a.ws = (unsigned char*)d_ws;
#if MK_N_LAUNCHES == 1
    a.ph_lo = 0; a.ph_hi = N_PHASES; a.li = 0;
    hipLaunchKernelGGL(mk_fwd, dim3(grid), dim3(NTHR), LDS_BYTES, stream, a);
#else
    for (int li = 0; li < N_PHASES; ++li) { a.ph_lo = li; a.ph_hi = li + 1; a.li = 0; hipLaunchKernelGGL(mk_fwd, dim3(grid), dim3(NTHR), LDS_BYTES, stream, a); }
#endif
}
```

```cpp
#include <hip/hip_runtime.h>
#include <cstdio>
#include <cstdint>
#define MK_N_LAUNCHES 1

namespace pg8 {
#define PG8_LAS __attribute__((address_space(3)))
typedef unsigned short bf16_t;
typedef short bf16x8 __attribute__((ext_vector_type(8)));
typedef float f32x4 __attribute__((ext_vector_type(4)));
typedef unsigned u32x4 __attribute__((ext_vector_type(4)));
constexpr int BM = 256, BK = 64, HALF = 128, HTB = HALF * BK * 2  , STAGE_BYTES = 8 * HTB, NXCD = 8, WGM = 8;

__host__ __device__ __forceinline__ int lds_byte(int r, int c) { const int st = (r >> 4) * 2 + (c >> 5), rr = r & 15, cc = c & 31, ob = rr * 64 + cc * 2; return st * 1024 + (ob ^ (((ob >> 9) & 1) << 5)); }
__host__ __device__ __forceinline__ void stage_rc(int b, int& R, int& C) { const int st = b / 1024, sb = b % 1024, swz = sb ^ (((sb >> 9) & 1) << 5); R = (st >> 1) * 16 + swz / 64; C = (st & 1) * 32 + (swz % 64) / 2; }
__host__ __device__ __forceinline__ int perm32(int rho) { const int n = rho >> 4, i = rho & 15; return 8 * (i >> 2) + 4 * n + (i & 3); }

struct Unit { int pm, pn; };
struct Gemm { const bf16_t* A; const bf16_t* Bt; int M, N, K; };

struct StaticOrder {
    int nM, nN, nwg, G, c;
    __host__ __device__ void init(int M, int N, int G_, int c_) { nM = M / BM; nN = N / BM; nwg = nM * nN; G = G_; c = c_; }
    __host__ __device__ bool next(int i, Unit& u) const {
        const long L = (long)i * G + c; if (L >= nwg) return false;
        int wgid = (int)L; { const int q = nwg / NXCD, r = nwg % NXCD, xcd = wgid % NXCD, off = wgid / NXCD; wgid = (xcd < r ? xcd * (q + 1) : r * (q + 1) + (xcd - r) * q) + off; }
        const int nig = WGM * nN, gid = wgid / nig, fm = gid * WGM, gsz = (nM - fm) < WGM ? (nM - fm) : WGM;
        u.pm = fm + ((wgid % nig) % gsz); u.pn = (wgid % nig) / gsz; return true;
    }
    __device__ __forceinline__ void a_ready(const Unit&) const {}
    __device__ __forceinline__ void done(const Unit&) const {}
};

__device__ __forceinline__ unsigned cvt_pk_bf16(float lo, float hi) { unsigned r; asm volatile("v_cvt_pk_bf16_f32 %0, %1, %2" : "=v"(r) : "v"(lo), "v"(hi)); return r; }
typedef float f32x2 __attribute__((ext_vector_type(2)));
__device__ __forceinline__ f32x2 gelu_pk(f32x2 v) {
    const f32x2 av = __builtin_elementwise_abs(v), d = av * 0.2316418882f + 1.0f;
    f32x2 t; t.x = __builtin_amdgcn_rcpf(d.x); t.y = __builtin_amdgcn_rcpf(d.y);
    f32x2 q = t * 0.5307027145f + (-0.7265760135f); q = q * t + 0.7107068705f; q = q * t + (-0.142248368f); q = q * t + 0.127414796f; q = q * t;
    const f32x2 s = (v * v) * (-0.72134752044f);
    f32x2 e; e.x = __builtin_amdgcn_exp2f(s.x); e.y = __builtin_amdgcn_exp2f(s.y);
    const f32x2 m = v * (q * e), r = v - m;
    f32x2 o; o.x = v.x < 0.f ? m.x : r.x; o.y = v.y < 0.f ? m.y : r.y; return o;
}

template <int ACT  > struct EpiBf16 {
    static constexpr bool PERM = true, AFTER_DRAIN = false; static_assert(ACT == 0 || ACT == 1, "EpiBf16: ACT is 0 (none) or 1 (gelu_pk)");
    bf16_t* O; int ldc; const float* bias; int split_cols; size_t split_stride; float scale0;
    __device__ __forceinline__ void operator()(const f32x4 (&acc)[2][2][4][2], const Unit& u, int wr, int wc, int fr, int fq) const {
        const int row0 = u.pm * BM + wr * 64 + fr; int colt = u.pn * BM; bf16_t* base = O;
        float sc = 1.f; if (split_cols) { const int t = colt / split_cols; base += (size_t)t * split_stride; colt -= t * split_cols; if (t == 0) sc = scale0; }
        const int col0 = colt + wc * 32 + 8 * fq, bcol0 = u.pn * BM + wc * 32 + 8 * fq;
        f32x4 bv[2][2];
#pragma unroll
        for (int bj = 0; bj < 2; ++bj)
#pragma unroll
            for (int n = 0; n < 2; ++n) bv[bj][n] = bias ? *(const f32x4*)(bias + bcol0 + bj * HALF + 4 * n) : (f32x4){0.f, 0.f, 0.f, 0.f};
#pragma unroll
        for (int ai = 0; ai < 2; ++ai)
#pragma unroll
            for (int m = 0; m < 4; ++m) { bf16_t* rowp = base + (size_t)(row0 + ai * HALF + m * 16) * ldc + col0;
#pragma unroll
                for (int bj = 0; bj < 2; ++bj) { f32x4 v0 = acc[ai][bj][m][0] + bv[bj][0], v1 = acc[ai][bj][m][1] + bv[bj][1];
                    if (ACT == 1) { f32x2 a = gelu_pk((f32x2){v0[0], v0[1]}), b = gelu_pk((f32x2){v0[2], v0[3]}), c = gelu_pk((f32x2){v1[0], v1[1]}), d = gelu_pk((f32x2){v1[2], v1[3]});
                        v0 = (f32x4){a.x, a.y, b.x, b.y}; v1 = (f32x4){c.x, c.y, d.x, d.y}; }
                    v0 = v0 * sc; v1 = v1 * sc; u32x4 w; w.x = cvt_pk_bf16(v0[0], v0[1]); w.y = cvt_pk_bf16(v0[2], v0[3]); w.z = cvt_pk_bf16(v1[0], v1[1]); w.w = cvt_pk_bf16(v1[2], v1[3]);
                    *(u32x4*)(rowp + bj * HALF) = w; } }
    }
};

struct PanelStats {
    unsigned* xbuf;
    unsigned* cnt;
    unsigned* tmo;
    int ntn; float eps;
    unsigned code;
    __device__ __forceinline__ bool run(const f32x4 (&v)[2][2][4][2], const Unit& u, int wr, int wc, int fr, int fq, PG8_LAS unsigned char* lds, int wid, int lane) const {
        typedef float f32x2v __attribute__((ext_vector_type(2)));
        PG8_LAS f32x2v* P = (PG8_LAS f32x2v*)lds;
        PG8_LAS f32x2v* S = (PG8_LAS f32x2v*)(lds + 8192);
        PG8_LAS unsigned* flag = (PG8_LAS unsigned*)(lds + 8192 + 2048);
#pragma unroll
        for (int ai = 0; ai < 2; ++ai)
#pragma unroll
            for (int m = 0; m < 4; ++m) {
                float s = 0.f;
#pragma unroll
                for (int bj = 0; bj < 2; ++bj)
#pragma unroll
                    for (int n = 0; n < 2; ++n) { const f32x4 x = v[ai][bj][m][n]; s += (x[0] + x[1]) + (x[2] + x[3]); }
                s += __shfl_xor(s, 16); s += __shfl_xor(s, 32);
                const float mw = s * (1.0f / 64.0f); float q = 0.f;
#pragma unroll
                for (int bj = 0; bj < 2; ++bj)
#pragma unroll
                    for (int n = 0; n < 2; ++n) { const f32x4 d = v[ai][bj][m][n] - mw; q += (d[0] * d[0] + d[1] * d[1]) + (d[2] * d[2] + d[3] * d[3]); }
                q += __shfl_xor(q, 16); q += __shfl_xor(q, 32);
                if (fq == 0) P[(ai * HALF + wr * 64 + m * 16 + fr) * 4 + wc] = (f32x2v){mw, q};
            }
        asm volatile("s_waitcnt lgkmcnt(0)" ::: "memory"); __builtin_amdgcn_s_barrier(); asm volatile("" ::: "memory");
#if defined(BROKEN_EXCHANGE_NO_WAIT)
#warning BROKEN CONTROL BUILD: the row-statistics exchange does not wait; results are wrong by design
        if (blockIdx.x >= 64) { const long long t0_ = clock64(); while (clock64() - t0_ < 60000) __builtin_amdgcn_s_sleep(8); }
#endif
        const int row = wid * 32 + (lane & 31);
        if (lane < 32) {
            const f32x2v a = P[row * 4 + 0], b = P[row * 4 + 1], c = P[row * 4 + 2], d = P[row * 4 + 3];
            const float mt = (a.x + b.x + c.x + d.x) * 0.25f;
            const float da = a.x - mt, db = b.x - mt, dc = c.x - mt, dd = d.x - mt;
            const float m2 = (a.y + b.y) + (c.y + d.y) + 64.0f * ((da * da + db * db) + (dc * dc + dd * dd));
            unsigned long long* slot = (unsigned long long*)xbuf + ((size_t)(u.pm * BM + row) * 4 + u.pn);
            __hip_atomic_store(slot, ((unsigned long long)__float_as_uint(m2) << 32) | __float_as_uint(mt), __ATOMIC_RELAXED, __HIP_MEMORY_SCOPE_AGENT);
        }
        asm volatile("s_waitcnt vmcnt(0)" ::: "memory");
        if (lane == 0) __hip_atomic_fetch_add(cnt + 64 * u.pm, 1u, __ATOMIC_RELAXED, __HIP_MEMORY_SCOPE_AGENT);
        if (wid == 0) {
            bool dead = false; const unsigned long long t0 = __builtin_amdgcn_s_memrealtime(); const unsigned want = 8u * (unsigned)ntn;
            for (;;) {
#if defined(BROKEN_EXCHANGE_NO_WAIT)
                break;
#endif
                if ((unsigned)__builtin_amdgcn_readfirstlane(__hip_atomic_load(cnt + 64 * u.pm, __ATOMIC_RELAXED, __HIP_MEMORY_SCOPE_AGENT)) >= want) break;
                if (__builtin_amdgcn_s_memrealtime() - t0 > 2000000ull) {
                    if (lane == 0) { unsigned expect = 0u; __hip_atomic_compare_exchange_strong(tmo + 1, &expect, code | (unsigned)(u.pm & 0xff), __ATOMIC_RELAXED, __ATOMIC_RELAXED, __HIP_MEMORY_SCOPE_AGENT);
                                     __hip_atomic_store(tmo, 1u, __ATOMIC_RELAXED, __HIP_MEMORY_SCOPE_AGENT); }
                    dead = true; break; }
                __builtin_amdgcn_s_sleep(2);
            }
            __builtin_amdgcn_fence(__ATOMIC_ACQUIRE, "agent");
            if (lane == 0) flag[0] = dead ? 1u : 0u;
        }
        asm volatile("s_waitcnt vmcnt(0) lgkmcnt(0)" ::: "memory"); __builtin_amdgcn_s_barrier(); asm volatile("" ::: "memory");
        const bool bad = flag[0] != 0u;
        if (lane < 32) {
            const unsigned long long* slot = (const unsigned long long*)xbuf + (size_t)(u.pm * BM + row) * 4; float mt[4], m2[4]; float ms = 0.f;
#pragma unroll
            for (int t = 0; t < 4; ++t) { if (t < ntn) { const unsigned long long w = __hip_atomic_load(slot + t, __ATOMIC_RELAXED, __HIP_MEMORY_SCOPE_AGENT); mt[t] = __uint_as_float((unsigned)w); m2[t] = __uint_as_float((unsigned)(w >> 32)); } else { mt[t] = 0.f; m2[t] = 0.f; } ms += mt[t]; }
            const float mean = ms / (float)ntn; float q = 0.f;
#pragma unroll
            for (int t = 0; t < 4; ++t) if (t < ntn) { const float dm = mt[t] - mean; q += m2[t] + 256.0f * dm * dm; }
            S[row] = (f32x2v){mean, 1.0f / sqrtf(q / (256.0f * (float)ntn) + eps)};
        }
        asm volatile("s_waitcnt lgkmcnt(0)" ::: "memory"); __builtin_amdgcn_s_barrier(); asm volatile("" ::: "memory");
        return bad;
    }
};
struct EpiLnRes {
    static constexpr bool PERM = false, AFTER_DRAIN = true;
    const float* base; float* out; int ldc; const float* bias; PanelStats st; unsigned poison;
    __device__ __forceinline__ void fused(f32x4 (&acc)[2][2][4][2], const Unit& u, int wr, int wc, int fr, int fq, PG8_LAS unsigned char* lds, int wid, int lane) const {
        typedef float f32x2v __attribute__((ext_vector_type(2)));
        const PG8_LAS f32x2v* S = (const PG8_LAS f32x2v*)(lds + 8192);
        const int col0 = u.pn * BM + wc * 32 + 4 * fq;
#pragma unroll
        for (int bj = 0; bj < 2; ++bj)
#pragma unroll
            for (int n = 0; n < 2; ++n) { const f32x4 bv = bias ? *(const f32x4*)(bias + col0 + bj * HALF + n * 16) : (f32x4){0.f, 0.f, 0.f, 0.f};
#pragma unroll
                for (int ai = 0; ai < 2; ++ai)
#pragma unroll
                    for (int m = 0; m < 4; ++m) acc[ai][bj][m][n] += bv; }
        f32x4 pre[4][2][2];
#pragma unroll
        for (int m = 0; m < 4; ++m) { const size_t off = (size_t)(u.pm * BM + wr * 64 + m * 16 + fr) * ldc + col0;
#pragma unroll
            for (int bj = 0; bj < 2; ++bj)
#pragma unroll
                for (int n = 0; n < 2; ++n) pre[m][bj][n] = *(const f32x4*)(base + off + bj * HALF + n * 16); }
        const bool bad = st.run(acc, u, wr, wc, fr, fq, lds, wid, lane) || poison != 0u;
        const float qnan = __builtin_nanf("");
#pragma unroll
        for (int ai = 0; ai < 2; ++ai)
#pragma unroll
            for (int m = 0; m < 4; ++m) { const int r = ai * HALF + wr * 64 + m * 16 + fr; const f32x2v sr = S[r]; const size_t off = (size_t)(u.pm * BM + r) * ldc + col0;
#pragma unroll
                for (int bj = 0; bj < 2; ++bj)
#pragma unroll
                    for (int n = 0; n < 2; ++n) { const f32x4 bs = ai == 0 ? pre[m][bj][n] : *(const f32x4*)(base + off + bj * HALF + n * 16); f32x4 o = bs + (acc[ai][bj][m][n] - sr.x) * sr.y;
                        if (bad) o = (f32x4){qnan, qnan, qnan, qnan}; *(f32x4*)(out + off + bj * HALF + n * 16) = o; }
                if (m & 1) asm volatile("" ::: "memory"); }
    }
};
struct EpiLnResLn {
    static constexpr bool PERM = false, AFTER_DRAIN = true;
    const float* base; float* out; bf16_t* xn; int ldc; const float* bias; PanelStats st1, st2; unsigned poison;
    __device__ __forceinline__ void fused(f32x4 (&acc)[2][2][4][2], const Unit& u, int wr, int wc, int fr, int fq, PG8_LAS unsigned char* lds, int wid, int lane) const {
        typedef float f32x2v __attribute__((ext_vector_type(2))); typedef unsigned u32x2v __attribute__((ext_vector_type(2)));
        const PG8_LAS f32x2v* S = (const PG8_LAS f32x2v*)(lds + 8192);
        const int col0 = u.pn * BM + wc * 32 + 4 * fq;
#pragma unroll
        for (int bj = 0; bj < 2; ++bj)
#pragma unroll
            for (int n = 0; n < 2; ++n) { const f32x4 bv = bias ? *(const f32x4*)(bias + col0 + bj * HALF + n * 16) : (f32x4){0.f, 0.f, 0.f, 0.f};
#pragma unroll
                for (int ai = 0; ai < 2; ++ai)
#pragma unroll
                    for (int m = 0; m < 4; ++m) acc[ai][bj][m][n] += bv; }
        bool bad = st1.run(acc, u, wr, wc, fr, fq, lds, wid, lane) || poison != 0u;
        const float qnan = __builtin_nanf("");
#pragma unroll
        for (int ai = 0; ai < 2; ++ai)
#pragma unroll
            for (int m = 0; m < 4; ++m) { const int r = ai * HALF + wr * 64 + m * 16 + fr; const f32x2v sr = S[r]; const size_t off = (size_t)(u.pm * BM + r) * ldc + col0;
#pragma unroll
                for (int bj = 0; bj < 2; ++bj)
#pragma unroll
                    for (int n = 0; n < 2; ++n) { const f32x4 bs = *(const f32x4*)(base + off + bj * HALF + n * 16); acc[ai][bj][m][n] = bs + (acc[ai][bj][m][n] - sr.x) * sr.y; }
                asm volatile("" : "+v"(acc[ai][0][m][0]), "+v"(acc[ai][0][m][1]), "+v"(acc[ai][1][m][0]), "+v"(acc[ai][1][m][1]));
                if (m & 1) asm volatile("" ::: "memory"); }
        const bool bad1 = bad;
        bad = st2.run(acc, u, wr, wc, fr, fq, lds, wid, lane) || bad;
#pragma unroll
        for (int ai = 0; ai < 2; ++ai)
#pragma unroll
            for (int m = 0; m < 4; ++m) { const int r = ai * HALF + wr * 64 + m * 16 + fr; const f32x2v sr = S[r]; const size_t off = (size_t)(u.pm * BM + r) * ldc + col0;
#pragma unroll
                for (int bj = 0; bj < 2; ++bj)
#pragma unroll
                    for (int n = 0; n < 2; ++n) { const f32x4 x1 = acc[ai][bj][m][n]; *(f32x4*)(out + off + bj * HALF + n * 16) = bad1 ? (f32x4){qnan, qnan, qnan, qnan} : x1;
                        const f32x4 o = (x1 - sr.x) * sr.y; u32x2v w; w.x = cvt_pk_bf16(o[0], o[1]); w.y = cvt_pk_bf16(o[2], o[3]);
                        if (bad) { w.x = 0x7fc07fc0u; w.y = 0x7fc07fc0u; } *(u32x2v*)(xn + off + bj * HALF + n * 16) = w; }
                asm volatile("" ::: "memory"); }
    }
};

template <class Epi, class Sched, bool ALIGN_EPI = false, bool SP2 = false>
__device__ __forceinline__ void gemm_phase(PG8_LAS unsigned char* lds, const Gemm g, const Sched& S, const Epi& E) {
    const int tid = threadIdx.x, wid = __builtin_amdgcn_readfirstlane(tid >> 6), lane = tid & 63, wr = wid >> 2, wc = wid & 3, fr = lane & 15, fq = lane >> 4;
    const int K = g.K, nt = K / BK;
    unsigned voffA[2], voffB[2];
#pragma unroll
    for (int i = 0; i < 2; ++i) { int R, C; stage_rc(tid * 16 + i * 8192, R, C); const int Rb = Epi::PERM ? ((R & ~31) + perm32(R & 31)) : R;
        voffA[i] = (unsigned)(R * K + C) * 2u; voffB[i] = (unsigned)(Rb * K + C) * 2u; }
    const size_t kstep = (size_t)(BK * 2);
    const size_t hstep = (size_t)HALF * K * 2;
    const size_t tstep = 2 * hstep;
    const unsigned ldsw = (unsigned)wid * 1024u;
    const int aoff = lds_byte(wr * 64 + fr, fq * 8), boff = lds_byte(wc * 32 + fr, fq * 8);
#define PG8_SA(b, h) (((b) * 2 + (h)) * HTB)
#define PG8_SB(b, h) ((4 + (b) * 2 + (h)) * HTB)
#define PG8_STAGE(bufoff, gbase, voff) do { _Pragma("unroll") for (int _i = 0; _i < 2; ++_i) \
        __builtin_amdgcn_global_load_lds((const unsigned*)((const char*)(gbase) + (voff)[_i]), (PG8_LAS unsigned*)(lds + (bufoff) + ldsw + _i * 8192), 16, 0, 0); } while (0)
#define PG8_LDA(dst, b, h) do { _Pragma("unroll") for (int m = 0; m < 4; ++m) _Pragma("unroll") for (int k = 0; k < 2; ++k) dst[m][k] = *(const PG8_LAS bf16x8*)(lds + PG8_SA(b, h) + aoff + m * 2048 + k * 1024); } while (0)
#define PG8_LDB(dst, b, h) do { _Pragma("unroll") for (int n = 0; n < 2; ++n) _Pragma("unroll") for (int k = 0; k < 2; ++k) dst[n][k] = *(const PG8_LAS bf16x8*)(lds + PG8_SB(b, h) + boff + n * 2048 + k * 1024); } while (0)
#define PG8_MMA(ai, bj, At, Bt) do { __builtin_amdgcn_s_setprio(1); _Pragma("unroll") for (int m = 0; m < 4; ++m) _Pragma("unroll") for (int n = 0; n < 2; ++n) _Pragma("unroll") for (int k = 0; k < 2; ++k) \
        acc[ai][bj][m][n] = __builtin_amdgcn_mfma_f32_16x16x32_bf16(Bt[n][k], At[m][k], acc[ai][bj][m][n], 0, 0, 0); __builtin_amdgcn_s_setprio(0); } while (0)
#define PG8_WAIT_V(n) asm volatile("s_waitcnt vmcnt(" #n ")" ::: "memory")
#define PG8_WAIT_L(n) asm volatile("s_waitcnt lgkmcnt(" #n ")" ::: "memory")
#define PG8_BAR __builtin_amdgcn_s_barrier()
#define PG8_SCHED __builtin_amdgcn_sched_barrier(0)
    Unit cur, nxt; int ui = 0;
    if (!S.next(0, cur)) return;
    f32x4 acc[2][2][4][2];
#pragma unroll
    for (int a = 0; a < 2; ++a)
#pragma unroll
        for (int b = 0; b < 2; ++b)
#pragma unroll
            for (int m = 0; m < 4; ++m)
#pragma unroll
                for (int n = 0; n < 2; ++n) acc[a][b][m][n] = (f32x4){0.f, 0.f, 0.f, 0.f};
    bf16x8 At[4][2], B0[2][2], B1[2][2];
    const char* cA = (const char*)g.A + (size_t)cur.pm * tstep; const char* cB = (const char*)g.Bt + (size_t)cur.pn * tstep;
    S.a_ready(cur);
    if constexpr (SP2) {
        PG8_STAGE(PG8_SB(0, 0), cB, voffB); PG8_STAGE(PG8_SB(0, 1), cB + hstep, voffB); PG8_STAGE(PG8_SA(0, 0), cA, voffA); PG8_STAGE(PG8_SA(0, 1), cA + hstep, voffA);
        if (wr == 1) PG8_BAR;
        PG8_WAIT_V(2); PG8_BAR;
        PG8_STAGE(PG8_SB(1, 0), cB + kstep, voffB); PG8_STAGE(PG8_SA(1, 0), cA + kstep, voffA); PG8_STAGE(PG8_SB(1, 1), cB + hstep + kstep, voffB);
        PG8_WAIT_V(6); PG8_BAR;
    } else {
        PG8_STAGE(PG8_SB(0, 0), cB, voffB); PG8_STAGE(PG8_SA(0, 0), cA, voffA); PG8_STAGE(PG8_SB(0, 1), cB + hstep, voffB); PG8_STAGE(PG8_SA(0, 1), cA + hstep, voffA);
        if (wr == 1) PG8_BAR;
        PG8_WAIT_V(4); PG8_BAR;
        PG8_STAGE(PG8_SB(1, 0), cB + kstep, voffB); PG8_STAGE(PG8_SA(1, 0), cA + kstep, voffA); PG8_STAGE(PG8_SB(1, 1), cB + hstep + kstep, voffB);
        PG8_WAIT_V(6); PG8_BAR;
    }
    for (;;) {
        const bool has_next = S.next(ui + 1, nxt);
        const char* nA = has_next ? (const char*)g.A + (size_t)nxt.pm * tstep : cA; const char* nB = has_next ? (const char*)g.Bt + (size_t)nxt.pn * tstep : cB;
        for (int t = 0; t < nt; t += 2) {
            const bool last = (t == nt - 2);
            const char* a1 = cA + (size_t)(t + 1) * kstep;
            const char* a2 = last ? nA : cA + (size_t)(t + 2) * kstep; const char* b2 = last ? nB : cB + (size_t)(t + 2) * kstep;
            const char* a3 = a2 + kstep; const char* b3 = b2 + kstep;
            if (last && has_next) S.a_ready(nxt);
            if constexpr (SP2) {
            PG8_LDB(B0, 0, 0); PG8_LDB(B1, 0, 1); PG8_SCHED; PG8_LDA(At, 0, 0); PG8_STAGE(PG8_SA(1, 1), a1 + hstep, voffA);
            PG8_WAIT_V(8); PG8_WAIT_L(0); PG8_BAR; PG8_MMA(0, 0, At, B0); PG8_MMA(0, 1, At, B1); PG8_BAR; PG8_SCHED;
            PG8_LDA(At, 0, 1); PG8_STAGE(PG8_SB(0, 0), b2, voffB); PG8_STAGE(PG8_SB(0, 1), b2 + hstep, voffB); PG8_STAGE(PG8_SA(0, 0), a2, voffA);
            PG8_WAIT_V(8); PG8_WAIT_L(0); PG8_BAR; PG8_MMA(1, 0, At, B0); PG8_MMA(1, 1, At, B1); PG8_BAR; PG8_SCHED;
            PG8_LDB(B0, 1, 0); PG8_LDB(B1, 1, 1); PG8_SCHED; PG8_LDA(At, 1, 0); PG8_STAGE(PG8_SA(0, 1), a2 + hstep, voffA);
            PG8_WAIT_V(8); PG8_WAIT_L(0); PG8_BAR; PG8_MMA(0, 0, At, B0); PG8_MMA(0, 1, At, B1); PG8_BAR; PG8_SCHED;
            PG8_LDA(At, 1, 1); PG8_STAGE(PG8_SB(1, 0), b3, voffB); PG8_STAGE(PG8_SB(1, 1), b3 + hstep, voffB); PG8_STAGE(PG8_SA(1, 0), a3, voffA);
            PG8_WAIT_V(8); PG8_WAIT_L(0); PG8_BAR; PG8_MMA(1, 0, At, B0); PG8_MMA(1, 1, At, B1); PG8_BAR; PG8_SCHED;
            } else {
            PG8_LDB(B0, 0, 0); PG8_SCHED; PG8_LDA(At, 0, 0); PG8_STAGE(PG8_SA(1, 1), a1 + hstep, voffA);
            PG8_WAIT_L(8); PG8_BAR; PG8_WAIT_L(0); PG8_MMA(0, 0, At, B0); PG8_BAR; PG8_SCHED;
            PG8_LDB(B1, 0, 1); PG8_STAGE(PG8_SB(0, 0), b2, voffB);
            PG8_BAR; PG8_WAIT_L(0); PG8_MMA(0, 1, At, B1); PG8_BAR;
            PG8_LDA(At, 0, 1); PG8_STAGE(PG8_SA(0, 0), a2, voffA);
            PG8_BAR; PG8_WAIT_L(0); PG8_MMA(1, 0, At, B0); PG8_BAR; PG8_SCHED;
            PG8_STAGE(PG8_SB(0, 1), b2 + hstep, voffB);
            PG8_WAIT_V(6); PG8_BAR; PG8_MMA(1, 1, At, B1); PG8_BAR;
            PG8_LDB(B0, 1, 0); PG8_SCHED; PG8_LDA(At, 1, 0); PG8_STAGE(PG8_SA(0, 1), a2 + hstep, voffA);
            PG8_WAIT_L(8); PG8_BAR; PG8_WAIT_L(0); PG8_MMA(0, 0, At, B0); PG8_BAR; PG8_SCHED;
            PG8_LDB(B1, 1, 1); PG8_STAGE(PG8_SB(1, 0), b3, voffB);
            PG8_BAR; PG8_WAIT_L(0); PG8_MMA(0, 1, At, B1); PG8_BAR;
            PG8_LDA(At, 1, 1); PG8_STAGE(PG8_SA(1, 0), a3, voffA);
            PG8_BAR; PG8_WAIT_L(0); PG8_MMA(1, 0, At, B0); PG8_BAR; PG8_SCHED;
            PG8_STAGE(PG8_SB(1, 1), b3 + hstep, voffB);
            PG8_WAIT_V(6); PG8_BAR; PG8_MMA(1, 1, At, B1); PG8_BAR;
            }
        }
        if constexpr (ALIGN_EPI) { if (wr == 0) PG8_BAR; }
        if constexpr (!Epi::AFTER_DRAIN) { E(acc, cur, wr, wc, fr, fq); S.done(cur); }
        if (!has_next) break;
#pragma unroll
        for (int a = 0; a < 2; ++a)
#pragma unroll
            for (int b = 0; b < 2; ++b)
#pragma unroll
                for (int m = 0; m < 4; ++m)
#pragma unroll
                    for (int n = 0; n < 2; ++n) acc[a][b][m][n] = (f32x4){0.f, 0.f, 0.f, 0.f};
        cur = nxt; cA = nA; cB = nB; ++ui;
        if constexpr (ALIGN_EPI) { if (wr == 1) PG8_BAR; }
    }
    PG8_WAIT_V(0);
    if constexpr (!ALIGN_EPI) { if (wr == 0) PG8_BAR; }
    PG8_BAR;
    if constexpr (Epi::AFTER_DRAIN) { E.fused(acc, cur, wr, wc, fr, fq, lds, wid, lane); S.done(cur); }
#undef PG8_SA
#undef PG8_SB
#undef PG8_STAGE
#undef PG8_LDA
#undef PG8_LDB
#undef PG8_MMA
#undef PG8_WAIT_V
#undef PG8_WAIT_L
#undef PG8_BAR
#undef PG8_SCHED
}
}

namespace pg8 {
struct EpiStore {
    static constexpr bool PERM = true, AFTER_DRAIN = false;
    bf16_t* O; int ldc; int n_lo; float sc_lo; int pn_one; float sc_one;
    __device__ __forceinline__ void operator()(const f32x4 (&acc)[2][2][4][2], const Unit& u, int wr, int wc, int fr, int fq) const {
        const int row0 = u.pm * BM + wr * 64 + fr; const int col0 = u.pn * BM + wc * 32 + 8 * fq;
        const float sc = (u.pn < n_lo) ? sc_lo : ((u.pn == pn_one) ? sc_one : 1.0f);
#pragma unroll
        for (int ai = 0; ai < 2; ++ai)
#pragma unroll
            for (int m = 0; m < 4; ++m) { bf16_t* rowp = O + (size_t)(row0 + ai * HALF + m * 16) * ldc + col0;
#pragma unroll
                for (int bj = 0; bj < 2; ++bj) { f32x4 v0 = acc[ai][bj][m][0] * sc, v1 = acc[ai][bj][m][1] * sc;
                    u32x4 w; w.x = cvt_pk_bf16(v0[0], v0[1]); w.y = cvt_pk_bf16(v0[2], v0[3]); w.z = cvt_pk_bf16(v1[0], v1[1]); w.w = cvt_pk_bf16(v1[2], v1[3]);
                    *(u32x4*)(rowp + bj * HALF) = w; } }
    }
};

__device__ __forceinline__ float dpp_ror1(float v) { return __builtin_bit_cast(float, __builtin_amdgcn_update_dpp(0, __builtin_bit_cast(int, v), 0x121, 0xf, 0xf, false)); }
__device__ __forceinline__ float dpp_ror2(float v) { return __builtin_bit_cast(float, __builtin_amdgcn_update_dpp(0, __builtin_bit_cast(int, v), 0x122, 0xf, 0xf, false)); }
__device__ __forceinline__ float gelu_tanh_f(float x) {
    const float A = -2.302208198f, Bc = -0.1029432397f;
    const float t = x * (A + Bc * x * x);
    return x * __builtin_amdgcn_rcpf(1.0f + __builtin_amdgcn_exp2f(t));
}
struct EpiConvAct {
    static constexpr bool PERM = true, AFTER_DRAIN = false;
    bf16_t* act; float* ub; const float* cw; const float* cb;
    __device__ __forceinline__ void operator()(const f32x4 (&acc)[2][2][4][2], const Unit& u, int wr, int wc, int fr, int fq) const {
        constexpr int FFc = 2816, FF2c = 5632;
#pragma unroll
        for (int n = 0; n < 2; ++n) {
            const int j = u.pn * 128 + wc * 32 + 8 * fq + 4 * n;
            const f32x4 w0g = *(const f32x4*)(cw + j), w1g = *(const f32x4*)(cw + FF2c + j), w2g = *(const f32x4*)(cw + 2 * FF2c + j), bg = *(const f32x4*)(cb + j);
            const f32x4 w0u = *(const f32x4*)(cw + FFc + j), w1u = *(const f32x4*)(cw + FF2c + FFc + j), w2u = *(const f32x4*)(cw + 2 * FF2c + FFc + j), bu = *(const f32x4*)(cb + FFc + j);
#pragma unroll
            for (int ai = 0; ai < 2; ++ai) {
                const int g = u.pm * 4 + ai * 2 + wr;
                f32x4 qg1 = {0.f, 0.f, 0.f, 0.f}, qg2 = qg1, qu1 = qg1, qu2 = qg1;
#pragma unroll
                for (int m = 0; m < 4; ++m) {
                    const f32x4 ug = acc[ai][0][m][n], uu = acc[ai][1][m][n];
                    f32x4 ag1, ag2, au1, au2;
#pragma unroll
                    for (int k = 0; k < 4; ++k) { ag1[k] = dpp_ror1(ug[k]); ag2[k] = dpp_ror2(ug[k]); au1[k] = dpp_ror1(uu[k]); au2[k] = dpp_ror2(uu[k]); }
                    f32x4 pg1, pg2, pu1, pu2;
#pragma unroll
                    for (int k = 0; k < 4; ++k) { pg1[k] = (fr >= 1) ? ag1[k] : qg1[k]; pg2[k] = (fr >= 2) ? ag2[k] : qg2[k]; pu1[k] = (fr >= 1) ? au1[k] : qu1[k]; pu2[k] = (fr >= 2) ? au2[k] : qu2[k]; }
                    qg1 = ag1; qg2 = ag2; qu1 = au1; qu2 = au2;
                    const f32x4 yg = bg + w2g * ug + w1g * pg1 + w0g * pg2;
                    const f32x4 yu = bu + w2u * uu + w1u * pu1 + w0u * pu2;
                    float a0 = gelu_tanh_f(yg[0]) * yu[0], a1 = gelu_tanh_f(yg[1]) * yu[1], a2 = gelu_tanh_f(yg[2]) * yu[2], a3 = gelu_tanh_f(yg[3]) * yu[3];
                    const int row = u.pm * BM + ai * HALF + wr * 64 + m * 16 + fr;
                    typedef unsigned u32x2 __attribute__((ext_vector_type(2)));
                    u32x2 w; w.x = cvt_pk_bf16(a0, a1); w.y = cvt_pk_bf16(a2, a3);
                    if (!(m == 0 && fr < 2)) *(u32x2*)(act + (size_t)row * FFc + j) = w;
                    if (m == 0 && fr < 2) { float* p = ub + ((size_t)(g * 4 + 2 + fr) * 2) * FFc + j; *(f32x4*)p = ug; *(f32x4*)(p + FFc) = uu; }
                    if (m == 3 && fr >= 14) { float* p = ub + ((size_t)(g * 4 + (fr - 14)) * 2) * FFc + j; *(f32x4*)p = ug; *(f32x4*)(p + FFc) = uu; }
                }
            }
        }
    }
};
}
#define GAS __attribute__((address_space(1)))
#define LAS __attribute__((address_space(3)))
typedef unsigned short bf16;
typedef unsigned v4u __attribute__((ext_vector_type(4)));
typedef float f32x4 __attribute__((ext_vector_type(4)));
typedef short bf16x8 __attribute__((ext_vector_type(8)));
typedef GAS unsigned gu32;
typedef GAS unsigned long long gu64;
#define RLX_AGENT __ATOMIC_RELAXED, __HIP_MEMORY_SCOPE_AGENT
#define LDS_WAIT() asm volatile("s_waitcnt lgkmcnt(0)" ::: "memory")
#define VM_WAIT() asm volatile("s_waitcnt vmcnt(0)" ::: "memory")
__device__ __forceinline__ unsigned long long rt() { return __builtin_amdgcn_s_memrealtime(); }
__device__ __forceinline__ unsigned f2bf(float f) { unsigned u = __builtin_bit_cast(unsigned, f); return (u + 0x7fffu + ((u >> 16) & 1u)) >> 16; }
__device__ __forceinline__ unsigned pk2(float lo, float hi) { return f2bf(lo) | (f2bf(hi) << 16); }

#define XB_TMO      128
#define XB_XCNT(j)  (256  + 64 * (j))
#define XB_XSUB(j)  (1280 + 64 * (j))
#define XB_XGEN(j)  (2304 + 64 * (j))
#define XB_TOP      3328
#define XB_TOPGEN   3392
#define XCD_BAR_WORDS 3456
#define XB_SPIN_CAP (1u << 18)

__device__ __forceinline__ unsigned xb_ld(unsigned* p)              { return __hip_atomic_load(p, __ATOMIC_RELAXED, __HIP_MEMORY_SCOPE_AGENT); }
__device__ __forceinline__ unsigned xb_add(unsigned* p, unsigned v) { return __hip_atomic_fetch_add(p, v, __ATOMIC_RELAXED, __HIP_MEMORY_SCOPE_AGENT); }
__device__ __forceinline__ unsigned xb_xcc_id() { return (unsigned)__builtin_amdgcn_s_getreg((3 << 11) | 20) & 0xFu; }
#define XB_SPIN(cond, bar) do { unsigned _sp = 0; while (cond) { __builtin_amdgcn_s_sleep(1); \
    if ((++_sp & 255u) == 0u) { if (xb_ld(&(bar)[XB_TMO])) break; if (_sp > XB_SPIN_CAP) { atomicAdd(&(bar)[XB_TMO], 1u); break; } } } } while (0)

struct XcdBarrier {
    unsigned* bar; unsigned x;
    volatile LAS unsigned* st;
};

__device__ __forceinline__ XcdBarrier xcd_barrier_post(unsigned* bar, volatile LAS unsigned* st) {
    XcdBarrier b; b.bar = bar; b.x = xb_xcc_id(); b.st = st;
    if (threadIdx.x == 0) (void)xb_add(&bar[XB_XCNT(b.x)], 1u);
    return b;
}
__device__ __forceinline__ void xcd_barrier_complete(unsigned* bar, unsigned x, unsigned& nloc, unsigned& nx) {
    const unsigned G = gridDim.x * gridDim.y * gridDim.z;
    unsigned sum, cnt, mine, sp = 0u;
    for (;;) {
        sum = 0u; cnt = 0u; mine = 0u;
#pragma unroll
        for (unsigned j = 0; j < 16; ++j) { const unsigned c = xb_ld(&bar[XB_XCNT(j)]); sum += c; cnt += (c > 0u) ? 1u : 0u; mine = (j == x) ? c : mine; }
        if (sum == G) break;
        __builtin_amdgcn_s_sleep(1);
        if ((++sp & 255u) == 0u) { if (xb_ld(&bar[XB_TMO])) break; if (sp > XB_SPIN_CAP) { atomicAdd(&bar[XB_TMO], 1u); break; } }
    }
    nloc = mine > 0u ? mine : 1u; nx = cnt > 0u ? cnt : 1u;
}

__device__ __forceinline__ void xcd_barrier(const XcdBarrier& b) {
    asm volatile("s_waitcnt vmcnt(0)" ::: "memory");
    __syncthreads();
    if (threadIdx.x == 0) {
        unsigned* bar = b.bar;
        __builtin_amdgcn_s_waitcnt(0);
        unsigned nloc = b.st[0], nx = b.st[1];
        if (nloc == 0u) { xcd_barrier_complete(bar, b.x, nloc, nx); b.st[0] = nloc; b.st[1] = nx; }
        const unsigned old = xb_add(&bar[XB_XSUB(b.x)], 1u);
        const unsigned gen = old / nloc;
        if (old + 1u == (gen + 1u) * nloc) {
            __builtin_amdgcn_fence(__ATOMIC_RELEASE, "agent");
            asm volatile("s_waitcnt vmcnt(0)" ::: "memory");
            const unsigned og = xb_add(&bar[XB_TOP], 1u);
            const unsigned tg = og / nx;
            if (og + 1u == (tg + 1u) * nx) xb_add(&bar[XB_TOPGEN], 1u);
            else XB_SPIN(xb_ld(&bar[XB_TOPGEN]) == tg, bar);
            __builtin_amdgcn_fence(__ATOMIC_ACQUIRE, "agent");
            xb_add(&bar[XB_XGEN(b.x)], 1u);
            asm volatile("s_waitcnt vmcnt(0)" ::: "memory");
        } else {
            XB_SPIN(xb_ld(&bar[XB_XGEN(b.x)]) == gen, bar);
            __builtin_amdgcn_fence(__ATOMIC_ACQUIRE, "agent");
            asm volatile("s_waitcnt vmcnt(0)" ::: "memory");
        }
    }
    __syncthreads();
}

constexpr int NWAVES = 8, NTHR = 512;
#ifndef MK_N_LAUNCHES
#define MK_N_LAUNCHES 1
#endif
constexpr int N_PHASES = 11;
constexpr int BATCH = 4, SEQ = 8192, DM = 1024, M = BATCH * SEQ, INW = 3072, FF = 2816, FF2 = 5632;
constexpr float NORM_EPS = 1e-6f;
constexpr float QSCALE = 0.125f * 1.4426950408889634f;
constexpr size_t MiB = 1u << 20;
constexpr size_t WS_CTL = 0, CTL_ZERO_BYTES = 1 * MiB;
constexpr size_t WS_ROPE = 1 * MiB;
constexpr size_t WS_WIN = 4 * MiB, WS_WOUT = 10 * MiB, WS_WUP = 12 * MiB, WS_WDN = 23 * MiB;
constexpr size_t WS_XN = 32 * MiB;
constexpr size_t WS_PROJ = 96 * MiB;
constexpr size_t WS_ACT = 96 * MiB;
constexpr size_t WS_OPART = 288 * MiB;
constexpr size_t WS_LSE = 384 * MiB;
constexpr size_t WS_MIX = 288 * MiB;
constexpr size_t WS_FFN = 352 * MiB;
constexpr size_t WS_MIXED = 416 * MiB;
constexpr size_t WS_UB = 416 * MiB;
constexpr size_t WS_KV = 480 * MiB;
constexpr size_t WS_END = 512 * MiB;
constexpr int CW_TMO = 0, CW_BAR = 4096;
constexpr int RING_OFF = 0, RING_BYTES = 133120;
constexpr int LDSCTL_OFF = RING_BYTES, MISC_OFF = LDSCTL_OFF + 320;
constexpr int LDS_BYTES = 147456;
static_assert(MISC_OFF + 128 <= LDS_BYTES, "LDS map");

__device__ const float ROPE_F[32] = {1.000000000e+00f, 7.498942018e-01f, 5.623413324e-01f, 4.216965139e-01f, 3.162277639e-01f, 2.371373773e-01f, 1.778279394e-01f, 1.333521456e-01f, 1.000000015e-01f, 7.498942316e-02f, 5.623413250e-02f, 4.216964915e-02f, 3.162277490e-02f, 2.371373773e-02f, 1.778279431e-02f, 1.333521400e-02f, 9.999999776e-03f, 7.498942316e-03f, 5.623413250e-03f, 4.216964822e-03f, 3.162277630e-03f, 2.371373819e-03f, 1.778279431e-03f, 1.333521446e-03f, 1.000000047e-03f, 7.498941850e-04f, 5.623413017e-04f, 4.216965172e-04f, 3.162277571e-04f, 2.371373703e-04f, 1.778279402e-04f, 1.333521504e-04f};

typedef float f32x16 __attribute__((ext_vector_type(16)));
typedef short s16x4 __attribute__((ext_vector_type(4)));
typedef unsigned u32x2 __attribute__((ext_vector_type(2)));
typedef float f32x2v __attribute__((ext_vector_type(2)));
typedef __bf16 bf16x2_t __attribute__((ext_vector_type(2)));
__device__ __forceinline__ unsigned cvtpk(float lo, float hi) { f32x2v v = {lo, hi}; bf16x2_t b = __builtin_convertvector(v, bf16x2_t); return __builtin_bit_cast(unsigned, b); }
__device__ __forceinline__ float bf_lo(unsigned w) { return __builtin_bit_cast(float, w << 16); }
__device__ __forceinline__ float bf_hi(unsigned w) { return __builtin_bit_cast(float, w & 0xffff0000u); }
__device__ __forceinline__ int crow(int r, int hi) { return (r & 3) + 8 * (r >> 2) + 4 * hi; }
__device__ __forceinline__ s16x4 tr16(const LAS unsigned char* p) { typedef short v4i16_t __attribute__((ext_vector_type(4))); return __builtin_bit_cast(s16x4, __builtin_amdgcn_ds_read_tr16_b64_v4i16((LAS v4i16_t*)p)); }
__device__ __forceinline__ bf16x8 mk8(s16x4 a, s16x4 b) { return (bf16x8){a[0], a[1], a[2], a[3], b[0], b[1], b[2], b[3]}; }
__device__ __forceinline__ float wave_sum(float v) {
#pragma unroll
    for (int o = 1; o < 64; o <<= 1) v += __shfl_xor(v, o);
    return v;
}
__device__ __forceinline__ float lg2gamma(int h) { return log2f(1.0f - exp2f(-5.0f - (float)h)); }

struct Frame {
    LAS unsigned char* lds;
    volatile LAS unsigned* MISC;
    gu32* ctl;
    int tid, lane, wave, vcu, G;
    const float *x, *g_pre, *g_post, *w_in, *w_out, *g_fpre, *g_fpost, *w_up, *conv_w, *conv_b, *w_down;
    float* out;
    bf16 *Win_t, *Wout_t, *Wup_t, *Wdn_t, *XN, *PROJ, *ACT, *OPART, *MIX, *FFN, *MIXED;
    float *LSE, *UB, *KV; f32x2v* ROPE;
};

__device__ __forceinline__ void p0_transpose_item(const float* W, int K, int N, bf16* WT, int row_off, LAS float* scr, int kb, int nb, int lane) {
    const int k0 = 64 * kb, n0 = 32 * nb;
#pragma unroll 8
    for (int i = 0; i < 32; ++i) { const int kk = 2 * i + (lane >> 5); scr[kk * 33 + (lane & 31)] = W[(size_t)(k0 + kk) * N + n0 + (lane & 31)]; }
    LDS_WAIT(); asm volatile("" ::: "memory");
    const int c = lane & 7;
#pragma unroll
    for (int j = 0; j < 4; ++j) { const int n = (lane >> 3) + 8 * j; const LAS float* s = scr + (8 * c) * 33 + n;
        v4u o; o.x = cvtpk(s[0 * 33], s[1 * 33]); o.y = cvtpk(s[2 * 33], s[3 * 33]); o.z = cvtpk(s[4 * 33], s[5 * 33]); o.w = cvtpk(s[6 * 33], s[7 * 33]);
        *(GAS v4u*)(WT + (size_t)(row_off + n0 + n) * K + k0 + 8 * c) = o; }
    LDS_WAIT(); asm volatile("" ::: "memory");
}
__device__ __forceinline__ void rms_row_to_bf16(const float* xrow, const float* gain, bf16* orow, int lane) {
    const GAS f32x4* xr = (const GAS f32x4*)xrow + lane; const GAS f32x4* gr = (const GAS f32x4*)gain + lane;
    f32x4 v[4]; float s = 0.f;
#pragma unroll
    for (int j = 0; j < 4; ++j) { v[j] = xr[64 * j]; s += (v[j].x * v[j].x + v[j].y * v[j].y) + (v[j].z * v[j].z + v[j].w * v[j].w); }
    const float rstd = 1.f / sqrtf(wave_sum(s) * (1.f / DM) + NORM_EPS);
    GAS unsigned long long* o8 = (GAS unsigned long long*)orow + lane;
#pragma unroll
    for (int j = 0; j < 4; ++j) { const f32x4 g = gr[64 * j];
        o8[64 * j] = (unsigned long long)cvtpk(v[j].x * rstd * g.x, v[j].y * rstd * g.y) | ((unsigned long long)cvtpk(v[j].z * rstd * g.z, v[j].w * rstd * g.w) << 32); }
}
__device__ __forceinline__ void rms_rows4_to_bf16(const float* xrow, const float* gain, bf16* orow, int lane) {
    const GAS f32x4* gr = (const GAS f32x4*)gain + lane;
    f32x4 v[4][4]; float s[4];
#pragma unroll
    for (int r = 0; r < 4; ++r) { const GAS f32x4* xr = (const GAS f32x4*)(xrow + (size_t)r * DM) + lane;
#pragma unroll
        for (int j = 0; j < 4; ++j) v[r][j] = xr[64 * j]; }
#pragma unroll
    for (int r = 0; r < 4; ++r) { s[r] = 0.f;
#pragma unroll
        for (int j = 0; j < 4; ++j) s[r] += (v[r][j].x * v[r][j].x + v[r][j].y * v[r][j].y) + (v[r][j].z * v[r][j].z + v[r][j].w * v[r][j].w); }
#pragma unroll
    for (int o = 1; o < 64; o <<= 1) {
#pragma unroll
        for (int r = 0; r < 4; ++r) s[r] += __shfl_xor(s[r], o); }
#pragma unroll
    for (int r = 0; r < 4; ++r) { const float rstd = 1.f / sqrtf(s[r] * (1.f / DM) + NORM_EPS); GAS unsigned long long* o8 = (GAS unsigned long long*)(orow + (size_t)r * DM) + lane;
#pragma unroll
        for (int j = 0; j < 4; ++j) { const f32x4 g = gr[64 * j];
            o8[64 * j] = (unsigned long long)cvtpk(v[r][j].x * rstd * g.x, v[r][j].y * rstd * g.y) | ((unsigned long long)cvtpk(v[r][j].z * rstd * g.z, v[r][j].w * rstd * g.w) << 32); } }
}
__device__ __forceinline__ void p0_prep(Frame& F) {
    LAS float* scr = (LAS float*)(F.lds + RING_OFF + F.wave * 16384);
    const int gw = F.vcu * NWAVES + F.wave, NGW = F.G * NWAVES;
    constexpr int I_IN = (DM / 64) * (INW / 32), I_OUT = (DM / 64) * (DM / 32), I_UP = (DM / 64) * (FF2 / 32), I_DN = (FF / 64) * (DM / 32);
    constexpr int NITEMS = I_IN + I_OUT + I_UP + I_DN;
    for (int it = gw; it < NITEMS; it += NGW) {
        int r = it;
        if (r < I_IN) { const int nblk = INW / 32; p0_transpose_item(F.w_in, DM, INW, F.Win_t, 0, scr, r / nblk, r % nblk, F.lane); continue; } r -= I_IN;
        if (r < I_OUT) { const int nblk = DM / 32; p0_transpose_item(F.w_out, DM, DM, F.Wout_t, 0, scr, r / nblk, r % nblk, F.lane); continue; } r -= I_OUT;
        if (r < I_UP) { const int nblk = FF2 / 32; const int kb = r / nblk, nb = r % nblk; const int n0 = 32 * nb;
            const int dest = (n0 < FF) ? ((n0 / 128) * 256 + (n0 % 128)) : (((n0 - FF) / 128) * 256 + 128 + ((n0 - FF) % 128));
            p0_transpose_item(F.w_up, DM, FF2, F.Wup_t, dest - n0, scr, kb, nb, F.lane); continue; } r -= I_UP;
        { const int nblk = DM / 32; p0_transpose_item(F.w_down, FF, DM, F.Wdn_t, 0, scr, r / nblk, r % nblk, F.lane); }
    }
    for (int m = gw * 4; m < M; m += NGW * 4) rms_rows4_to_bf16(F.x + (size_t)m * DM, F.g_pre, F.XN + (size_t)m * DM, F.lane);
    for (int idx = F.vcu * NTHR + F.tid; idx < SEQ * 32; idx += F.G * NTHR) { const int t = idx >> 5, i = idx & 31; const float ang = (float)t * ROPE_F[i]; F.ROPE[idx] = (f32x2v){cosf(ang), sinf(ang)}; }
}

namespace att {
constexpr int NKEY = 384, K_OFF = 0, K_BYTES = NKEY * 128, V_OFF = K_BYTES, VHALF = NKEY * 64, V_BYTES = 2 * VHALF, SCR_OFF = V_OFF + V_BYTES, OST_OFF = SCR_OFF + 8 * 256, END = OST_OFF + 8 * 4096;
static_assert(END <= RING_BYTES, "attention LDS");
}
struct AttnPre { v4u k[6], v[6]; bf16x8 q[4]; };
__device__ __forceinline__ void attn_load(Frame& F, int u, AttnPre& P) {
    const int tid = F.tid, lane = F.lane, w = F.wave, r32 = lane & 31, hi = lane >> 5;
    const int p = u >> 10, rem = u & 1023, bh = rem >> 5, xx = rem & 31, b = bh >> 3, h = bh & 7;
    const int dsh = (p == 0) ? 4 : ((p == 1) ? 2 : 0);
    const int nsb = 32 >> dsh, r = xx / nsb, sb = xx % nsb;
    const bf16* Pb = F.PROJ + (size_t)b * SEQ * INW;
#pragma unroll
    for (int it = 0; it < 6; ++it) { const int idx = tid + NTHR * it, kk = idx >> 3, c = idx & 7; int sp = 256 * sb - 128 + kk; sp = sp < 0 ? 0 : sp;
        const bf16* src = Pb + (size_t)((sp << dsh) + r) * INW + h * 64 + c * 8;
        P.k[it] = *(const GAS v4u*)(src + 512); P.v[it] = *(const GAS v4u*)(src + 1024); }
    const size_t qtok = (size_t)(((256 * sb + 32 * w + r32) << dsh) + r);
#pragma unroll
    for (int d0 = 0; d0 < 4; ++d0) P.q[d0] = *(const GAS bf16x8*)(Pb + qtok * INW + h * 64 + d0 * 16 + hi * 8);
}
__device__ __forceinline__ void attn_units(Frame& F, int u0, int u1) {
    using namespace att;
    if (u0 >= u1) return;
    const int tid = F.tid, lane = F.lane, w = F.wave, r32 = lane & 31, hi = lane >> 5;
    LAS unsigned char* lds = F.lds + RING_OFF;
    AttnPre P; attn_load(F, u0, P);
    for (int u = u0; u < u1; ++u) {
    const int p = u >> 10, rem = u & 1023, bh = rem >> 5, xx = rem & 31, b = bh >> 3, h = bh & 7;
    const int dsh = (p == 0) ? 4 : ((p == 1) ? 2 : 0);
    const int nsb = 32 >> dsh, r = xx / nsb, sb = xx % nsb;
    __syncthreads();
#pragma unroll
    for (int it = 0; it < 6; ++it) { const int idx = tid + NTHR * it, kk = idx >> 3, c = idx & 7;
        *(LAS v4u*)(lds + K_OFF + kk * 128 + ((c ^ ((kk >> 1) & 7)) << 4)) = P.k[it];
        *(LAS v4u*)(lds + V_OFF + (c >> 2) * VHALF + kk * 64 + (c & 3) * 16) = P.v[it]; }
    bf16x8 qr[4];
#pragma unroll
    for (int d0 = 0; d0 < 4; ++d0) qr[d0] = P.q[d0];
    const size_t qtok = (size_t)(((256 * sb + 32 * w + r32) << dsh) + r);
    __syncthreads();
    if (u + 1 < u1) attn_load(F, u + 1, P);
    f32x16 pt[5];
#pragma unroll
    for (int j = 0; j < 5; ++j) {
        pt[j] = (f32x16){0.f, 0.f, 0.f, 0.f, 0.f, 0.f, 0.f, 0.f, 0.f, 0.f, 0.f, 0.f, 0.f, 0.f, 0.f, 0.f};
        const int row = 32 * (w + j) + r32;
#pragma unroll
        for (int d0 = 0; d0 < 4; ++d0) { const bf16x8 kf = *(const LAS bf16x8*)(lds + K_OFF + row * 128 + (((2 * d0 + hi) ^ ((row >> 1) & 7)) << 4));
            pt[j] = __builtin_amdgcn_mfma_f32_32x32x16_bf16(kf, qr[d0], pt[j], 0, 0, 0); }
    }
    const float NEG = -1e30f;
#pragma unroll
    for (int rr = 0; rr < 16; ++rr) { const int kr = crow(rr, hi); if (kr < r32) pt[0][rr] = NEG; if (kr > r32) pt[4][rr] = NEG; }
    if (sb == 0) {
#pragma unroll
        for (int j = 0; j < 4; ++j) if (w + j < 4) {
#pragma unroll
            for (int rr = 0; rr < 16; ++rr) pt[j][rr] = NEG; }
    }
    float mx = NEG;
#pragma unroll
    for (int j = 0; j < 5; ++j)
#pragma unroll
        for (int rr = 0; rr < 16; ++rr) mx = fmaxf(mx, pt[j][rr]);
    mx = fmaxf(mx, __shfl_xor(mx, 32));
    float ls = 0.f;
#pragma unroll
    for (int j = 0; j < 5; ++j)
#pragma unroll
        for (int rr = 0; rr < 16; ++rr) { const float e = __builtin_amdgcn_exp2f(pt[j][rr] - mx); pt[j][rr] = e; ls += e; }
    ls += __shfl_xor(ls, 32);
    f32x16 o[2];
    o[0] = (f32x16){0.f, 0.f, 0.f, 0.f, 0.f, 0.f, 0.f, 0.f, 0.f, 0.f, 0.f, 0.f, 0.f, 0.f, 0.f, 0.f}; o[1] = o[0];
    const LAS unsigned char* vb = lds + V_OFF + ((lane >> 4) & 1) * 32 + (lane & 3) * 8 + (4 * hi + ((lane & 15) >> 2)) * 64;
#pragma unroll
    for (int j = 0; j < 5; ++j)
#pragma unroll
        for (int s = 0; s < 2; ++s) {
            v4u pw; pw.x = cvtpk(pt[j][8 * s + 0], pt[j][8 * s + 1]); pw.y = cvtpk(pt[j][8 * s + 2], pt[j][8 * s + 3]); pw.z = cvtpk(pt[j][8 * s + 4], pt[j][8 * s + 5]); pw.w = cvtpk(pt[j][8 * s + 6], pt[j][8 * s + 7]);
            const bf16x8 pa = __builtin_bit_cast(bf16x8, pw);
            const int k0 = 32 * (w + j) + 16 * s;
#pragma unroll
            for (int d0 = 0; d0 < 2; ++d0) { const LAS unsigned char* vp = vb + d0 * VHALF + k0 * 64;
                const bf16x8 vf = mk8(tr16(vp), tr16(vp + 512));
                o[d0] = __builtin_amdgcn_mfma_f32_32x32x16_bf16(pa, vf, o[d0], 0, 0, 0); }
        }
    volatile LAS float* scr = (volatile LAS float*)(lds + SCR_OFF) + w * 64;
    if (hi == 0) scr[r32] = ls;
    LDS_WAIT();
    LAS bf16* stg = (LAS bf16*)(lds + OST_OFF) + w * 2048;
#pragma unroll
    for (int rr = 0; rr < 16; ++rr) { const int orow = crow(rr, hi); const float rl = 1.0f / scr[orow];
#pragma unroll
        for (int d0 = 0; d0 < 2; ++d0) stg[orow * 64 + d0 * 32 + r32] = (bf16)(cvtpk(o[d0][rr] * rl, 0.f) & 0xffffu); }
    LDS_WAIT(); asm volatile("" ::: "memory");
    bf16* Op = F.OPART + ((size_t)p * M + (size_t)b * SEQ) * 512 + h * 64;
#pragma unroll
    for (int i = 0; i < 4; ++i) { const int row = i * 8 + (lane >> 3), ch = lane & 7; const v4u v = *(const LAS v4u*)(stg + row * 64 + ch * 8);
        const size_t tok = (size_t)(((256 * sb + 32 * w + row) << dsh) + r);
        *(GAS v4u*)(Op + tok * 512 + ch * 8) = v; }
    if (hi == 0) F.LSE[((size_t)p * M + (size_t)b * SEQ + qtok) * 8 + h] = mx + log2f(ls);
    }
}

namespace ret {
constexpr int KRP = 192, VRP = 320;
constexpr int KV_K = 0, KV_V = 128 * KRP;
static_assert(KV_V + 128 * VRP <= RING_BYTES, "ret kv LDS");
constexpr int QRP = 144;
constexpr int O_QA = 0, O_QD = 128 * QRP, O_KA = 2 * 128 * QRP, O_VA = 3 * 128 * QRP, O_SA = O_VA + 128 * VRP, O_END = O_SA + 64 * VRP;
static_assert(O_END <= RING_BYTES, "ret out LDS");
constexpr int O_OUT = 0;
}
__device__ __forceinline__ void rot8(const v4u a, const v4u bq, const f32x2v* cs, float sc, v4u& o1, v4u& o2) {
    float x1[8], x2[8], y1[8], y2[8];
    x1[0] = bf_lo(a.x); x1[1] = bf_hi(a.x); x1[2] = bf_lo(a.y); x1[3] = bf_hi(a.y); x1[4] = bf_lo(a.z); x1[5] = bf_hi(a.z); x1[6] = bf_lo(a.w); x1[7] = bf_hi(a.w);
    x2[0] = bf_lo(bq.x); x2[1] = bf_hi(bq.x); x2[2] = bf_lo(bq.y); x2[3] = bf_hi(bq.y); x2[4] = bf_lo(bq.z); x2[5] = bf_hi(bq.z); x2[6] = bf_lo(bq.w); x2[7] = bf_hi(bq.w);
#pragma unroll
    for (int i = 0; i < 8; ++i) { const f32x2v c = cs[i]; y1[i] = (x1[i] * c.x - x2[i] * c.y) * sc; y2[i] = (x1[i] * c.y + x2[i] * c.x) * sc; }
    o1.x = cvtpk(y1[0], y1[1]); o1.y = cvtpk(y1[2], y1[3]); o1.z = cvtpk(y1[4], y1[5]); o1.w = cvtpk(y1[6], y1[7]);
    o2.x = cvtpk(y2[0], y2[1]); o2.y = cvtpk(y2[2], y2[3]); o2.z = cvtpk(y2[4], y2[5]); o2.w = cvtpk(y2[6], y2[7]);
}
__device__ __forceinline__ void retkv_unit(Frame& F, int u) {
    using namespace ret;
    const int tid = F.tid, lane = F.lane, w = F.wave, r32 = lane & 31, hi = lane >> 5;
    const int bh = u >> 6, n = u & 63, b = bh >> 2, h = bh & 3;
    LAS unsigned char* lds = F.lds + RING_OFF;
    const bf16* Pb = F.PROJ + ((size_t)b * SEQ + 128 * n) * INW;
    const float lg = lg2gamma(h);
    __syncthreads();
    {
        const int j = tid >> 2, c = tid & 3, t = 128 * n + j;
        const bf16* src = Pb + (size_t)j * INW + 1792 + h * 64 + 8 * c;
        const v4u a = *(const GAS v4u*)src, bq = *(const GAS v4u*)(src + 32);
        f32x2v cs[8];
#pragma unroll
        for (int i = 0; i < 8; ++i) cs[i] = F.ROPE[t * 32 + 8 * c + i];
        v4u o1, o2; rot8(a, bq, cs, __builtin_amdgcn_exp2f(lg * (float)(127 - j)), o1, o2);
        *(LAS v4u*)(lds + KV_K + j * KRP + 16 * c) = o1; *(LAS v4u*)(lds + KV_K + j * KRP + 64 + 16 * c) = o2;
#pragma unroll
        for (int it = 0; it < 4; ++it) { const int idx = tid + NTHR * it, jj = idx >> 4, cc = idx & 15;
            *(LAS v4u*)(lds + KV_V + jj * VRP + 16 * cc) = *(const GAS v4u*)(Pb + (size_t)jj * INW + 2048 + h * 128 + 8 * cc); }
    }
    __syncthreads();
    const int dt = w & 1, et = w >> 1;
    f32x16 acc = (f32x16){0.f, 0.f, 0.f, 0.f, 0.f, 0.f, 0.f, 0.f, 0.f, 0.f, 0.f, 0.f, 0.f, 0.f, 0.f, 0.f};
    const int rq = 4 * hi + ((lane & 15) >> 2), cq = 16 * ((lane >> 4) & 1) + 4 * (lane & 3);
    const LAS unsigned char* ka = lds + KV_K + rq * KRP + (32 * dt + cq) * 2;
    const LAS unsigned char* va = lds + KV_V + rq * VRP + (32 * et + cq) * 2;
#pragma unroll
    for (int ks = 0; ks < 8; ++ks) {
        const bf16x8 af = mk8(tr16(ka + 16 * ks * KRP), tr16(ka + (16 * ks + 8) * KRP));
        const bf16x8 bfv = mk8(tr16(va + 16 * ks * VRP), tr16(va + (16 * ks + 8) * VRP));
        acc = __builtin_amdgcn_mfma_f32_32x32x16_bf16(af, bfv, acc, 0, 0, 0);
    }
    float* dst = F.KV + (size_t)u * 8192;
#pragma unroll
    for (int rr = 0; rr < 16; ++rr) dst[(32 * dt + crow(rr, hi)) * 128 + 32 * et + r32] = acc[rr];
}

__device__ __forceinline__ void p3_scan_combine(Frame& F) {
    for (int e = F.vcu * NTHR + F.tid; e < 16 * 8192; e += F.G * NTHR) {
        const int bh = e >> 13, de = e & 8191; const float cd = __builtin_amdgcn_exp2f(lg2gamma(bh & 3) * 128.0f);
        float* p = F.KV + (size_t)bh * 64 * 8192 + de; float st = 0.f;
        for (int n0 = 0; n0 < 64; n0 += 8) { float cur[8];
#pragma unroll
            for (int i = 0; i < 8; ++i) cur[i] = p[(size_t)(n0 + i) * 8192];
#pragma unroll
            for (int i = 0; i < 8; ++i) { p[(size_t)(n0 + i) * 8192] = st; st = cd * st + cur[i]; } }
    }
    for (int it = F.vcu * NTHR + F.tid; it < M * 64; it += F.G * NTHR) {
        const int row = it >> 6, h = (it >> 3) & 7, c = it & 7;
        const float l0 = F.LSE[((size_t)0 * M + row) * 8 + h], l1 = F.LSE[((size_t)1 * M + row) * 8 + h], l2 = F.LSE[((size_t)2 * M + row) * 8 + h];
        const float mx = fmaxf(l0, fmaxf(l1, l2)); float w0 = __builtin_amdgcn_exp2f(l0 - mx), w1 = __builtin_amdgcn_exp2f(l1 - mx), w2 = __builtin_amdgcn_exp2f(l2 - mx);
        const float inv = 1.0f / (w0 + w1 + w2); w0 *= inv; w1 *= inv; w2 *= inv;
        const size_t off = (size_t)row * 512 + h * 64 + c * 8;
        const v4u a = *(const GAS v4u*)(F.OPART + off), bq = *(const GAS v4u*)(F.OPART + (size_t)M * 512 + off), cq = *(const GAS v4u*)(F.OPART + (size_t)2 * M * 512 + off);
        v4u o;
        o.x = cvtpk(w0 * bf_lo(a.x) + w1 * bf_lo(bq.x) + w2 * bf_lo(cq.x), w0 * bf_hi(a.x) + w1 * bf_hi(bq.x) + w2 * bf_hi(cq.x));
        o.y = cvtpk(w0 * bf_lo(a.y) + w1 * bf_lo(bq.y) + w2 * bf_lo(cq.y), w0 * bf_hi(a.y) + w1 * bf_hi(bq.y) + w2 * bf_hi(cq.y));
        o.z = cvtpk(w0 * bf_lo(a.z) + w1 * bf_lo(bq.z) + w2 * bf_lo(cq.z), w0 * bf_hi(a.z) + w1 * bf_hi(bq.z) + w2 * bf_hi(cq.z));
        o.w = cvtpk(w0 * bf_lo(a.w) + w1 * bf_lo(bq.w) + w2 * bf_lo(cq.w), w0 * bf_hi(a.w) + w1 * bf_hi(bq.w) + w2 * bf_hi(cq.w));
        *(GAS v4u*)(F.MIXED + (size_t)row * DM + h * 64 + c * 8) = o;
    }
}

__device__ __forceinline__ void retout_unit(Frame& F, int u) {
    using namespace ret;
    const int tid = F.tid, lane = F.lane, w = F.wave, r32 = lane & 31, hi = lane >> 5;
    const int bh = u >> 6, n = u & 63, b = bh >> 2, h = bh & 3;
    LAS unsigned char* lds = F.lds + RING_OFF;
    const size_t row0 = (size_t)b * SEQ + 128 * n;
    const bf16* Pb = F.PROJ + row0 * INW;
    const float lg = lg2gamma(h);
    __syncthreads();
    {
        const int i = tid >> 2, c = tid & 3, t = 128 * n + i;
        f32x2v cs[8];
#pragma unroll
        for (int k = 0; k < 8; ++k) cs[k] = F.ROPE[t * 32 + 8 * c + k];
        const bf16* sq = Pb + (size_t)i * INW + 1536 + h * 64 + 8 * c;
        v4u a = *(const GAS v4u*)sq, bq = *(const GAS v4u*)(sq + 32), o1, o2;
        rot8(a, bq, cs, 1.0f, o1, o2);
        *(LAS v4u*)(lds + O_QA + i * QRP + 16 * c) = o1; *(LAS v4u*)(lds + O_QA + i * QRP + 64 + 16 * c) = o2;
        rot8(a, bq, cs, __builtin_amdgcn_exp2f(lg * (float)(i + 1)), o1, o2);
        *(LAS v4u*)(lds + O_QD + i * QRP + 16 * c) = o1; *(LAS v4u*)(lds + O_QD + i * QRP + 64 + 16 * c) = o2;
        const bf16* sk = Pb + (size_t)i * INW + 1792 + h * 64 + 8 * c;
        a = *(const GAS v4u*)sk; bq = *(const GAS v4u*)(sk + 32);
        rot8(a, bq, cs, 1.0f, o1, o2);
        *(LAS v4u*)(lds + O_KA + i * QRP + 16 * c) = o1; *(LAS v4u*)(lds + O_KA + i * QRP + 64 + 16 * c) = o2;
#pragma unroll
        for (int it = 0; it < 4; ++it) { const int idx = tid + NTHR * it, jj = idx >> 4, cc = idx & 15;
            *(LAS v4u*)(lds + O_VA + jj * VRP + 16 * cc) = *(const GAS v4u*)(Pb + (size_t)jj * INW + 2048 + h * 128 + 8 * cc); }
        const float* sp = F.KV + (size_t)u * 8192 + tid * 16; const int sd = tid >> 3, se = (tid & 7) * 16;
        const f32x4 s0 = *(const GAS f32x4*)sp, s1 = *(const GAS f32x4*)(sp + 4), s2 = *(const GAS f32x4*)(sp + 8), s3 = *(const GAS f32x4*)(sp + 12);
        v4u q0, q1; q0.x = cvtpk(s0.x, s0.y); q0.y = cvtpk(s0.z, s0.w); q0.z = cvtpk(s1.x, s1.y); q0.w = cvtpk(s1.z, s1.w);
        q1.x = cvtpk(s2.x, s2.y); q1.y = cvtpk(s2.z, s2.w); q1.z = cvtpk(s3.x, s3.y); q1.w = cvtpk(s3.z, s3.w);
        *(LAS v4u*)(lds + O_SA + sd * VRP + se * 2) = q0; *(LAS v4u*)(lds + O_SA + sd * VRP + se * 2 + 16) = q1;
    }
    __syncthreads();
    const int qt = w & 3, eh = w >> 2;
    bf16x8 qf[4], qd[4];
#pragma unroll
    for (int ds = 0; ds < 4; ++ds) { qf[ds] = *(const LAS bf16x8*)(lds + O_QA + (32 * qt + r32) * QRP + (2 * ds + hi) * 16); qd[ds] = *(const LAS bf16x8*)(lds + O_QD + (32 * qt + r32) * QRP + (2 * ds + hi) * 16); }
    f32x16 o[2];
    o[0] = (f32x16){0.f, 0.f, 0.f, 0.f, 0.f, 0.f, 0.f, 0.f, 0.f, 0.f, 0.f, 0.f, 0.f, 0.f, 0.f, 0.f}; o[1] = o[0];
    const int rq = (lane & 15) >> 2, cq = 16 * ((lane >> 4) & 1) + 4 * (lane & 3);
#pragma unroll
    for (int kt = 0; kt < 4; ++kt) if (kt <= qt) {
        f32x16 pt = (f32x16){0.f, 0.f, 0.f, 0.f, 0.f, 0.f, 0.f, 0.f, 0.f, 0.f, 0.f, 0.f, 0.f, 0.f, 0.f, 0.f};
#pragma unroll
        for (int ds = 0; ds < 4; ++ds) { const bf16x8 kf = *(const LAS bf16x8*)(lds + O_KA + (32 * kt + r32) * QRP + (2 * ds + hi) * 16);
            pt = __builtin_amdgcn_mfma_f32_32x32x16_bf16(kf, qf[ds], pt, 0, 0, 0); }
#pragma unroll
        for (int rr = 0; rr < 16; ++rr) { const int dd = (32 * qt + r32) - (32 * kt + crow(rr, hi)); pt[rr] = (dd >= 0) ? pt[rr] * __builtin_amdgcn_exp2f(lg * (float)dd) : 0.f; }
#pragma unroll
        for (int s = 0; s < 2; ++s) {
            v4u pw; pw.x = cvtpk(pt[8 * s + 0], pt[8 * s + 1]); pw.y = cvtpk(pt[8 * s + 2], pt[8 * s + 3]); pw.z = cvtpk(pt[8 * s + 4], pt[8 * s + 5]); pw.w = cvtpk(pt[8 * s + 6], pt[8 * s + 7]);
            const bf16x8 pa = __builtin_bit_cast(bf16x8, pw);
#pragma unroll
            for (int d0 = 0; d0 < 2; ++d0) { const LAS unsigned char* vp = lds + O_VA + (32 * kt + 16 * s + 4 * hi + rq) * VRP + (64 * eh + 32 * d0 + cq) * 2;
                o[d0] = __builtin_amdgcn_mfma_f32_32x32x16_bf16(pa, mk8(tr16(vp), tr16(vp + 8 * VRP)), o[d0], 0, 0, 0); }
        }
    }
#pragma unroll
    for (int ds = 0; ds < 4; ++ds)
#pragma unroll
        for (int d0 = 0; d0 < 2; ++d0) { const LAS unsigned char* sp = lds + O_SA + (16 * ds + 8 * hi + rq) * VRP + (64 * eh + 32 * d0 + cq) * 2;
            o[d0] = __builtin_amdgcn_mfma_f32_32x32x16_bf16(qd[ds], mk8(tr16(sp), tr16(sp + 4 * VRP)), o[d0], 0, 0, 0); }
    __syncthreads();
    LAS float* outl = (LAS float*)(lds + O_OUT);
#pragma unroll
    for (int rr = 0; rr < 16; ++rr)
#pragma unroll
        for (int d0 = 0; d0 < 2; ++d0) outl[(32 * qt + crow(rr, hi)) * 128 + 64 * eh + 32 * d0 + r32] = o[d0][rr];
    __syncthreads();
    {
        const int i = tid >> 2, part = tid & 3;
        float v[32]; float ss = 0.f;
#pragma unroll
        for (int k = 0; k < 8; ++k) { const f32x4 t4 = *(const LAS f32x4*)(outl + i * 128 + 32 * part + 4 * k); v[4 * k] = t4.x; v[4 * k + 1] = t4.y; v[4 * k + 2] = t4.z; v[4 * k + 3] = t4.w; ss += (t4.x * t4.x + t4.y * t4.y) + (t4.z * t4.z + t4.w * t4.w); }
        ss += __shfl_xor(ss, 1); ss += __shfl_xor(ss, 2);
        const float rstd = 1.0f / sqrtf(ss * (1.0f / 128.0f) + NORM_EPS);
        const bf16* gp = Pb + (size_t)i * INW + 2560 + h * 128 + 32 * part;
        bf16* op = F.MIXED + (row0 + i) * DM + 512 + h * 128 + 32 * part;
#pragma unroll
        for (int k = 0; k < 4; ++k) { const v4u g = *(const GAS v4u*)(gp + 8 * k); float gv[8];
            gv[0] = bf_lo(g.x); gv[1] = bf_hi(g.x); gv[2] = bf_lo(g.y); gv[3] = bf_hi(g.y); gv[4] = bf_lo(g.z); gv[5] = bf_hi(g.z); gv[6] = bf_lo(g.w); gv[7] = bf_hi(g.w);
            float ov[8];
#pragma unroll
            for (int q = 0; q < 8; ++q) { const float sg = gv[q] * __builtin_amdgcn_rcpf(1.0f + __builtin_amdgcn_exp2f(-1.4426950408889634f * gv[q])); ov[q] = v[8 * k + q] * rstd * sg; }
            v4u ow; ow.x = cvtpk(ov[0], ov[1]); ow.y = cvtpk(ov[2], ov[3]); ow.z = cvtpk(ov[4], ov[5]); ow.w = cvtpk(ov[6], ov[7]);
            *(GAS v4u*)(op + 8 * k) = ow; }
    }
}

__device__ __forceinline__ void load_bf16_row(const bf16* row, int lane, f32x4 (&v)[4]) {
    const GAS u32x2* p = (const GAS u32x2*)row + lane;
#pragma unroll
    for (int j = 0; j < 4; ++j) { const u32x2 w = p[64 * j]; v[j] = (f32x4){bf_lo(w.x), bf_hi(w.x), bf_lo(w.y), bf_hi(w.y)}; }
}
__device__ __forceinline__ float sumsq4(const f32x4 (&v)[4]) { float s = 0.f;
#pragma unroll
    for (int j = 0; j < 4; ++j) s += (v[j].x * v[j].x + v[j].y * v[j].y) + (v[j].z * v[j].z + v[j].w * v[j].w);
    return s; }
__device__ __forceinline__ void p6_resnorm(Frame& F) {
    constexpr int R = 4;
    const int gw = F.vcu * NWAVES + F.wave, NGW = F.G * NWAVES, lane = F.lane;
    const GAS f32x4* g2 = (const GAS f32x4*)F.g_post + lane; const GAS f32x4* g3 = (const GAS f32x4*)F.g_fpre + lane;
    for (int m0 = gw * R; m0 < M; m0 += NGW * R) {
        f32x4 a[R][4], xv[R][4];
#pragma unroll
        for (int r = 0; r < R; ++r) { load_bf16_row(F.MIX + (size_t)(m0 + r) * DM, lane, a[r]); const GAS f32x4* xr = (const GAS f32x4*)(F.x + (size_t)(m0 + r) * DM) + lane;
#pragma unroll
            for (int j = 0; j < 4; ++j) xv[r][j] = xr[64 * j]; }
        float s[R];
#pragma unroll
        for (int r = 0; r < R; ++r) s[r] = sumsq4(a[r]);
#pragma unroll
        for (int o = 1; o < 64; o <<= 1) {
#pragma unroll
            for (int r = 0; r < R; ++r) s[r] += __shfl_xor(s[r], o); }
#pragma unroll
        for (int r = 0; r < R; ++r) { const float r2 = 1.f / sqrtf(s[r] * (1.f / DM) + NORM_EPS); GAS unsigned long long* x1b = (GAS unsigned long long*)(F.MIX + (size_t)(m0 + r) * DM) + lane;
#pragma unroll
            for (int j = 0; j < 4; ++j) { a[r][j] = xv[r][j] + a[r][j] * r2 * g2[64 * j];
                x1b[64 * j] = (unsigned long long)cvtpk(a[r][j].x, a[r][j].y) | ((unsigned long long)cvtpk(a[r][j].z, a[r][j].w) << 32); }
            s[r] = sumsq4(a[r]); }
#pragma unroll
        for (int o = 1; o < 64; o <<= 1) {
#pragma unroll
            for (int r = 0; r < R; ++r) s[r] += __shfl_xor(s[r], o); }
#pragma unroll
        for (int r = 0; r < R; ++r) { const float r3 = 1.f / sqrtf(s[r] * (1.f / DM) + NORM_EPS); GAS unsigned long long* o8 = (GAS unsigned long long*)(F.XN + (size_t)(m0 + r) * DM) + lane;
#pragma unroll
            for (int j = 0; j < 4; ++j) { const f32x4 g = g3[64 * j]; o8[64 * j] = (unsigned long long)cvtpk(a[r][j].x * r3 * g.x, a[r][j].y * r3 * g.y) | ((unsigned long long)cvtpk(a[r][j].z * r3 * g.z, a[r][j].w * r3 * g.w) << 32); } }
    }
}
__device__ __forceinline__ void p10_final(Frame& F, const float dscale, const float dadd) {
    constexpr int R = 4;
    const int gw = F.vcu * NWAVES + F.wave, NGW = F.G * NWAVES, lane = F.lane;
    const GAS f32x4* g4 = (const GAS f32x4*)F.g_fpost + lane;
    for (int m0 = gw * R; m0 < M; m0 += NGW * R) {
        f32x4 a[R][4], xv[R][4];
#pragma unroll
        for (int r = 0; r < R; ++r) { load_bf16_row(F.FFN + (size_t)(m0 + r) * DM, lane, a[r]); load_bf16_row(F.MIX + (size_t)(m0 + r) * DM, lane, xv[r]); }
        float s[R];
#pragma unroll
        for (int r = 0; r < R; ++r) s[r] = sumsq4(a[r]);
#pragma unroll
        for (int o = 1; o < 64; o <<= 1) {
#pragma unroll
            for (int r = 0; r < R; ++r) s[r] += __shfl_xor(s[r], o); }
#pragma unroll
        for (int r = 0; r < R; ++r) { const float r4 = 1.f / sqrtf(s[r] * (1.f / DM) + NORM_EPS); GAS f32x4* orow = (GAS f32x4*)(F.out + (size_t)(m0 + r) * DM) + lane;
#pragma unroll
            for (int j = 0; j < 4; ++j) { f32x4 o = (xv[r][j] + a[r][j] * r4 * g4[64 * j]) * dscale; if (m0 + r == 0 && lane == 0 && j == 0) o.x += dadd; orow[64 * j] = o; } }
    }
}
__device__ __forceinline__ void p8_fixup(Frame& F) {
    for (int it = F.vcu * NTHR + F.tid; it < (M / 64) * 2 * FF; it += F.G * NTHR) {
        const int ri = it / FF, j = it % FF, g = ri >> 1, which = ri & 1; const bool first = (g % (SEQ / 64)) == 0;
        float y[2];
#pragma unroll
        for (int hf = 0; hf < 2; ++hf) {
            const float* ubg = F.UB + ((size_t)g * 8 + hf) * FF + j;
            const float* ubp = ubg - (size_t)8 * FF;
            const int c = hf * FF + j;
            const float ut = ubg[(size_t)(2 + which) * 2 * FF];
            const float u1 = which ? ubg[(size_t)2 * 2 * FF] : (first ? 0.f : ubp[(size_t)1 * 2 * FF]);
            const float u2 = first ? 0.f : (which ? ubp[(size_t)1 * 2 * FF] : ubp[0]);
            y[hf] = F.conv_b[c] + F.conv_w[2 * FF2 + c] * ut + F.conv_w[FF2 + c] * u1 + F.conv_w[c] * u2;
        }
        const float a = pg8::gelu_tanh_f(y[0]) * y[1];
        F.ACT[(size_t)(64 * g + which) * FF + j] = (bf16)(cvtpk(a, 0.f) & 0xffffu);
    }
}

struct Args { const float* in[11]; float* out; unsigned char* ws; int ph_lo, ph_hi, li, pad; };
__global__ void __launch_bounds__(NTHR, 2) mk_fwd(Args args) {
    extern __shared__ __attribute__((aligned(16))) unsigned char lds[];
    Frame F;
    F.lds = (LAS unsigned char*)lds;
    F.MISC = (volatile LAS unsigned*)(F.lds + MISC_OFF);
    F.tid = threadIdx.x; F.lane = F.tid & 63; F.wave = __builtin_amdgcn_readfirstlane(F.tid >> 6);
    F.G = gridDim.x; { const int bx = blockIdx.x; F.vcu = (F.G % 8 == 0) ? (bx % 8) * (F.G / 8) + bx / 8 : bx; }
    unsigned char* ws = args.ws;
    F.ctl = (gu32*)(ws + WS_CTL);
    F.x = args.in[0]; F.g_pre = args.in[1]; F.g_post = args.in[2]; F.w_in = args.in[3]; F.w_out = args.in[4]; F.g_fpre = args.in[5]; F.g_fpost = args.in[6];
    F.w_up = args.in[7]; F.conv_w = args.in[8]; F.conv_b = args.in[9]; F.w_down = args.in[10]; F.out = args.out;
    F.Win_t = (bf16*)(ws + WS_WIN); F.Wout_t = (bf16*)(ws + WS_WOUT); F.Wup_t = (bf16*)(ws + WS_WUP); F.Wdn_t = (bf16*)(ws + WS_WDN);
    F.XN = (bf16*)(ws + WS_XN); F.PROJ = (bf16*)(ws + WS_PROJ); F.ACT = (bf16*)(ws + WS_ACT); F.OPART = (bf16*)(ws + WS_OPART); F.MIX = (bf16*)(ws + WS_MIX);
    F.FFN = (bf16*)(ws + WS_FFN); F.MIXED = (bf16*)(ws + WS_MIXED); F.LSE = (float*)(ws + WS_LSE); F.UB = (float*)(ws + WS_UB); F.KV = (float*)(ws + WS_KV);
    F.ROPE = (f32x2v*)(ws + WS_ROPE);
    for (int u = F.tid; u < (LDS_BYTES - LDSCTL_OFF) / 4; u += NTHR) ((LAS unsigned*)(F.lds + LDSCTL_OFF))[u] = 0u;
    __syncthreads();
    XcdBarrier bar; bar.bar = (unsigned*)(F.ctl + CW_BAR) + args.li * XCD_BAR_WORDS; bar.x = 0; bar.st = nullptr;
    const int lo = args.ph_lo, hi = args.ph_hi;
    if (hi - lo > 1) bar = xcd_barrier_post((unsigned*)(F.ctl + CW_BAR) + args.li * XCD_BAR_WORDS, F.MISC + 8);
#define IN(k) (lo <= (k) && (k) < hi)
#ifndef MK_REP_MASK
#define MK_REP_MASK 0
#endif
#define REPEAT(k) _Pragma("unroll") for (int rep_ = 0, nrep_ = ((MK_REP_MASK >> (k)) & 1) ? 2 : 1; rep_ < nrep_; ++rep_)
#define REPSYNC(k) do { if (rep_ + 1 < nrep_) xcd_barrier(bar); } while (0)
#ifdef MK_DIAG_A
    unsigned long long* const tsb = (unsigned long long*)(ws + WS_CTL + 32768);
    if (blockIdx.x == 0 && F.tid == 0) tsb[0] = __builtin_amdgcn_s_memrealtime();
#define SEAM(k) do { if (IN(k) && IN((k) + 1)) { xcd_barrier(bar); if (blockIdx.x == 0 && F.tid == 0) { tsb[(k) + 1] = __builtin_amdgcn_s_memrealtime(); asm volatile("s_waitcnt vmcnt(0)" ::: "memory"); } } } while (0)
#else
#define SEAM(k) do { if (IN(k) && IN((k) + 1)) xcd_barrier(bar); } while (0)
#endif

    if (IN(0)) { REPEAT(0) { p0_prep(F); REPSYNC(0); } SEAM(0); }
    if (IN(1)) {
        pg8::Gemm g{F.XN, F.Win_t, M, INW, DM}; pg8::StaticOrder S; S.init(M, INW, F.G, (int)blockIdx.x);
        pg8::EpiStore E{F.PROJ, INW, 2, QSCALE, 7, 0.125f};
        REPEAT(1) { pg8::gemm_phase<pg8::EpiStore, pg8::StaticOrder, true, true>(F.lds + RING_OFF, g, S, E); REPSYNC(1); }
        SEAM(1);
    }
    if (IN(2)) { REPEAT(2) {
        { const int NU = 3 * 1024; const int u0 = (int)((long)F.vcu * NU / F.G), u1 = (int)((long)(F.vcu + 1) * NU / F.G); attn_units(F, u0, u1); }
        { const int NU = 1024; const int u0 = (int)((long)F.vcu * NU / F.G), u1 = (int)((long)(F.vcu + 1) * NU / F.G); for (int u = u0; u < u1; ++u) retkv_unit(F, u); }
        __syncthreads(); REPSYNC(2); }
        SEAM(2);
    }
    if (IN(3)) { p3_scan_combine(F); SEAM(3); }
    if (IN(4)) { REPEAT(4) {
        { const int NU = 1024; const int u0 = (int)((long)F.vcu * NU / F.G), u1 = (int)((long)(F.vcu + 1) * NU / F.G); for (int u = u0; u < u1; ++u) retout_unit(F, u); }
        __syncthreads(); REPSYNC(4); }
        SEAM(4);
    }
    if (IN(5)) {
        pg8::Gemm g{F.MIXED, F.Wout_t, M, DM, DM}; pg8::StaticOrder S; S.init(M, DM, F.G, (int)blockIdx.x);
        pg8::EpiStore E{F.MIX, DM, 0, 1.0f, -1, 1.0f};
        REPEAT(5) { pg8::gemm_phase<pg8::EpiStore, pg8::StaticOrder, true, true>(F.lds + RING_OFF, g, S, E); REPSYNC(5); }
        SEAM(5);
    }
    if (IN(6)) { REPEAT(6) { p6_resnorm(F); REPSYNC(6); } SEAM(6); }
    if (IN(7)) {
        pg8::Gemm g{F.XN, F.Wup_t, M, FF2, DM}; pg8::StaticOrder S; S.init(M, FF2, F.G, (int)blockIdx.x);
        pg8::EpiConvAct E{F.ACT, F.UB, F.conv_w, F.conv_b};
        REPEAT(7) { pg8::gemm_phase<pg8::EpiConvAct, pg8::StaticOrder, true, true>(F.lds + RING_OFF, g, S, E); REPSYNC(7); }
        SEAM(7);
    }
    if (IN(8)) { REPEAT(8) { p8_fixup(F); REPSYNC(8); } SEAM(8); }
    if (IN(9)) {
        pg8::Gemm g{F.ACT, F.Wdn_t, M, DM, FF}; pg8::StaticOrder S; S.init(M, DM, F.G, (int)blockIdx.x);
        pg8::EpiStore E{F.FFN, DM, 0, 1.0f, -1, 1.0f};
        REPEAT(9) { pg8::gemm_phase<pg8::EpiStore, pg8::StaticOrder, true, true>(F.lds + RING_OFF, g, S, E); REPSYNC(9); }
        SEAM(9);
    }
#ifdef MK_DIAG_A
    if (IN(10)) { const unsigned long long* tsr = (const unsigned long long*)(ws + WS_CTL + 32768);
        const float dA = (float)(__hip_atomic_load(tsr + MK_DIAG_A + 1, __ATOMIC_RELAXED, __HIP_MEMORY_SCOPE_AGENT) - __hip_atomic_load(tsr + MK_DIAG_A, __ATOMIC_RELAXED, __HIP_MEMORY_SCOPE_AGENT)) * 0.01f;
        const float dB = (float)(__hip_atomic_load(tsr + MK_DIAG_B + 1, __ATOMIC_RELAXED, __HIP_MEMORY_SCOPE_AGENT) - __hip_atomic_load(tsr + MK_DIAG_B, __ATOMIC_RELAXED, __HIP_MEMORY_SCOPE_AGENT)) * 0.01f;
        p10_final(F, 1.0f + dA * MK_DIAG_SCALE, dB); }
#else
    if (IN(10)) { p10_final(F, 1.0f, 0.0f); }
#endif
#undef IN
#undef SEAM
}

extern "C" void kernel_launch(void* const* d_in, const int* in_sizes, int n_in, void* d_out, int out_size, void* d_ws, size_t ws_size, hipStream_t stream) {
    static int grid = 0;
    if (grid == 0) {
        if (n_in != 11 || in_sizes[0] != M * DM || out_size != M * DM || ws_size < WS_END) { fprintf(stderr, "kernel_launch: unexpected shapes (n_in %d in0 %d out %d ws %zu); nothing launched\n", n_in, n_in > 0 ? in_sizes[0] : -1, out_size, ws_size); grid = -1; return; }
        int dev = 0, cus = 0, per_cu = 0;
        if (hipGetDevice(&dev) != hipSuccess || hipDeviceGetAttribute(&cus, hipDeviceAttributeMultiprocessorCount, dev) != hipSuccess) { grid = -1; return; }
        if (hipFuncSetAttribute((const void*)mk_fwd, hipFuncAttributeMaxDynamicSharedMemorySize, LDS_BYTES) != hipSuccess) { fprintf(stderr, "kernel_launch: hipFuncSetAttribute failed\n"); grid = -1; return; }
        if (hipOccupancyMaxActiveBlocksPerMultiprocessor(&per_cu, (const void*)mk_fwd, NTHR, LDS_BYTES) != hipSuccess || per_cu < 1) fprintf(stderr, "kernel_launch: occupancy query says %d blocks per CU\n", per_cu);
        (void)hipGetLastError();
        grid = cus;
    }
    if (grid < 0) return;
    if (hipMemsetAsync((char*)d_ws + WS_CTL, 0, CTL_ZERO_BYTES, stream) != hipSuccess) return;
    Args a{};
    for (int i = 0; i < 11; ++i) a.in[i] = (const float*)d_in[i];
    a.out = (float*)d_out; a.ws = (unsigned char*)d_ws;
#if MK_N_LAUNCHES == 1
    a.ph_lo = 0; a.ph_hi = N_PHASES; a.li = 0;
    hipLaunchKernelGGL(mk_fwd, dim3(grid), dim3(NTHR), LDS_BYTES, stream, a);
#else
    for (int li = 0; li < N_PHASES; ++li) { a.ph_lo = li; a.ph_hi = li + 1; a.li = 0; hipLaunchKernelGGL(mk_fwd, dim3(grid), dim3(NTHR), LDS_BYTES, stream, a); }
#endif
}
```

```cpp
#include <hip/hip_runtime.h>
#include <cstdio>
#include <cstdint>
#define MK_N_LAUNCHES 1

namespace pg8 {
#define PG8_LAS __attribute__((address_space(3)))
typedef unsigned short bf16_t;
typedef short bf16x8 __attribute__((ext_vector_type(8)));
typedef float f32x4 __attribute__((ext_vector_type(4)));
typedef unsigned u32x4 __attribute__((ext_vector_type(4)));
constexpr int BM = 256, BK = 64, HALF = 128, HTB = HALF * BK * 2  , STAGE_BYTES = 8 * HTB, NXCD = 8, WGM = 8;

__host__ __device__ __forceinline__ int lds_byte(int r, int c) { const int st = (r >> 4) * 2 + (c >> 5), rr = r & 15, cc = c & 31, ob = rr * 64 + cc * 2; return st * 1024 + (ob ^ (((ob >> 9) & 1) << 5)); }
__host__ __device__ __forceinline__ void stage_rc(int b, int& R, int& C) { const int st = b / 1024, sb = b % 1024, swz = sb ^ (((sb >> 9) & 1) << 5); R = (st >> 1) * 16 + swz / 64; C = (st & 1) * 32 + (swz % 64) / 2; }
__host__ __device__ __forceinline__ int perm32(int rho) { const int n = rho >> 4, i = rho & 15; return 8 * (i >> 2) + 4 * n + (i & 3); }

struct Unit { int pm, pn; };
struct Gemm { const bf16_t* A; const bf16_t* Bt; int M, N, K; };

struct StaticOrder {
    int nM, nN, nwg, G, c;
    __host__ __device__ void init(int M, int N, int G_, int c_) { nM = M / BM; nN = N / BM; nwg = nM * nN; G = G_; c = c_; }
    __host__ __device__ bool next(int i, Unit& u) const {
        const long L = (long)i * G + c; if (L >= nwg) return false;
        int wgid = (int)L; { const int q = nwg / NXCD, r = nwg % NXCD, xcd = wgid % NXCD, off = wgid / NXCD; wgid = (xcd < r ? xcd * (q + 1) : r * (q + 1) + (xcd - r) * q) + off; }
        const int nig = WGM * nN, gid = wgid / nig, fm = gid * WGM, gsz = (nM - fm) < WGM ? (nM - fm) : WGM;
        u.pm = fm + ((wgid % nig) % gsz); u.pn = (wgid % nig) / gsz; return true;
    }
    __device__ __forceinline__ void a_ready(const Unit&) const {}
    __device__ __forceinline__ void done(const Unit&) const {}
};

__device__ __forceinline__ unsigned cvt_pk_bf16(float lo, float hi) { unsigned r; asm volatile("v_cvt_pk_bf16_f32 %0, %1, %2" : "=v"(r) : "v"(lo), "v"(hi)); return r; }
typedef float f32x2 __attribute__((ext_vector_type(2)));
__device__ __forceinline__ f32x2 gelu_pk(f32x2 v) {
    const f32x2 av = __builtin_elementwise_abs(v), d = av * 0.2316418882f + 1.0f;
    f32x2 t; t.x = __builtin_amdgcn_rcpf(d.x); t.y = __builtin_amdgcn_rcpf(d.y);
    f32x2 q = t * 0.5307027145f + (-0.7265760135f); q = q * t + 0.7107068705f; q = q * t + (-0.142248368f); q = q * t + 0.127414796f; q = q * t;
    const f32x2 s = (v * v) * (-0.72134752044f);
    f32x2 e; e.x = __builtin_amdgcn_exp2f(s.x); e.y = __builtin_amdgcn_exp2f(s.y);
    const f32x2 m = v * (q * e), r = v - m;
    f32x2 o; o.x = v.x < 0.f ? m.x : r.x; o.y = v.y < 0.f ? m.y : r.y; return o;
}

template <int ACT  > struct EpiBf16 {
    static constexpr bool PERM = true, AFTER_DRAIN = false; static_assert(ACT == 0 || ACT == 1, "EpiBf16: ACT is 0 (none) or 1 (gelu_pk)");
    bf16_t* O; int ldc; const float* bias; int split_cols; size_t split_stride; float scale0;
    __device__ __forceinline__ void operator()(const f32x4 (&acc)[2][2][4][2], const Unit& u, int wr, int wc, int fr, int fq) const {
        const int row0 = u.pm * BM + wr * 64 + fr; int colt = u.pn * BM; bf16_t* base = O;
        float sc = 1.f; if (split_cols) { const int t = colt / split_cols; base += (size_t)t * split_stride; colt -= t * split_cols; if (t == 0) sc = scale0; }
        const int col0 = colt + wc * 32 + 8 * fq, bcol0 = u.pn * BM + wc * 32 + 8 * fq;
        f32x4 bv[2][2];
#pragma unroll
        for (int bj = 0; bj < 2; ++bj)
#pragma unroll
            for (int n = 0; n < 2; ++n) bv[bj][n] = bias ? *(const f32x4*)(bias + bcol0 + bj * HALF + 4 * n) : (f32x4){0.f, 0.f, 0.f, 0.f};
#pragma unroll
        for (int ai = 0; ai < 2; ++ai)
#pragma unroll
            for (int m = 0; m < 4; ++m) { bf16_t* rowp = base + (size_t)(row0 + ai * HALF + m * 16) * ldc + col0;
#pragma unroll
                for (int bj = 0; bj < 2; ++bj) { f32x4 v0 = acc[ai][bj][m][0] + bv[bj][0], v1 = acc[ai][bj][m][1] + bv[bj][1];
                    if (ACT == 1) { f32x2 a = gelu_pk((f32x2){v0[0], v0[1]}), b = gelu_pk((f32x2){v0[2], v0[3]}), c = gelu_pk((f32x2){v1[0], v1[1]}), d = gelu_pk((f32x2){v1[2], v1[3]});
                        v0 = (f32x4){a.x, a.y, b.x, b.y}; v1 = (f32x4){c.x, c.y, d.x, d.y}; }
                    v0 = v0 * sc; v1 = v1 * sc; u32x4 w; w.x = cvt_pk_bf16(v0[0], v0[1]); w.y = cvt_pk_bf16(v0[2], v0[3]); w.z = cvt_pk_bf16(v1[0], v1[1]); w.w = cvt_pk_bf16(v1[2], v1[3]);
                    *(u32x4*)(rowp + bj * HALF) = w; } }
    }
};

struct PanelStats {
    unsigned* xbuf;
    unsigned* cnt;
    unsigned* tmo;
    int ntn; float eps;
    unsigned code;
    __device__ __forceinline__ bool run(const f32x4 (&v)[2][2][4][2], const Unit& u, int wr, int wc, int fr, int fq, PG8_LAS unsigned char* lds, int wid, int lane) const {
        typedef float f32x2v __attribute__((ext_vector_type(2)));
        PG8_LAS f32x2v* P = (PG8_LAS f32x2v*)lds;
        PG8_LAS f32x2v* S = (PG8_LAS f32x2v*)(lds + 8192);
        PG8_LAS unsigned* flag = (PG8_LAS unsigned*)(lds + 8192 + 2048);
#pragma unroll
        for (int ai = 0; ai < 2; ++ai)
#pragma unroll
            for (int m = 0; m < 4; ++m) {
                float s = 0.f;
#pragma unroll
                for (int bj = 0; bj < 2; ++bj)
#pragma unroll
                    for (int n = 0; n < 2; ++n) { const f32x4 x = v[ai][bj][m][n]; s += (x[0] + x[1]) + (x[2] + x[3]); }
                s += __shfl_xor(s, 16); s += __shfl_xor(s, 32);
                const float mw = s * (1.0f / 64.0f); float q = 0.f;
#pragma unroll
                for (int bj = 0; bj < 2; ++bj)
#pragma unroll
                    for (int n = 0; n < 2; ++n) { const f32x4 d = v[ai][bj][m][n] - mw; q += (d[0] * d[0] + d[1] * d[1]) + (d[2] * d[2] + d[3] * d[3]); }
                q += __shfl_xor(q, 16); q += __shfl_xor(q, 32);
                if (fq == 0) P[(ai * HALF + wr * 64 + m * 16 + fr) * 4 + wc] = (f32x2v){mw, q};
            }
        asm volatile("s_waitcnt lgkmcnt(0)" ::: "memory"); __builtin_amdgcn_s_barrier(); asm volatile("" ::: "memory");
#if defined(BROKEN_EXCHANGE_NO_WAIT)
#warning BROKEN CONTROL BUILD: the row-statistics exchange does not wait; results are wrong by design
        if (blockIdx.x >= 64) { const long long t0_ = clock64(); while (clock64() - t0_ < 60000) __builtin_amdgcn_s_sleep(8); }
#endif
        const int row = wid * 32 + (lane & 31);
        if (lane < 32) {
            const f32x2v a = P[row * 4 + 0], b = P[row * 4 + 1], c = P[row * 4 + 2], d = P[row * 4 + 3];
            const float mt = (a.x + b.x + c.x + d.x) * 0.25f;
            const float da = a.x - mt, db = b.x - mt, dc = c.x - mt, dd = d.x - mt;
            const float m2 = (a.y + b.y) + (c.y + d.y) + 64.0f * ((da * da + db * db) + (dc * dc + dd * dd));
            unsigned long long* slot = (unsigned long long*)xbuf + ((size_t)(u.pm * BM + row) * 4 + u.pn);
            __hip_atomic_store(slot, ((unsigned long long)__float_as_uint(m2) << 32) | __float_as_uint(mt), __ATOMIC_RELAXED, __HIP_MEMORY_SCOPE_AGENT);
        }
        asm volatile("s_waitcnt vmcnt(0)" ::: "memory");
        if (lane == 0) __hip_atomic_fetch_add(cnt + 64 * u.pm, 1u, __ATOMIC_RELAXED, __HIP_MEMORY_SCOPE_AGENT);
        if (wid == 0) {
            bool dead = false; const unsigned long long t0 = __builtin_amdgcn_s_memrealtime(); const unsigned want = 8u * (unsigned)ntn;
            for (;;) {
#if defined(BROKEN_EXCHANGE_NO_WAIT)
                break;
#endif
                if ((unsigned)__builtin_amdgcn_readfirstlane(__hip_atomic_load(cnt + 64 * u.pm, __ATOMIC_RELAXED, __HIP_MEMORY_SCOPE_AGENT)) >= want) break;
                if (__builtin_amdgcn_s_memrealtime() - t0 > 2000000ull) {
                    if (lane == 0) { unsigned expect = 0u; __hip_atomic_compare_exchange_strong(tmo + 1, &expect, code | (unsigned)(u.pm & 0xff), __ATOMIC_RELAXED, __ATOMIC_RELAXED, __HIP_MEMORY_SCOPE_AGENT);
                                     __hip_atomic_store(tmo, 1u, __ATOMIC_RELAXED, __HIP_MEMORY_SCOPE_AGENT); }
                    dead = true; break; }
                __builtin_amdgcn_s_sleep(2);
            }
            __builtin_amdgcn_fence(__ATOMIC_ACQUIRE, "agent");
            if (lane == 0) flag[0] = dead ? 1u : 0u;
        }
        asm volatile("s_waitcnt vmcnt(0) lgkmcnt(0)" ::: "memory"); __builtin_amdgcn_s_barrier(); asm volatile("" ::: "memory");
        const bool bad = flag[0] != 0u;
        if (lane < 32) {
            const unsigned long long* slot = (const unsigned long long*)xbuf + (size_t)(u.pm * BM + row) * 4; float mt[4], m2[4]; float ms = 0.f;
#pragma unroll
            for (int t = 0; t < 4; ++t) { if (t < ntn) { const unsigned long long w = __hip_atomic_load(slot + t, __ATOMIC_RELAXED, __HIP_MEMORY_SCOPE_AGENT); mt[t] = __uint_as_float((unsigned)w); m2[t] = __uint_as_float((unsigned)(w >> 32)); } else { mt[t] = 0.f; m2[t] = 0.f; } ms += mt[t]; }
            const float mean = ms / (float)ntn; float q = 0.f;
#pragma unroll
            for (int t = 0; t < 4; ++t) if (t < ntn) { const float dm = mt[t] - mean; q += m2[t] + 256.0f * dm * dm; }
            S[row] = (f32x2v){mean, 1.0f / sqrtf(q / (256.0f * (float)ntn) + eps)};
        }
        asm volatile("s_waitcnt lgkmcnt(0)" ::: "memory"); __builtin_amdgcn_s_barrier(); asm volatile("" ::: "memory");
        return bad;
    }
};
struct EpiLnRes {
    static constexpr bool PERM = false, AFTER_DRAIN = true;
    const float* base; float* out; int ldc; const float* bias; PanelStats st; unsigned poison;
    __device__ __forceinline__ void fused(f32x4 (&acc)[2][2][4][2], const Unit& u, int wr, int wc, int fr, int fq, PG8_LAS unsigned char* lds, int wid, int lane) const {
        typedef float f32x2v __attribute__((ext_vector_type(2)));
        const PG8_LAS f32x2v* S = (const PG8_LAS f32x2v*)(lds + 8192);
        const int col0 = u.pn * BM + wc * 32 + 4 * fq;
#pragma unroll
        for (int bj = 0; bj < 2; ++bj)
#pragma unroll
            for (int n = 0; n < 2; ++n) { const f32x4 bv = bias ? *(const f32x4*)(bias + col0 + bj * HALF + n * 16) : (f32x4){0.f, 0.f, 0.f, 0.f};
#pragma unroll
                for (int ai = 0; ai < 2; ++ai)
#pragma unroll
                    for (int m = 0; m < 4; ++m) acc[ai][bj][m][n] += bv; }
        f32x4 pre[4][2][2];
#pragma unroll
        for (int m = 0; m < 4; ++m) { const size_t off = (size_t)(u.pm * BM + wr * 64 + m * 16 + fr) * ldc + col0;
#pragma unroll
            for (int bj = 0; bj < 2; ++bj)
#pragma unroll
                for (int n = 0; n < 2; ++n) pre[m][bj][n] = *(const f32x4*)(base + off + bj * HALF + n * 16); }
        const bool bad = st.run(acc, u, wr, wc, fr, fq, lds, wid, lane) || poison != 0u;
        const float qnan = __builtin_nanf("");
#pragma unroll
        for (int ai = 0; ai < 2; ++ai)
#pragma unroll
            for (int m = 0; m < 4; ++m) { const int r = ai * HALF + wr * 64 + m * 16 + fr; const f32x2v sr = S[r]; const size_t off = (size_t)(u.pm * BM + r) * ldc + col0;
#pragma unroll
                for (int bj = 0; bj < 2; ++bj)
#pragma unroll
                    for (int n = 0; n < 2; ++n) { const f32x4 bs = ai == 0 ? pre[m][bj][n] : *(const f32x4*)(base + off + bj * HALF + n * 16); f32x4 o = bs + (acc[ai][bj][m][n] - sr.x) * sr.y;
                        if (bad) o = (f32x4){qnan, qnan, qnan, qnan}; *(f32x4*)(out + off + bj * HALF + n * 16) = o; }
                if (m & 1) asm volatile("" ::: "memory"); }
    }
};
struct EpiLnResLn {
    static constexpr bool PERM = false, AFTER_DRAIN = true;
    const float* base; float* out; bf16_t* xn; int ldc; const float* bias; PanelStats st1, st2; unsigned poison;
    __device__ __forceinline__ void fused(f32x4 (&acc)[2][2][4][2], const Unit& u, int wr, int wc, int fr, int fq, PG8_LAS unsigned char* lds, int wid, int lane) const {
        typedef float f32x2v __attribute__((ext_vector_type(2))); typedef unsigned u32x2v __attribute__((ext_vector_type(2)));
        const PG8_LAS f32x2v* S = (const PG8_LAS f32x2v*)(lds + 8192);
        const int col0 = u.pn * BM + wc * 32 + 4 * fq;
#pragma unroll
        for (int bj = 0; bj < 2; ++bj)
#pragma unroll
            for (int n = 0; n < 2; ++n) { const f32x4 bv = bias ? *(const f32x4*)(bias + col0 + bj * HALF + n * 16) : (f32x4){0.f, 0.f, 0.f, 0.f};
#pragma unroll
                for (int ai = 0; ai < 2; ++ai)
#pragma unroll
                    for (int m = 0; m < 4; ++m) acc[ai][bj][m][n] += bv; }
        bool bad = st1.run(acc, u, wr, wc, fr, fq, lds, wid, lane) || poison != 0u;
        const float qnan = __builtin_nanf("");
#pragma unroll
        for (int ai = 0; ai < 2; ++ai)
#pragma unroll
            for (int m = 0; m < 4; ++m) { const int r = ai * HALF + wr * 64 + m * 16 + fr; const f32x2v sr = S[r]; const size_t off = (size_t)(u.pm * BM + r) * ldc + col0;
#pragma unroll
                for (int bj = 0; bj < 2; ++bj)
#pragma unroll
                    for (int n = 0; n < 2; ++n) { const f32x4 bs = *(const f32x4*)(base + off + bj * HALF + n * 16); acc[ai][bj][m][n] = bs + (acc[ai][bj][m][n] - sr.x) * sr.y; }
                asm volatile("" : "+v"(acc[ai][0][m][0]), "+v"(acc[ai][0][m][1]), "+v"(acc[ai][1][m][0]), "+v"(acc[ai][1][m][1]));
                if (m & 1) asm volatile("" ::: "memory"); }
        const bool bad1 = bad;
        bad = st2.run(acc, u, wr, wc, fr, fq, lds, wid, lane) || bad;
#pragma unroll
        for (int ai = 0; ai < 2; ++ai)
#pragma unroll
            for (int m = 0; m < 4; ++m) { const int r = ai * HALF + wr * 64 + m * 16 + fr; const f32x2v sr = S[r]; const size_t off = (size_t)(u.pm * BM + r) * ldc + col0;
#pragma unroll
                for (int bj = 0; bj < 2; ++bj)
#pragma unroll
                    for (int n = 0; n < 2; ++n) { const f32x4 x1 = acc[ai][bj][m][n]; *(f32x4*)(out + off + bj * HALF + n * 16) = bad1 ? (f32x4){qnan, qnan, qnan, qnan} : x1;
                        const f32x4 o = (x1 - sr.x) * sr.y; u32x2v w; w.x = cvt_pk_bf16(o[0], o[1]); w.y = cvt_pk_bf16(o[2], o[3]);
                        if (bad) { w.x = 0x7fc07fc0u; w.y = 0x7fc07fc0u; } *(u32x2v*)(xn + off + bj * HALF + n * 16) = w; }
                asm volatile("" ::: "memory"); }
    }
};

template <class Epi, class Sched, bool ALIGN_EPI = false, bool SP2 = false>
__device__ __forceinline__ void gemm_phase(PG8_LAS unsigned char* lds, const Gemm g, const Sched& S, const Epi& E) {
    const int tid = threadIdx.x, wid = __builtin_amdgcn_readfirstlane(tid >> 6), lane = tid & 63, wr = wid >> 2, wc = wid & 3, fr = lane & 15, fq = lane >> 4;
    const int K = g.K, nt = K / BK;
    unsigned voffA[2], voffB[2];
#pragma unroll
    for (int i = 0; i < 2; ++i) { int R, C; stage_rc(tid * 16 + i * 8192, R, C); const int Rb = Epi::PERM ? ((R & ~31) + perm32(R & 31)) : R;
        voffA[i] = (unsigned)(R * K + C) * 2u; voffB[i] = (unsigned)(Rb * K + C) * 2u; }
    const size_t kstep = (size_t)(BK * 2);
    const size_t hstep = (size_t)HALF * K * 2;
    const size_t tstep = 2 * hstep;
    const unsigned ldsw = (unsigned)wid * 1024u;
    const int aoff = lds_byte(wr * 64 + fr, fq * 8), boff = lds_byte(wc * 32 + fr, fq * 8);
#define PG8_SA(b, h) (((b) * 2 + (h)) * HTB)
#define PG8_SB(b, h) ((4 + (b) * 2 + (h)) * HTB)
#define PG8_STAGE(bufoff, gbase, voff) do { _Pragma("unroll") for (int _i = 0; _i < 2; ++_i) \
        __builtin_amdgcn_global_load_lds((const unsigned*)((const char*)(gbase) + (voff)[_i]), (PG8_LAS unsigned*)(lds + (bufoff) + ldsw + _i * 8192), 16, 0, 0); } while (0)
#define PG8_LDA(dst, b, h) do { _Pragma("unroll") for (int m = 0; m < 4; ++m) _Pragma("unroll") for (int k = 0; k < 2; ++k) dst[m][k] = *(const PG8_LAS bf16x8*)(lds + PG8_SA(b, h) + aoff + m * 2048 + k * 1024); } while (0)
#define PG8_LDB(dst, b, h) do { _Pragma("unroll") for (int n = 0; n < 2; ++n) _Pragma("unroll") for (int k = 0; k < 2; ++k) dst[n][k] = *(const PG8_LAS bf16x8*)(lds + PG8_SB(b, h) + boff + n * 2048 + k * 1024); } while (0)
#define PG8_MMA(ai, bj, At, Bt) do { __builtin_amdgcn_s_setprio(1); _Pragma("unroll") for (int m = 0; m < 4; ++m) _Pragma("unroll") for (int n = 0; n < 2; ++n) _Pragma("unroll") for (int k = 0; k < 2; ++k) \
        acc[ai][bj][m][n] = __builtin_amdgcn_mfma_f32_16x16x32_bf16(Bt[n][k], At[m][k], acc[ai][bj][m][n], 0, 0, 0); __builtin_amdgcn_s_setprio(0); } while (0)
#define PG8_WAIT_V(n) asm volatile("s_waitcnt vmcnt(" #n ")" ::: "memory")
#define PG8_WAIT_L(n) asm volatile("s_waitcnt lgkmcnt(" #n ")" ::: "memory")
#define PG8_BAR __builtin_amdgcn_s_barrier()
#define PG8_SCHED __builtin_amdgcn_sched_barrier(0)
    Unit cur, nxt; int ui = 0;
    if (!S.next(0, cur)) return;
    f32x4 acc[2][2][4][2];
#pragma unroll
    for (int a = 0; a < 2; ++a)
#pragma unroll
        for (int b = 0; b < 2; ++b)
#pragma unroll
            for (int m = 0; m < 4; ++m)
#pragma unroll
                for (int n = 0; n < 2; ++n) acc[a][b][m][n] = (f32x4){0.f, 0.f, 0.f, 0.f};
    bf16x8 At[4][2], B0[2][2], B1[2][2];
    const char* cA = (const char*)g.A + (size_t)cur.pm * tstep; const char* cB = (const char*)g.Bt + (size_t)cur.pn * tstep;
    S.a_ready(cur);
    if constexpr (SP2) {
        PG8_STAGE(PG8_SB(0, 0), cB, voffB); PG8_STAGE(PG8_SB(0, 1), cB + hstep, voffB); PG8_STAGE(PG8_SA(0, 0), cA, voffA); PG8_STAGE(PG8_SA(0, 1), cA + hstep, voffA);
        if (wr == 1) PG8_BAR;
        PG8_WAIT_V(2); PG8_BAR;
        PG8_STAGE(PG8_SB(1, 0), cB + kstep, voffB); PG8_STAGE(PG8_SA(1, 0), cA + kstep, voffA); PG8_STAGE(PG8_SB(1, 1), cB + hstep + kstep, voffB);
        PG8_WAIT_V(6); PG8_BAR;
    } else {
        PG8_STAGE(PG8_SB(0, 0), cB, voffB); PG8_STAGE(PG8_SA(0, 0), cA, voffA); PG8_STAGE(PG8_SB(0, 1), cB + hstep, voffB); PG8_STAGE(PG8_SA(0, 1), cA + hstep, voffA);
        if (wr == 1) PG8_BAR;
        PG8_WAIT_V(4); PG8_BAR;
        PG8_STAGE(PG8_SB(1, 0), cB + kstep, voffB); PG8_STAGE(PG8_SA(1, 0), cA + kstep, voffA); PG8_STAGE(PG8_SB(1, 1), cB + hstep + kstep, voffB);
        PG8_WAIT_V(6); PG8_BAR;
    }
    for (;;) {
        const bool has_next = S.next(ui + 1, nxt);
        const char* nA = has_next ? (const char*)g.A + (size_t)nxt.pm * tstep : cA; const char* nB = has_next ? (const char*)g.Bt + (size_t)nxt.pn * tstep : cB;
        for (int t = 0; t < nt; t += 2) {
            const bool last = (t == nt - 2);
            const char* a1 = cA + (size_t)(t + 1) * kstep;
            const char* a2 = last ? nA : cA + (size_t)(t + 2) * kstep; const char* b2 = last ? nB : cB + (size_t)(t + 2) * kstep;
            const char* a3 = a2 + kstep; const char* b3 = b2 + kstep;
            if (last && has_next) S.a_ready(nxt);
            if constexpr (SP2) {
            PG8_LDB(B0, 0, 0); PG8_LDB(B1, 0, 1); PG8_SCHED; PG8_LDA(At, 0, 0); PG8_STAGE(PG8_SA(1, 1), a1 + hstep, voffA);
            PG8_WAIT_V(8); PG8_WAIT_L(0); PG8_BAR; PG8_MMA(0, 0, At, B0); PG8_MMA(0, 1, At, B1); PG8_BAR; PG8_SCHED;
            PG8_LDA(At, 0, 1); PG8_STAGE(PG8_SB(0, 0), b2, voffB); PG8_STAGE(PG8_SB(0, 1), b2 + hstep, voffB); PG8_STAGE(PG8_SA(0, 0), a2, voffA);
            PG8_WAIT_V(8); PG8_WAIT_L(0); PG8_BAR; PG8_MMA(1, 0, At, B0); PG8_MMA(1, 1, At, B1); PG8_BAR; PG8_SCHED;
            PG8_LDB(B0, 1, 0); PG8_LDB(B1, 1, 1); PG8_SCHED; PG8_LDA(At, 1, 0); PG8_STAGE(PG8_SA(0, 1), a2 + hstep, voffA);
            PG8_WAIT_V(8); PG8_WAIT_L(0); PG8_BAR; PG8_MMA(0, 0, At, B0); PG8_MMA(0, 1, At, B1); PG8_BAR; PG8_SCHED;
            PG8_LDA(At, 1, 1); PG8_STAGE(PG8_SB(1, 0), b3, voffB); PG8_STAGE(PG8_SB(1, 1), b3 + hstep, voffB); PG8_STAGE(PG8_SA(1, 0), a3, voffA);
            PG8_WAIT_V(8); PG8_WAIT_L(0); PG8_BAR; PG8_MMA(1, 0, At, B0); PG8_MMA(1, 1, At, B1); PG8_BAR; PG8_SCHED;
            } else {
            PG8_LDB(B0, 0, 0); PG8_SCHED; PG8_LDA(At, 0, 0); PG8_STAGE(PG8_SA(1, 1), a1 + hstep, voffA);
            PG8_WAIT_L(8); PG8_BAR; PG8_WAIT_L(0); PG8_MMA(0, 0, At, B0); PG8_BAR; PG8_SCHED;
            PG8_LDB(B1, 0, 1); PG8_STAGE(PG8_SB(0, 0), b2, voffB);
            PG8_BAR; PG8_WAIT_L(0); PG8_MMA(0, 1, At, B1); PG8_BAR;
            PG8_LDA(At, 0, 1); PG8_STAGE(PG8_SA(0, 0), a2, voffA);
            PG8_BAR; PG8_WAIT_L(0); PG8_MMA(1, 0, At, B0); PG8_BAR; PG8_SCHED;
            PG8_STAGE(PG8_SB(0, 1), b2 + hstep, voffB);
            PG8_WAIT_V(6); PG8_BAR; PG8_MMA(1, 1, At, B1); PG8_BAR;
            PG8_LDB(B0, 1, 0); PG8_SCHED; PG8_LDA(At, 1, 0); PG8_STAGE(PG8_SA(0, 1), a2 + hstep, voffA);
            PG8_WAIT_L(8); PG8_BAR; PG8_WAIT_L(0); PG8_MMA(0, 0, At, B0); PG8_BAR; PG8_SCHED;
            PG8_LDB(B1, 1, 1); PG8_STAGE(PG8_SB(1, 0), b3, voffB);
            PG8_BAR; PG8_WAIT_L(0); PG8_MMA(0, 1, At, B1); PG8_BAR;
            PG8_LDA(At, 1, 1); PG8_STAGE(PG8_SA(1, 0), a3, voffA);
            PG8_BAR; PG8_WAIT_L(0); PG8_MMA(1, 0, At, B0); PG8_BAR; PG8_SCHED;
            PG8_STAGE(PG8_SB(1, 1), b3 + hstep, voffB);
            PG8_WAIT_V(6); PG8_BAR; PG8_MMA(1, 1, At, B1); PG8_BAR;
            }
        }
        if constexpr (ALIGN_EPI) { if (wr == 0) PG8_BAR; }
        if constexpr (!Epi::AFTER_DRAIN) { E(acc, cur, wr, wc, fr, fq); S.done(cur); }
        if (!has_next) break;
#pragma unroll
        for (int a = 0; a < 2; ++a)
#pragma unroll
            for (int b = 0; b < 2; ++b)
#pragma unroll
                for (int m = 0; m < 4; ++m)
#pragma unroll
                    for (int n = 0; n < 2; ++n) acc[a][b][m][n] = (f32x4){0.f, 0.f, 0.f, 0.f};
        cur = nxt; cA = nA; cB = nB; ++ui;
        if constexpr (ALIGN_EPI) { if (wr == 1) PG8_BAR; }
    }
    PG8_WAIT_V(0);
    if constexpr (!ALIGN_EPI) { if (wr == 0) PG8_BAR; }
    PG8_BAR;
    if constexpr (Epi::AFTER_DRAIN) { E.fused(acc, cur, wr, wc, fr, fq, lds, wid, lane); S.done(cur); }
#undef PG8_SA
#undef PG8_SB
#undef PG8_STAGE
#undef PG8_LDA
#undef PG8_LDB
#undef PG8_MMA
#undef PG8_WAIT_V
#undef PG8_WAIT_L
#undef PG8_BAR
#undef PG8_SCHED
}
}

namespace pg8 {
struct EpiStore {
    static constexpr bool PERM = true, AFTER_DRAIN = false;
    bf16_t* O; int ldc; int n_lo; float sc_lo; int pn_one; float sc_one;
    __device__ __forceinline__ void operator()(const f32x4 (&acc)[2][2][4][2], const Unit& u, int wr, int wc, int fr, int fq) const {
        const int row0 = u.pm * BM + wr * 64 + fr; const int col0 = u.pn * BM + wc * 32 + 8 * fq;
        const float sc = (u.pn < n_lo) ? sc_lo : ((u.pn == pn_one) ? sc_one : 1.0f);
#pragma unroll
        for (int ai = 0; ai < 2; ++ai)
#pragma unroll
            for (int m = 0; m < 4; ++m) { bf16_t* rowp = O + (size_t)(row0 + ai * HALF + m * 16) * ldc + col0;
#pragma unroll
                for (int bj = 0; bj < 2; ++bj) { f32x4 v0 = acc[ai][bj][m][0] * sc, v1 = acc[ai][bj][m][1] * sc;
                    u32x4 w; w.x = cvt_pk_bf16(v0[0], v0[1]); w.y = cvt_pk_bf16(v0[2], v0[3]); w.z = cvt_pk_bf16(v1[0], v1[1]); w.w = cvt_pk_bf16(v1[2], v1[3]);
                    *(u32x4*)(rowp + bj * HALF) = w; } }
    }
};

struct EpiProj {
    static constexpr bool PERM = true, AFTER_DRAIN = false;
    bf16_t* P; float qscale;
    __device__ __forceinline__ void operator()(const f32x4 (&acc)[2][2][4][2], const Unit& u, int wr, int wc, int fr, int fq) const {
        const int b = u.pm >> 5, tb = u.pm & 31, pn = u.pn;
        constexpr size_t Mi = 1u << 20;
#pragma unroll
        for (int bj = 0; bj < 2; ++bj) {
            size_t base; int rstride;  float sc = 1.0f; bool posmap = false;
            if (pn < 6) { const int head = (pn & 1) * 4 + 2 * bj + (wc >> 1); base = (size_t)(pn >> 1) * 16 * Mi + (size_t)(b * 8 + head) * 8192 * 64 + (wc & 1) * 32 + 8 * fq; rstride = 64; posmap = true; if (pn < 2) sc = qscale; }
            else if (pn < 8) { const int head = 2 * bj + (wc >> 1); base = 48 * Mi + (size_t)(pn - 6) * 8 * Mi + (size_t)(b * 4 + head) * 8192 * 64 + (wc & 1) * 32 + 8 * fq; rstride = 64; if (pn == 7) sc = 0.125f; }
            else { const int head = ((pn - 8) & 1) * 2 + bj; base = 64 * Mi + (size_t)((pn - 8) >> 1) * 16 * Mi + (size_t)(b * 4 + head) * 8192 * 128 + 32 * wc + 8 * fq; rstride = 128; }
#pragma unroll
            for (int ai = 0; ai < 2; ++ai)
#pragma unroll
                for (int m = 0; m < 4; ++m) {
                    const int ridx = posmap ? (fr * 512 + tb * 16 + 8 * ai + 4 * wr + m) : (tb * 256 + 128 * ai + 64 * wr + 16 * m + fr);
                    const f32x4 v0 = acc[ai][bj][m][0] * sc, v1 = acc[ai][bj][m][1] * sc;
                    u32x4 w; w.x = cvt_pk_bf16(v0[0], v0[1]); w.y = cvt_pk_bf16(v0[2], v0[3]); w.z = cvt_pk_bf16(v1[0], v1[1]); w.w = cvt_pk_bf16(v1[2], v1[3]);
                    *(u32x4*)(P + base + (size_t)ridx * rstride) = w; }
        }
    }
};

__device__ __forceinline__ float dpp_ror1(float v) { return __builtin_bit_cast(float, __builtin_amdgcn_update_dpp(0, __builtin_bit_cast(int, v), 0x121, 0xf, 0xf, false)); }
__device__ __forceinline__ float dpp_ror2(float v) { return __builtin_bit_cast(float, __builtin_amdgcn_update_dpp(0, __builtin_bit_cast(int, v), 0x122, 0xf, 0xf, false)); }
__device__ __forceinline__ float gelu_tanh_f(float x) {
    const float A = -2.302208198f, Bc = -0.1029432397f;
    const float t = x * (A + Bc * x * x);
    return x * __builtin_amdgcn_rcpf(1.0f + __builtin_amdgcn_exp2f(t));
}
struct EpiConvAct {
    static constexpr bool PERM = true, AFTER_DRAIN = false;
    bf16_t* act; float* ub; const float* cw; const float* cb;
    __device__ __forceinline__ void operator()(const f32x4 (&acc)[2][2][4][2], const Unit& u, int wr, int wc, int fr, int fq) const {
        constexpr int FFc = 2816, FF2c = 5632;
#pragma unroll
        for (int n = 0; n < 2; ++n) {
            const int j = u.pn * 128 + wc * 32 + 8 * fq + 4 * n;
            const f32x4 w0g = *(const f32x4*)(cw + j), w1g = *(const f32x4*)(cw + FF2c + j), w2g = *(const f32x4*)(cw + 2 * FF2c + j), bg = *(const f32x4*)(cb + j);
            const f32x4 w0u = *(const f32x4*)(cw + FFc + j), w1u = *(const f32x4*)(cw + FF2c + FFc + j), w2u = *(const f32x4*)(cw + 2 * FF2c + FFc + j), bu = *(const f32x4*)(cb + FFc + j);
#pragma unroll
            for (int ai = 0; ai < 2; ++ai) {
                const int g = u.pm * 4 + ai * 2 + wr;
                f32x4 qg1 = {0.f, 0.f, 0.f, 0.f}, qg2 = qg1, qu1 = qg1, qu2 = qg1;
#pragma unroll
                for (int m = 0; m < 4; ++m) {
                    const f32x4 ug = acc[ai][0][m][n], uu = acc[ai][1][m][n];
                    f32x4 ag1, ag2, au1, au2;
#pragma unroll
                    for (int k = 0; k < 4; ++k) { ag1[k] = dpp_ror1(ug[k]); ag2[k] = dpp_ror2(ug[k]); au1[k] = dpp_ror1(uu[k]); au2[k] = dpp_ror2(uu[k]); }
                    f32x4 pg1, pg2, pu1, pu2;
#pragma unroll
                    for (int k = 0; k < 4; ++k) { pg1[k] = (fr >= 1) ? ag1[k] : qg1[k]; pg2[k] = (fr >= 2) ? ag2[k] : qg2[k]; pu1[k] = (fr >= 1) ? au1[k] : qu1[k]; pu2[k] = (fr >= 2) ? au2[k] : qu2[k]; }
                    qg1 = ag1; qg2 = ag2; qu1 = au1; qu2 = au2;
                    const f32x4 yg = bg + w2g * ug + w1g * pg1 + w0g * pg2;
                    const f32x4 yu = bu + w2u * uu + w1u * pu1 + w0u * pu2;
                    float a0 = gelu_tanh_f(yg[0]) * yu[0], a1 = gelu_tanh_f(yg[1]) * yu[1], a2 = gelu_tanh_f(yg[2]) * yu[2], a3 = gelu_tanh_f(yg[3]) * yu[3];
                    const int row = u.pm * BM + ai * HALF + wr * 64 + m * 16 + fr;
                    typedef unsigned u32x2 __attribute__((ext_vector_type(2)));
                    u32x2 w; w.x = cvt_pk_bf16(a0, a1); w.y = cvt_pk_bf16(a2, a3);
                    if (!(m == 0 && fr < 2)) *(u32x2*)(act + (size_t)row * FFc + j) = w;
                    if (m == 0 && fr < 2) { float* p = ub + ((size_t)(g * 4 + 2 + fr) * 2) * FFc + j; *(f32x4*)p = ug; *(f32x4*)(p + FFc) = uu; }
                    if (m == 3 && fr >= 14) { float* p = ub + ((size_t)(g * 4 + (fr - 14)) * 2) * FFc + j; *(f32x4*)p = ug; *(f32x4*)(p + FFc) = uu; }
                }
            }
        }
    }
};
}
#define GAS __attribute__((address_space(1)))
#define LAS __attribute__((address_space(3)))
typedef unsigned short bf16;
typedef unsigned v4u __attribute__((ext_vector_type(4)));
typedef float f32x4 __attribute__((ext_vector_type(4)));
typedef short bf16x8 __attribute__((ext_vector_type(8)));
typedef GAS unsigned gu32;
typedef GAS unsigned long long gu64;
#define RLX_AGENT __ATOMIC_RELAXED, __HIP_MEMORY_SCOPE_AGENT
#define LDS_WAIT() asm volatile("s_waitcnt lgkmcnt(0)" ::: "memory")
#define VM_WAIT() asm volatile("s_waitcnt vmcnt(0)" ::: "memory")
__device__ __forceinline__ unsigned long long rt() { return __builtin_amdgcn_s_memrealtime(); }
__device__ __forceinline__ unsigned f2bf(float f) { unsigned u = __builtin_bit_cast(unsigned, f); return (u + 0x7fffu + ((u >> 16) & 1u)) >> 16; }
__device__ __forceinline__ unsigned pk2(float lo, float hi) { return f2bf(lo) | (f2bf(hi) << 16); }

#define XB_TMO      128
#define XB_XCNT(j)  (256  + 64 * (j))
#define XB_XSUB(j)  (1280 + 64 * (j))
#define XB_XGEN(j)  (2304 + 64 * (j))
#define XB_TOP      3328
#define XB_TOPGEN   3392
#define XCD_BAR_WORDS 3456
#define XB_SPIN_CAP (1u << 18)

__device__ __forceinline__ unsigned xb_ld(unsigned* p)              { return __hip_atomic_load(p, __ATOMIC_RELAXED, __HIP_MEMORY_SCOPE_AGENT); }
__device__ __forceinline__ unsigned xb_add(unsigned* p, unsigned v) { return __hip_atomic_fetch_add(p, v, __ATOMIC_RELAXED, __HIP_MEMORY_SCOPE_AGENT); }
__device__ __forceinline__ unsigned xb_xcc_id() { return (unsigned)__builtin_amdgcn_s_getreg((3 << 11) | 20) & 0xFu; }
#define XB_SPIN(cond, bar) do { unsigned _sp = 0; while (cond) { __builtin_amdgcn_s_sleep(1); \
    if ((++_sp & 255u) == 0u) { if (xb_ld(&(bar)[XB_TMO])) break; if (_sp > XB_SPIN_CAP) { atomicAdd(&(bar)[XB_TMO], 1u); break; } } } } while (0)

struct XcdBarrier {
    unsigned* bar; unsigned x;
    volatile LAS unsigned* st;
};

__device__ __forceinline__ XcdBarrier xcd_barrier_post(unsigned* bar, volatile LAS unsigned* st) {
    XcdBarrier b; b.bar = bar; b.x = xb_xcc_id(); b.st = st;
    if (threadIdx.x == 0) (void)xb_add(&bar[XB_XCNT(b.x)], 1u);
    return b;
}
__device__ __forceinline__ void xcd_barrier_complete(unsigned* bar, unsigned x, unsigned& nloc, unsigned& nx) {
    const unsigned G = gridDim.x * gridDim.y * gridDim.z;
    unsigned sum, cnt, mine, sp = 0u;
    for (;;) {
        sum = 0u; cnt = 0u; mine = 0u;
#pragma unroll
        for (unsigned j = 0; j < 16; ++j) { const unsigned c = xb_ld(&bar[XB_XCNT(j)]); sum += c; cnt += (c > 0u) ? 1u : 0u; mine = (j == x) ? c : mine; }
        if (sum == G) break;
        __builtin_amdgcn_s_sleep(1);
        if ((++sp & 255u) == 0u) { if (xb_ld(&bar[XB_TMO])) break; if (sp > XB_SPIN_CAP) { atomicAdd(&bar[XB_TMO], 1u); break; } }
    }
    nloc = mine > 0u ? mine : 1u; nx = cnt > 0u ? cnt : 1u;
}

__device__ __forceinline__ void xcd_barrier(const XcdBarrier& b) {
    asm volatile("s_waitcnt vmcnt(0)" ::: "memory");
    __syncthreads();
    if (threadIdx.x == 0) {
        unsigned* bar = b.bar;
        __builtin_amdgcn_s_waitcnt(0);
        unsigned nloc = b.st[0], nx = b.st[1];
        if (nloc == 0u) { xcd_barrier_complete(bar, b.x, nloc, nx); b.st[0] = nloc; b.st[1] = nx; }
        const unsigned old = xb_add(&bar[XB_XSUB(b.x)], 1u);
        const unsigned gen = old / nloc;
        if (old + 1u == (gen + 1u) * nloc) {
            __builtin_amdgcn_fence(__ATOMIC_RELEASE, "agent");
            asm volatile("s_waitcnt vmcnt(0)" ::: "memory");
            const unsigned og = xb_add(&bar[XB_TOP], 1u);
            const unsigned tg = og / nx;
            if (og + 1u == (tg + 1u) * nx) xb_add(&bar[XB_TOPGEN], 1u);
            else XB_SPIN(xb_ld(&bar[XB_TOPGEN]) == tg, bar);
            __builtin_amdgcn_fence(__ATOMIC_ACQUIRE, "agent");
            xb_add(&bar[XB_XGEN(b.x)], 1u);
            asm volatile("s_waitcnt vmcnt(0)" ::: "memory");
        } else {
            XB_SPIN(xb_ld(&bar[XB_XGEN(b.x)]) == gen, bar);
            __builtin_amdgcn_fence(__ATOMIC_ACQUIRE, "agent");
            asm volatile("s_waitcnt vmcnt(0)" ::: "memory");
        }
    }
    __syncthreads();
}

constexpr int NWAVES = 8, NTHR = 512;
#ifndef MK_N_LAUNCHES
#define MK_N_LAUNCHES 1
#endif
constexpr int N_PHASES = 11;
constexpr int BATCH = 4, SEQ = 8192, DM = 1024, M = BATCH * SEQ, INW = 3072, FF = 2816, FF2 = 5632;
constexpr float NORM_EPS = 1e-6f;
constexpr float QSCALE = 0.125f * 1.4426950408889634f;
constexpr size_t MiB = 1u << 20;
constexpr size_t WS_CTL = 0, CTL_ZERO_BYTES = 1 * MiB;
constexpr size_t WS_ROPE = 1 * MiB;
constexpr size_t WS_WIN = 4 * MiB, WS_WOUT = 10 * MiB, WS_WUP = 12 * MiB, WS_WDN = 23 * MiB;
constexpr size_t WS_XN = 32 * MiB;
constexpr size_t WS_PROJ = 96 * MiB;
constexpr size_t WS_ACT = 96 * MiB;
constexpr size_t WS_OPART = 288 * MiB;
constexpr size_t WS_LSE = 384 * MiB;
constexpr size_t WS_MIX = 288 * MiB;
constexpr size_t WS_FFN = 352 * MiB;
constexpr size_t WS_MIXED = 416 * MiB;
constexpr size_t WS_UB = 416 * MiB;
constexpr size_t WS_KV = 480 * MiB;
constexpr size_t WS_END = 512 * MiB;
constexpr int CW_TMO = 0, CW_BAR = 4096;
constexpr int RING_OFF = 0, RING_BYTES = 133120;
constexpr int LDSCTL_OFF = RING_BYTES, MISC_OFF = LDSCTL_OFF + 320;
constexpr int LDS_BYTES = 147456;
static_assert(MISC_OFF + 128 <= LDS_BYTES, "LDS map");

__device__ const float ROPE_F[32] = {1.000000000e+00f, 7.498942018e-01f, 5.623413324e-01f, 4.216965139e-01f, 3.162277639e-01f, 2.371373773e-01f, 1.778279394e-01f, 1.333521456e-01f, 1.000000015e-01f, 7.498942316e-02f, 5.623413250e-02f, 4.216964915e-02f, 3.162277490e-02f, 2.371373773e-02f, 1.778279431e-02f, 1.333521400e-02f, 9.999999776e-03f, 7.498942316e-03f, 5.623413250e-03f, 4.216964822e-03f, 3.162277630e-03f, 2.371373819e-03f, 1.778279431e-03f, 1.333521446e-03f, 1.000000047e-03f, 7.498941850e-04f, 5.623413017e-04f, 4.216965172e-04f, 3.162277571e-04f, 2.371373703e-04f, 1.778279402e-04f, 1.333521504e-04f};

typedef float f32x16 __attribute__((ext_vector_type(16)));
typedef short s16x4 __attribute__((ext_vector_type(4)));
typedef unsigned u32x2 __attribute__((ext_vector_type(2)));
typedef float f32x2v __attribute__((ext_vector_type(2)));
typedef __bf16 bf16x2_t __attribute__((ext_vector_type(2)));
__device__ __forceinline__ unsigned cvtpk(float lo, float hi) { f32x2v v = {lo, hi}; bf16x2_t b = __builtin_convertvector(v, bf16x2_t); return __builtin_bit_cast(unsigned, b); }
__device__ __forceinline__ float bf_lo(unsigned w) { return __builtin_bit_cast(float, w << 16); }
__device__ __forceinline__ float bf_hi(unsigned w) { return __builtin_bit_cast(float, w & 0xffff0000u); }
__device__ __forceinline__ int crow(int r, int hi) { return (r & 3) + 8 * (r >> 2) + 4 * hi; }
__device__ __forceinline__ s16x4 tr16(const LAS unsigned char* p) { typedef short v4i16_t __attribute__((ext_vector_type(4))); return __builtin_bit_cast(s16x4, __builtin_amdgcn_ds_read_tr16_b64_v4i16((LAS v4i16_t*)p)); }
__device__ __forceinline__ bf16x8 mk8(s16x4 a, s16x4 b) { return (bf16x8){a[0], a[1], a[2], a[3], b[0], b[1], b[2], b[3]}; }
__device__ __forceinline__ float wave_sum(float v) {
#pragma unroll
    for (int o = 1; o < 64; o <<= 1) v += __shfl_xor(v, o);
    return v;
}
__device__ __forceinline__ float lg2gamma(int h) { return log2f(1.0f - exp2f(-5.0f - (float)h)); }

struct Frame {
    LAS unsigned char* lds;
    volatile LAS unsigned* MISC;
    gu32* ctl;
    int tid, lane, wave, vcu, G;
    const float *x, *g_pre, *g_post, *w_in, *w_out, *g_fpre, *g_fpost, *w_up, *conv_w, *conv_b, *w_down;
    float* out;
    bf16 *Win_t, *Wout_t, *Wup_t, *Wdn_t, *XN, *PROJ, *ACT, *OPART, *MIX, *FFN, *MIXED;
    float *LSE, *UB, *KV; f32x2v* ROPE;
};

__device__ __forceinline__ void p0_transpose_item(const float* W, int K, int N, bf16* WT, int row_off, LAS float* scr, int kb, int nb, int lane) {
    const int k0 = 64 * kb, n0 = 32 * nb;
#pragma unroll 8
    for (int i = 0; i < 32; ++i) { const int kk = 2 * i + (lane >> 5); scr[kk * 33 + (lane & 31)] = W[(size_t)(k0 + kk) * N + n0 + (lane & 31)]; }
    LDS_WAIT(); asm volatile("" ::: "memory");
    const int c = lane & 7;
#pragma unroll
    for (int j = 0; j < 4; ++j) { const int n = (lane >> 3) + 8 * j; const LAS float* s = scr + (8 * c) * 33 + n;
        v4u o; o.x = cvtpk(s[0 * 33], s[1 * 33]); o.y = cvtpk(s[2 * 33], s[3 * 33]); o.z = cvtpk(s[4 * 33], s[5 * 33]); o.w = cvtpk(s[6 * 33], s[7 * 33]);
        *(GAS v4u*)(WT + (size_t)(row_off + n0 + n) * K + k0 + 8 * c) = o; }
    LDS_WAIT(); asm volatile("" ::: "memory");
}
__device__ __forceinline__ void rms_row_to_bf16(const float* xrow, const float* gain, bf16* orow, int lane) {
    const GAS f32x4* xr = (const GAS f32x4*)xrow + lane; const GAS f32x4* gr = (const GAS f32x4*)gain + lane;
    f32x4 v[4]; float s = 0.f;
#pragma unroll
    for (int j = 0; j < 4; ++j) { v[j] = xr[64 * j]; s += (v[j].x * v[j].x + v[j].y * v[j].y) + (v[j].z * v[j].z + v[j].w * v[j].w); }
    const float rstd = 1.f / sqrtf(wave_sum(s) * (1.f / DM) + NORM_EPS);
    GAS unsigned long long* o8 = (GAS unsigned long long*)orow + lane;
#pragma unroll
    for (int j = 0; j < 4; ++j) { const f32x4 g = gr[64 * j];
        o8[64 * j] = (unsigned long long)cvtpk(v[j].x * rstd * g.x, v[j].y * rstd * g.y) | ((unsigned long long)cvtpk(v[j].z * rstd * g.z, v[j].w * rstd * g.w) << 32); }
}
__device__ __forceinline__ void rms_rows4_to_bf16(const float* xrow, const float* gain, bf16* orow, int lane) {
    const GAS f32x4* gr = (const GAS f32x4*)gain + lane;
    f32x4 v[4][4]; float s[4];
#pragma unroll
    for (int r = 0; r < 4; ++r) { const GAS f32x4* xr = (const GAS f32x4*)(xrow + (size_t)r * DM) + lane;
#pragma unroll
        for (int j = 0; j < 4; ++j) v[r][j] = xr[64 * j]; }
#pragma unroll
    for (int r = 0; r < 4; ++r) { s[r] = 0.f;
#pragma unroll
        for (int j = 0; j < 4; ++j) s[r] += (v[r][j].x * v[r][j].x + v[r][j].y * v[r][j].y) + (v[r][j].z * v[r][j].z + v[r][j].w * v[r][j].w); }
#pragma unroll
    for (int o = 1; o < 64; o <<= 1) {
#pragma unroll
        for (int r = 0; r < 4; ++r) s[r] += __shfl_xor(s[r], o); }
#pragma unroll
    for (int r = 0; r < 4; ++r) { const float rstd = 1.f / sqrtf(s[r] * (1.f / DM) + NORM_EPS); GAS unsigned long long* o8 = (GAS unsigned long long*)(orow + (size_t)r * DM) + lane;
#pragma unroll
        for (int j = 0; j < 4; ++j) { const f32x4 g = gr[64 * j];
            o8[64 * j] = (unsigned long long)cvtpk(v[r][j].x * rstd * g.x, v[r][j].y * rstd * g.y) | ((unsigned long long)cvtpk(v[r][j].z * rstd * g.z, v[r][j].w * rstd * g.w) << 32); } }
}
__device__ __forceinline__ void p0_prep(Frame& F) {
    LAS float* scr = (LAS float*)(F.lds + RING_OFF + F.wave * 16384);
    const int gw = F.vcu * NWAVES + F.wave, NGW = F.G * NWAVES;
    constexpr int I_IN = (DM / 64) * (INW / 32), I_OUT = (DM / 64) * (DM / 32), I_UP = (DM / 64) * (FF2 / 32), I_DN = (FF / 64) * (DM / 32);
    constexpr int NITEMS = I_IN + I_OUT + I_UP + I_DN;
    for (int it = gw; it < NITEMS; it += NGW) {
        int r = it;
        if (r < I_IN) { const int nblk = INW / 32; p0_transpose_item(F.w_in, DM, INW, F.Win_t, 0, scr, r / nblk, r % nblk, F.lane); continue; } r -= I_IN;
        if (r < I_OUT) { const int nblk = DM / 32; p0_transpose_item(F.w_out, DM, DM, F.Wout_t, 0, scr, r / nblk, r % nblk, F.lane); continue; } r -= I_OUT;
        if (r < I_UP) { const int nblk = FF2 / 32; const int kb = r / nblk, nb = r % nblk; const int n0 = 32 * nb;
            const int dest = (n0 < FF) ? ((n0 / 128) * 256 + (n0 % 128)) : (((n0 - FF) / 128) * 256 + 128 + ((n0 - FF) % 128));
            p0_transpose_item(F.w_up, DM, FF2, F.Wup_t, dest - n0, scr, kb, nb, F.lane); continue; } r -= I_UP;
        { const int nblk = DM / 32; p0_transpose_item(F.w_down, FF, DM, F.Wdn_t, 0, scr, r / nblk, r % nblk, F.lane); }
    }
    for (int m = gw * 4; m < M; m += NGW * 4) rms_rows4_to_bf16(F.x + (size_t)m * DM, F.g_pre, F.XN + (size_t)m * DM, F.lane);
    for (int idx = F.vcu * NTHR + F.tid; idx < SEQ * 32; idx += F.G * NTHR) { const int t = idx >> 5, i = idx & 31; const float ang = (float)t * ROPE_F[i]; F.ROPE[idx] = (f32x2v){cosf(ang), sinf(ang)}; }
}

namespace att {
constexpr int NKEY = 384, K_OFF = 0, K_BYTES = NKEY * 128, V_OFF = K_BYTES, VHALF = NKEY * 64, V_BYTES = 2 * VHALF, SCR_OFF = V_OFF + V_BYTES, OST_OFF = SCR_OFF + 8 * 256, END = OST_OFF + 8 * 4096;
static_assert(END <= RING_BYTES, "attention LDS");
}
struct AttnPre { v4u k[6], v[6]; bf16x8 q[4]; };
__device__ __forceinline__ void attn_load(Frame& F, int u, AttnPre& P) {
    const int tid = F.tid, lane = F.lane, w = F.wave, r32 = lane & 31, hi = lane >> 5;
    const int bh = u / 96, rem = u % 96, p = rem >> 5, xx = rem & 31, b = bh >> 3, h = bh & 7;
    const int dsh = (p == 0) ? 4 : ((p == 1) ? 2 : 0);
    const int nsb = 32 >> dsh, r = xx / nsb, sb = xx % nsb;
    const bf16* Qh = F.PROJ + (size_t)bh * SEQ * 64;
    const int nst = 16 >> dsh, per = 384 / nst;
#pragma unroll
    for (int it = 0; it < 6; ++it) { const int idx = tid + NTHR * it, q = idx >> 3, c = idx & 7, kk = (q % per) * nst + q / per; int sp = 256 * sb - 128 + kk; sp = sp < 0 ? 0 : sp;
        const int t = (sp << dsh) + r; const bf16* src = Qh + (size_t)((t & 15) * 512 + (t >> 4)) * 64 + c * 8;
        P.k[it] = *(const GAS v4u*)(src + ((size_t)16 << 20)); P.v[it] = *(const GAS v4u*)(src + ((size_t)32 << 20)); }
    const int qt_ = ((256 * sb + 32 * w + r32) << dsh) + r;
#pragma unroll
    for (int d0 = 0; d0 < 4; ++d0) P.q[d0] = *(const GAS bf16x8*)(Qh + (size_t)((qt_ & 15) * 512 + (qt_ >> 4)) * 64 + d0 * 16 + hi * 8);
}
__device__ __forceinline__ void attn_units(Frame& F, int u0, int u1) {
    using namespace att;
    if (u0 >= u1) return;
    const int tid = F.tid, lane = F.lane, w = F.wave, r32 = lane & 31, hi = lane >> 5;
    LAS unsigned char* lds = F.lds + RING_OFF;
    AttnPre P;
#ifndef MK_ATT_NOPREF
    attn_load(F, u0, P);
#endif
    for (int u = u0; u < u1; ++u) {
#ifdef MK_ATT_NOPREF
    attn_load(F, u, P);
#endif
    const int bh = u / 96, rem = u % 96, p = rem >> 5, xx = rem & 31, b = bh >> 3, h = bh & 7;
    const int dsh = (p == 0) ? 4 : ((p == 1) ? 2 : 0);
    const int nsb = 32 >> dsh, r = xx / nsb, sb = xx % nsb;
    __syncthreads();
    const int nst = 16 >> dsh, per = 384 / nst;
#pragma unroll
    for (int it = 0; it < 6; ++it) { const int idx = tid + NTHR * it, q = idx >> 3, c = idx & 7, kk = (q % per) * nst + q / per;
        *(LAS v4u*)(lds + K_OFF + kk * 128 + ((c ^ ((kk >> 1) & 7)) << 4)) = P.k[it];
        *(LAS v4u*)(lds + V_OFF + (c >> 2) * VHALF + kk * 64 + (c & 3) * 16) = P.v[it]; }
    bf16x8 qr[4];
#pragma unroll
    for (int d0 = 0; d0 < 4; ++d0) qr[d0] = P.q[d0];
    const int qtk = ((256 * sb + 32 * w + r32) << dsh) + r;
    __syncthreads();
#ifndef MK_ATT_NOPREF
    if (u + 1 < u1) attn_load(F, u + 1, P);
#endif
    f32x16 pt[5];
#pragma unroll
    for (int j = 0; j < 5; ++j) {
        pt[j] = (f32x16){0.f, 0.f, 0.f, 0.f, 0.f, 0.f, 0.f, 0.f, 0.f, 0.f, 0.f, 0.f, 0.f, 0.f, 0.f, 0.f};
        const int row = 32 * (w + j) + r32;
#pragma unroll
        for (int d0 = 0; d0 < 4; ++d0) { const bf16x8 kf = *(const LAS bf16x8*)(lds + K_OFF + row * 128 + (((2 * d0 + hi) ^ ((row >> 1) & 7)) << 4));
            pt[j] = __builtin_amdgcn_mfma_f32_32x32x16_bf16(kf, qr[d0], pt[j], 0, 0, 0); }
    }
    const float NEG = -1e30f;
#pragma unroll
    for (int rr = 0; rr < 16; ++rr) { const int kr = crow(rr, hi); if (kr < r32) pt[0][rr] = NEG; if (kr > r32) pt[4][rr] = NEG; }
    if (sb == 0) {
#pragma unroll
        for (int j = 0; j < 4; ++j) if (w + j < 4) {
#pragma unroll
            for (int rr = 0; rr < 16; ++rr) pt[j][rr] = NEG; }
    }
    float mx = NEG;
#pragma unroll
    for (int j = 0; j < 5; ++j)
#pragma unroll
        for (int rr = 0; rr < 16; ++rr) mx = fmaxf(mx, pt[j][rr]);
    mx = fmaxf(mx, __shfl_xor(mx, 32));
    float ls = 0.f;
#pragma unroll
    for (int j = 0; j < 5; ++j)
#pragma unroll
        for (int rr = 0; rr < 16; ++rr) { const float e = __builtin_amdgcn_exp2f(pt[j][rr] - mx); pt[j][rr] = e; ls += e; }
    ls += __shfl_xor(ls, 32);
    f32x16 o[2];
    o[0] = (f32x16){0.f, 0.f, 0.f, 0.f, 0.f, 0.f, 0.f, 0.f, 0.f, 0.f, 0.f, 0.f, 0.f, 0.f, 0.f, 0.f}; o[1] = o[0];
    const LAS unsigned char* vb = lds + V_OFF + ((lane >> 4) & 1) * 32 + (lane & 3) * 8 + (4 * hi + ((lane & 15) >> 2)) * 64;
#pragma unroll
    for (int j = 0; j < 5; ++j)
#pragma unroll
        for (int s = 0; s < 2; ++s) {
            v4u pw; pw.x = cvtpk(pt[j][8 * s + 0], pt[j][8 * s + 1]); pw.y = cvtpk(pt[j][8 * s + 2], pt[j][8 * s + 3]); pw.z = cvtpk(pt[j][8 * s + 4], pt[j][8 * s + 5]); pw.w = cvtpk(pt[j][8 * s + 6], pt[j][8 * s + 7]);
            const bf16x8 pa = __builtin_bit_cast(bf16x8, pw);
            const int k0 = 32 * (w + j) + 16 * s;
#pragma unroll
            for (int d0 = 0; d0 < 2; ++d0) { const LAS unsigned char* vp = vb + d0 * VHALF + k0 * 64;
                const bf16x8 vf = mk8(tr16(vp), tr16(vp + 512));
                o[d0] = __builtin_amdgcn_mfma_f32_32x32x16_bf16(pa, vf, o[d0], 0, 0, 0); }
        }
#ifdef MK_ATT_DUP
    {
        f32x16 dm = o[0];
#pragma unroll
        for (int j = 0; j < 5; ++j) { const int row = 32 * (w + j) + r32;
#pragma unroll
            for (int d0 = 0; d0 < 4; ++d0) { const bf16x8 kf = *(const LAS bf16x8*)(lds + K_OFF + row * 128 + (((2 * d0 + hi) ^ ((row >> 1) & 7)) << 4)); asm volatile("" : "+v"(dm));
                dm = __builtin_amdgcn_mfma_f32_32x32x16_bf16(kf, qr[d0], dm, 0, 0, 0); } }
#pragma unroll
        for (int j = 0; j < 5; ++j)
#pragma unroll
            for (int s = 0; s < 2; ++s) { const int k0 = 32 * (w + j) + 16 * s;
#pragma unroll
                for (int d0 = 0; d0 < 2; ++d0) { const LAS unsigned char* vp = vb + d0 * VHALF + k0 * 64; const bf16x8 vf = mk8(tr16(vp), tr16(vp + 512)); asm volatile("" : "+v"(dm));
                    dm = __builtin_amdgcn_mfma_f32_32x32x16_bf16(qr[d0], vf, dm, 0, 0, 0); } }
        asm volatile("" :: "v"(dm));
    }
#endif
    volatile LAS float* scr = (volatile LAS float*)(lds + SCR_OFF) + w * 64;
    if (hi == 0) scr[r32] = ls;
    LDS_WAIT();
    LAS bf16* stg = (LAS bf16*)(lds + OST_OFF) + w * 2048;
#pragma unroll
    for (int rr = 0; rr < 16; ++rr) { const int orow = crow(rr, hi); const float rl = 1.0f / scr[orow];
#pragma unroll
        for (int d0 = 0; d0 < 2; ++d0) stg[orow * 64 + d0 * 32 + r32] = (bf16)(cvtpk(o[d0][rr] * rl, 0.f) & 0xffffu); }
    LDS_WAIT(); asm volatile("" ::: "memory");
    bf16* Op = F.OPART + ((size_t)p * 32 + bh) * SEQ * 64;
#pragma unroll
    for (int i = 0; i < 4; ++i) { const int row = i * 8 + (lane >> 3), ch = lane & 7; const v4u v = *(const LAS v4u*)(stg + row * 64 + ch * 8);
        const int tok = ((256 * sb + 32 * w + row) << dsh) + r;
        *(GAS v4u*)(Op + (size_t)((tok & 15) * 512 + (tok >> 4)) * 64 + ch * 8) = v; }
    if (hi == 0) F.LSE[((size_t)p * 32 + bh) * SEQ + (qtk & 15) * 512 + (qtk >> 4)] = mx + log2f(ls);
    }
}

namespace ret {
constexpr int KRP = 192, VRP = 320;
constexpr int KV_K = 0, KV_V = 128 * KRP;
static_assert(KV_V + 128 * VRP <= RING_BYTES, "ret kv LDS");
constexpr int QRP = 144;
constexpr int O_QA = 0, O_QD = 128 * QRP, O_KA = 2 * 128 * QRP, O_VA = 3 * 128 * QRP, O_SA = O_VA + 128 * VRP, O_END = O_SA + 64 * VRP;
static_assert(O_END <= RING_BYTES, "ret out LDS");
constexpr int O_OUT = 0;
}
__device__ __forceinline__ void rot8(const v4u a, const v4u bq, const f32x2v* cs, float sc, v4u& o1, v4u& o2) {
    float x1[8], x2[8], y1[8], y2[8];
    x1[0] = bf_lo(a.x); x1[1] = bf_hi(a.x); x1[2] = bf_lo(a.y); x1[3] = bf_hi(a.y); x1[4] = bf_lo(a.z); x1[5] = bf_hi(a.z); x1[6] = bf_lo(a.w); x1[7] = bf_hi(a.w);
    x2[0] = bf_lo(bq.x); x2[1] = bf_hi(bq.x); x2[2] = bf_lo(bq.y); x2[3] = bf_hi(bq.y); x2[4] = bf_lo(bq.z); x2[5] = bf_hi(bq.z); x2[6] = bf_lo(bq.w); x2[7] = bf_hi(bq.w);
#pragma unroll
    for (int i = 0; i < 8; ++i) { const f32x2v c = cs[i]; y1[i] = (x1[i] * c.x - x2[i] * c.y) * sc; y2[i] = (x1[i] * c.y + x2[i] * c.x) * sc; }
    o1.x = cvtpk(y1[0], y1[1]); o1.y = cvtpk(y1[2], y1[3]); o1.z = cvtpk(y1[4], y1[5]); o1.w = cvtpk(y1[6], y1[7]);
    o2.x = cvtpk(y2[0], y2[1]); o2.y = cvtpk(y2[2], y2[3]); o2.z = cvtpk(y2[4], y2[5]); o2.w = cvtpk(y2[6], y2[7]);
}
__device__ __forceinline__ void retkv_unit(Frame& F, int u) {
    using namespace ret;
    const int tid = F.tid, lane = F.lane, w = F.wave, r32 = lane & 31, hi = lane >> 5;
    const int bh = u >> 6, n = u & 63, b = bh >> 2, h = bh & 3;
    LAS unsigned char* lds = F.lds + RING_OFF;
    const bf16* Kh = F.PROJ + ((size_t)56 << 20) + ((size_t)bh * SEQ + 128 * n) * 64;
    const bf16* Vh = F.PROJ + ((size_t)64 << 20) + ((size_t)bh * SEQ + 128 * n) * 128;
    const float lg = lg2gamma(h);
    __syncthreads();
    {
        const int j = tid >> 2, c = tid & 3, t = 128 * n + j;
        const bf16* src = Kh + (size_t)j * 64 + 8 * c;
        const v4u a = *(const GAS v4u*)src, bq = *(const GAS v4u*)(src + 32);
        f32x2v cs[8];
#pragma unroll
        for (int i = 0; i < 8; ++i) cs[i] = F.ROPE[t * 32 + 8 * c + i];
        v4u o1, o2; rot8(a, bq, cs, __builtin_amdgcn_exp2f(lg * (float)(127 - j)), o1, o2);
        *(LAS v4u*)(lds + KV_K + j * KRP + 16 * c) = o1; *(LAS v4u*)(lds + KV_K + j * KRP + 64 + 16 * c) = o2;
#pragma unroll
        for (int it = 0; it < 4; ++it) { const int idx = tid + NTHR * it, jj = idx >> 4, cc = idx & 15;
            *(LAS v4u*)(lds + KV_V + jj * VRP + 16 * cc) = *(const GAS v4u*)(Vh + (size_t)jj * 128 + 8 * cc); }
    }
    __syncthreads();
    const int dt = w & 1, et = w >> 1;
    f32x16 acc = (f32x16){0.f, 0.f, 0.f, 0.f, 0.f, 0.f, 0.f, 0.f, 0.f, 0.f, 0.f, 0.f, 0.f, 0.f, 0.f, 0.f};
    const int rq = 4 * hi + ((lane & 15) >> 2), cq = 16 * ((lane >> 4) & 1) + 4 * (lane & 3);
    const LAS unsigned char* ka = lds + KV_K + rq * KRP + (32 * dt + cq) * 2;
    const LAS unsigned char* va = lds + KV_V + rq * VRP + (32 * et + cq) * 2;
#pragma unroll
    for (int ks = 0; ks < 8; ++ks) {
        const bf16x8 af = mk8(tr16(ka + 16 * ks * KRP), tr16(ka + (16 * ks + 8) * KRP));
        const bf16x8 bfv = mk8(tr16(va + 16 * ks * VRP), tr16(va + (16 * ks + 8) * VRP));
        acc = __builtin_amdgcn_mfma_f32_32x32x16_bf16(af, bfv, acc, 0, 0, 0);
    }
    float* dst = F.KV + (size_t)u * 8192;
#pragma unroll
    for (int rr = 0; rr < 16; ++rr) dst[(32 * dt + crow(rr, hi)) * 128 + 32 * et + r32] = acc[rr];
}

__device__ __forceinline__ void p3_scan_combine(Frame& F) {
    for (int e = F.vcu * NTHR + F.tid; e < 16 * 8192; e += F.G * NTHR) {
        const int bh = e >> 13, de = e & 8191; const float cd = __builtin_amdgcn_exp2f(lg2gamma(bh & 3) * 128.0f);
        float* p = F.KV + (size_t)bh * 64 * 8192 + de; float st = 0.f;
        for (int n0 = 0; n0 < 64; n0 += 8) { float cur[8];
#pragma unroll
            for (int i = 0; i < 8; ++i) cur[i] = p[(size_t)(n0 + i) * 8192];
#pragma unroll
            for (int i = 0; i < 8; ++i) { p[(size_t)(n0 + i) * 8192] = st; st = cd * st + cur[i]; } }
    }
    for (int it = F.vcu * NTHR + F.tid; it < M * 64; it += F.G * NTHR) {
        const int row = it >> 6, h = (it >> 3) & 7, c = it & 7; const int t = row & (SEQ - 1), bh = (row >> 13) * 8 + h;
        const size_t li = (size_t)bh * SEQ + (t & 15) * 512 + (t >> 4);
        const float l0 = F.LSE[li], l1 = F.LSE[(size_t)32 * SEQ + li], l2 = F.LSE[(size_t)64 * SEQ + li];
        const float mx = fmaxf(l0, fmaxf(l1, l2)); float w0 = __builtin_amdgcn_exp2f(l0 - mx), w1 = __builtin_amdgcn_exp2f(l1 - mx), w2 = __builtin_amdgcn_exp2f(l2 - mx);
        const float inv = 1.0f / (w0 + w1 + w2); w0 *= inv; w1 *= inv; w2 *= inv;
        const size_t off = li * 64 + c * 8;
        const v4u a = *(const GAS v4u*)(F.OPART + off), bq = *(const GAS v4u*)(F.OPART + (size_t)M * 512 + off), cq = *(const GAS v4u*)(F.OPART + (size_t)2 * M * 512 + off);
        v4u o;
        o.x = cvtpk(w0 * bf_lo(a.x) + w1 * bf_lo(bq.x) + w2 * bf_lo(cq.x), w0 * bf_hi(a.x) + w1 * bf_hi(bq.x) + w2 * bf_hi(cq.x));
        o.y = cvtpk(w0 * bf_lo(a.y) + w1 * bf_lo(bq.y) + w2 * bf_lo(cq.y), w0 * bf_hi(a.y) + w1 * bf_hi(bq.y) + w2 * bf_hi(cq.y));
        o.z = cvtpk(w0 * bf_lo(a.z) + w1 * bf_lo(bq.z) + w2 * bf_lo(cq.z), w0 * bf_hi(a.z) + w1 * bf_hi(bq.z) + w2 * bf_hi(cq.z));
        o.w = cvtpk(w0 * bf_lo(a.w) + w1 * bf_lo(bq.w) + w2 * bf_lo(cq.w), w0 * bf_hi(a.w) + w1 * bf_hi(bq.w) + w2 * bf_hi(cq.w));
        *(GAS v4u*)(F.MIXED + (size_t)row * DM + h * 64 + c * 8) = o;
    }
}

__device__ __forceinline__ void retout_unit(Frame& F, int u) {
    using namespace ret;
    const int tid = F.tid, lane = F.lane, w = F.wave, r32 = lane & 31, hi = lane >> 5;
    const int bh = u >> 6, n = u & 63, b = bh >> 2, h = bh & 3;
    LAS unsigned char* lds = F.lds + RING_OFF;
    const size_t row0 = (size_t)b * SEQ + 128 * n;
    const size_t hrow0 = (size_t)bh * SEQ + 128 * n;
    const bf16* Qh = F.PROJ + ((size_t)48 << 20) + hrow0 * 64; const bf16* Kh = F.PROJ + ((size_t)56 << 20) + hrow0 * 64;
    const bf16* Vh = F.PROJ + ((size_t)64 << 20) + hrow0 * 128; const bf16* Gh = F.PROJ + ((size_t)80 << 20) + hrow0 * 128;
    const float lg = lg2gamma(h);
    __syncthreads();
    {
        const int i = tid >> 2, c = tid & 3, t = 128 * n + i;
        f32x2v cs[8];
#pragma unroll
        for (int k = 0; k < 8; ++k) cs[k] = F.ROPE[t * 32 + 8 * c + k];
        const bf16* sq = Qh + (size_t)i * 64 + 8 * c;
        v4u a = *(const GAS v4u*)sq, bq = *(const GAS v4u*)(sq + 32), o1, o2;
        rot8(a, bq, cs, 1.0f, o1, o2);
        *(LAS v4u*)(lds + O_QA + i * QRP + 16 * c) = o1; *(LAS v4u*)(lds + O_QA + i * QRP + 64 + 16 * c) = o2;
        rot8(a, bq, cs, __builtin_amdgcn_exp2f(lg * (float)(i + 1)), o1, o2);
        *(LAS v4u*)(lds + O_QD + i * QRP + 16 * c) = o1; *(LAS v4u*)(lds + O_QD + i * QRP + 64 + 16 * c) = o2;
        const bf16* sk = Kh + (size_t)i * 64 + 8 * c;
        a = *(const GAS v4u*)sk; bq = *(const GAS v4u*)(sk + 32);
        rot8(a, bq, cs, 1.0f, o1, o2);
        *(LAS v4u*)(lds + O_KA + i * QRP + 16 * c) = o1; *(LAS v4u*)(lds + O_KA + i * QRP + 64 + 16 * c) = o2;
#pragma unroll
        for (int it = 0; it < 4; ++it) { const int idx = tid + NTHR * it, jj = idx >> 4, cc = idx & 15;
            *(LAS v4u*)(lds + O_VA + jj * VRP + 16 * cc) = *(const GAS v4u*)(Vh + (size_t)jj * 128 + 8 * cc); }
        const float* sp = F.KV + (size_t)u * 8192 + tid * 16; const int sd = tid >> 3, se = (tid & 7) * 16;
        const f32x4 s0 = *(const GAS f32x4*)sp, s1 = *(const GAS f32x4*)(sp + 4), s2 = *(const GAS f32x4*)(sp + 8), s3 = *(const GAS f32x4*)(sp + 12);
        v4u q0, q1; q0.x = cvtpk(s0.x, s0.y); q0.y = cvtpk(s0.z, s0.w); q0.z = cvtpk(s1.x, s1.y); q0.w = cvtpk(s1.z, s1.w);
        q1.x = cvtpk(s2.x, s2.y); q1.y = cvtpk(s2.z, s2.w); q1.z = cvtpk(s3.x, s3.y); q1.w = cvtpk(s3.z, s3.w);
        *(LAS v4u*)(lds + O_SA + sd * VRP + se * 2) = q0; *(LAS v4u*)(lds + O_SA + sd * VRP + se * 2 + 16) = q1;
    }
    __syncthreads();
    const int qt = w & 3, eh = w >> 2;
    bf16x8 qf[4], qd[4];
#pragma unroll
    for (int ds = 0; ds < 4; ++ds) { qf[ds] = *(const LAS bf16x8*)(lds + O_QA + (32 * qt + r32) * QRP + (2 * ds + hi) * 16); qd[ds] = *(const LAS bf16x8*)(lds + O_QD + (32 * qt + r32) * QRP + (2 * ds + hi) * 16); }
    f32x16 o[2];
    o[0] = (f32x16){0.f, 0.f, 0.f, 0.f, 0.f, 0.f, 0.f, 0.f, 0.f, 0.f, 0.f, 0.f, 0.f, 0.f, 0.f, 0.f}; o[1] = o[0];
    const int rq = (lane & 15) >> 2, cq = 16 * ((lane >> 4) & 1) + 4 * (lane & 3);
#pragma unroll
    for (int kt = 0; kt < 4; ++kt) if (kt <= qt) {
        f32x16 pt = (f32x16){0.f, 0.f, 0.f, 0.f, 0.f, 0.f, 0.f, 0.f, 0.f, 0.f, 0.f, 0.f, 0.f, 0.f, 0.f, 0.f};
#pragma unroll
        for (int ds = 0; ds < 4; ++ds) { const bf16x8 kf = *(const LAS bf16x8*)(lds + O_KA + (32 * kt + r32) * QRP + (2 * ds + hi) * 16);
            pt = __builtin_amdgcn_mfma_f32_32x32x16_bf16(kf, qf[ds], pt, 0, 0, 0); }
#pragma unroll
        for (int rr = 0; rr < 16; ++rr) { const int dd = (32 * qt + r32) - (32 * kt + crow(rr, hi)); pt[rr] = (dd >= 0) ? pt[rr] * __builtin_amdgcn_exp2f(lg * (float)dd) : 0.f; }
#pragma unroll
        for (int s = 0; s < 2; ++s) {
            v4u pw; pw.x = cvtpk(pt[8 * s + 0], pt[8 * s + 1]); pw.y = cvtpk(pt[8 * s + 2], pt[8 * s + 3]); pw.z = cvtpk(pt[8 * s + 4], pt[8 * s + 5]); pw.w = cvtpk(pt[8 * s + 6], pt[8 * s + 7]);
            const bf16x8 pa = __builtin_bit_cast(bf16x8, pw);
#pragma unroll
            for (int d0 = 0; d0 < 2; ++d0) { const LAS unsigned char* vp = lds + O_VA + (32 * kt + 16 * s + 4 * hi + rq) * VRP + (64 * eh + 32 * d0 + cq) * 2;
                o[d0] = __builtin_amdgcn_mfma_f32_32x32x16_bf16(pa, mk8(tr16(vp), tr16(vp + 8 * VRP)), o[d0], 0, 0, 0); }
        }
    }
#pragma unroll
    for (int ds = 0; ds < 4; ++ds)
#pragma unroll
        for (int d0 = 0; d0 < 2; ++d0) { const LAS unsigned char* sp = lds + O_SA + (16 * ds + 8 * hi + rq) * VRP + (64 * eh + 32 * d0 + cq) * 2;
            o[d0] = __builtin_amdgcn_mfma_f32_32x32x16_bf16(qd[ds], mk8(tr16(sp), tr16(sp + 4 * VRP)), o[d0], 0, 0, 0); }
    __syncthreads();
    LAS float* outl = (LAS float*)(lds + O_OUT);
#pragma unroll
    for (int rr = 0; rr < 16; ++rr)
#pragma unroll
        for (int d0 = 0; d0 < 2; ++d0) outl[(32 * qt + crow(rr, hi)) * 128 + 64 * eh + 32 * d0 + r32] = o[d0][rr];
    __syncthreads();
    {
        const int i = tid >> 2, part = tid & 3;
        float v[32]; float ss = 0.f;
#pragma unroll
        for (int k = 0; k < 8; ++k) { const f32x4 t4 = *(const LAS f32x4*)(outl + i * 128 + 32 * part + 4 * k); v[4 * k] = t4.x; v[4 * k + 1] = t4.y; v[4 * k + 2] = t4.z; v[4 * k + 3] = t4.w; ss += (t4.x * t4.x + t4.y * t4.y) + (t4.z * t4.z + t4.w * t4.w); }
        ss += __shfl_xor(ss, 1); ss += __shfl_xor(ss, 2);
        const float rstd = 1.0f / sqrtf(ss * (1.0f / 128.0f) + NORM_EPS);
        const bf16* gp = Gh + (size_t)i * 128 + 32 * part;
        bf16* op = F.MIXED + (row0 + i) * DM + 512 + h * 128 + 32 * part;
#pragma unroll
        for (int k = 0; k < 4; ++k) { const v4u g = *(const GAS v4u*)(gp + 8 * k); float gv[8];
            gv[0] = bf_lo(g.x); gv[1] = bf_hi(g.x); gv[2] = bf_lo(g.y); gv[3] = bf_hi(g.y); gv[4] = bf_lo(g.z); gv[5] = bf_hi(g.z); gv[6] = bf_lo(g.w); gv[7] = bf_hi(g.w);
            float ov[8];
#pragma unroll
            for (int q = 0; q < 8; ++q) { const float sg = gv[q] * __builtin_amdgcn_rcpf(1.0f + __builtin_amdgcn_exp2f(-1.4426950408889634f * gv[q])); ov[q] = v[8 * k + q] * rstd * sg; }
            v4u ow; ow.x = cvtpk(ov[0], ov[1]); ow.y = cvtpk(ov[2], ov[3]); ow.z = cvtpk(ov[4], ov[5]); ow.w = cvtpk(ov[6], ov[7]);
            *(GAS v4u*)(op + 8 * k) = ow; }
    }
}

__device__ __forceinline__ void load_bf16_row(const bf16* row, int lane, f32x4 (&v)[4]) {
    const GAS u32x2* p = (const GAS u32x2*)row + lane;
#pragma unroll
    for (int j = 0; j < 4; ++j) { const u32x2 w = p[64 * j]; v[j] = (f32x4){bf_lo(w.x), bf_hi(w.x), bf_lo(w.y), bf_hi(w.y)}; }
}
__device__ __forceinline__ float sumsq4(const f32x4 (&v)[4]) { float s = 0.f;
#pragma unroll
    for (int j = 0; j < 4; ++j) s += (v[j].x * v[j].x + v[j].y * v[j].y) + (v[j].z * v[j].z + v[j].w * v[j].w);
    return s; }
__device__ __forceinline__ void p6_resnorm(Frame& F) {
    constexpr int R = 4;
    const int gw = F.vcu * NWAVES + F.wave, NGW = F.G * NWAVES, lane = F.lane;
    const GAS f32x4* g2 = (const GAS f32x4*)F.g_post + lane; const GAS f32x4* g3 = (const GAS f32x4*)F.g_fpre + lane;
    for (int m0 = gw * R; m0 < M; m0 += NGW * R) {
        f32x4 a[R][4], xv[R][4];
#pragma unroll
        for (int r = 0; r < R; ++r) { load_bf16_row(F.MIX + (size_t)(m0 + r) * DM, lane, a[r]); const GAS f32x4* xr = (const GAS f32x4*)(F.x + (size_t)(m0 + r) * DM) + lane;
#pragma unroll
            for (int j = 0; j < 4; ++j) xv[r][j] = xr[64 * j]; }
        float s[R];
#pragma unroll
        for (int r = 0; r < R; ++r) s[r] = sumsq4(a[r]);
#pragma unroll
        for (int o = 1; o < 64; o <<= 1) {
#pragma unroll
            for (int r = 0; r < R; ++r) s[r] += __shfl_xor(s[r], o); }
#pragma unroll
        for (int r = 0; r < R; ++r) { const float r2 = 1.f / sqrtf(s[r] * (1.f / DM) + NORM_EPS); GAS unsigned long long* x1b = (GAS unsigned long long*)(F.MIX + (size_t)(m0 + r) * DM) + lane;
#pragma unroll
            for (int j = 0; j < 4; ++j) { a[r][j] = xv[r][j] + a[r][j] * r2 * g2[64 * j];
                x1b[64 * j] = (unsigned long long)cvtpk(a[r][j].x, a[r][j].y) | ((unsigned long long)cvtpk(a[r][j].z, a[r][j].w) << 32); }
            s[r] = sumsq4(a[r]); }
#pragma unroll
        for (int o = 1; o < 64; o <<= 1) {
#pragma unroll
            for (int r = 0; r < R; ++r) s[r] += __shfl_xor(s[r], o); }
#pragma unroll
        for (int r = 0; r < R; ++r) { const float r3 = 1.f / sqrtf(s[r] * (1.f / DM) + NORM_EPS); GAS unsigned long long* o8 = (GAS unsigned long long*)(F.XN + (size_t)(m0 + r) * DM) + lane;
#pragma unroll
            for (int j = 0; j < 4; ++j) { const f32x4 g = g3[64 * j]; o8[64 * j] = (unsigned long long)cvtpk(a[r][j].x * r3 * g.x, a[r][j].y * r3 * g.y) | ((unsigned long long)cvtpk(a[r][j].z * r3 * g.z, a[r][j].w * r3 * g.w) << 32); } }
    }
}
__device__ __forceinline__ void p10_final(Frame& F, const float dscale, const float dadd) {
    constexpr int R = 4;
    const int gw = F.vcu * NWAVES + F.wave, NGW = F.G * NWAVES, lane = F.lane;
    const GAS f32x4* g4 = (const GAS f32x4*)F.g_fpost + lane;
    for (int m0 = gw * R; m0 < M; m0 += NGW * R) {
        f32x4 a[R][4], xv[R][4];
#pragma unroll
        for (int r = 0; r < R; ++r) { load_bf16_row(F.FFN + (size_t)(m0 + r) * DM, lane, a[r]); load_bf16_row(F.MIX + (size_t)(m0 + r) * DM, lane, xv[r]); }
        float s[R];
#pragma unroll
        for (int r = 0; r < R; ++r) s[r] = sumsq4(a[r]);
#pragma unroll
        for (int o = 1; o < 64; o <<= 1) {
#pragma unroll
            for (int r = 0; r < R; ++r) s[r] += __shfl_xor(s[r], o); }
#pragma unroll
        for (int r = 0; r < R; ++r) { const float r4 = 1.f / sqrtf(s[r] * (1.f / DM) + NORM_EPS); GAS f32x4* orow = (GAS f32x4*)(F.out + (size_t)(m0 + r) * DM) + lane;
#pragma unroll
            for (int j = 0; j < 4; ++j) { f32x4 o = (xv[r][j] + a[r][j] * r4 * g4[64 * j]) * dscale; if (m0 + r == 0 && lane == 0 && j == 0) o.x += dadd; orow[64 * j] = o; } }
    }
}
__device__ __forceinline__ void p8_fixup(Frame& F) {
    for (int it = F.vcu * NTHR + F.tid; it < (M / 64) * 2 * FF; it += F.G * NTHR) {
        const int ri = it / FF, j = it % FF, g = ri >> 1, which = ri & 1; const bool first = (g % (SEQ / 64)) == 0;
        float y[2];
#pragma unroll
        for (int hf = 0; hf < 2; ++hf) {
            const float* ubg = F.UB + ((size_t)g * 8 + hf) * FF + j;
            const float* ubp = ubg - (size_t)8 * FF;
            const int c = hf * FF + j;
            const float ut = ubg[(size_t)(2 + which) * 2 * FF];
            const float u1 = which ? ubg[(size_t)2 * 2 * FF] : (first ? 0.f : ubp[(size_t)1 * 2 * FF]);
            const float u2 = first ? 0.f : (which ? ubp[(size_t)1 * 2 * FF] : ubp[0]);
            y[hf] = F.conv_b[c] + F.conv_w[2 * FF2 + c] * ut + F.conv_w[FF2 + c] * u1 + F.conv_w[c] * u2;
        }
        const float a = pg8::gelu_tanh_f(y[0]) * y[1];
        F.ACT[(size_t)(64 * g + which) * FF + j] = (bf16)(cvtpk(a, 0.f) & 0xffffu);
    }
}

struct Args { const float* in[11]; float* out; unsigned char* ws; int ph_lo, ph_hi, li, pad; };
__global__ void __launch_bounds__(NTHR, 2) mk_fwd(Args args) {
    extern __shared__ __attribute__((aligned(16))) unsigned char lds[];
    Frame F;
    F.lds = (LAS unsigned char*)lds;
    F.MISC = (volatile LAS unsigned*)(F.lds + MISC_OFF);
    F.tid = threadIdx.x; F.lane = F.tid & 63; F.wave = __builtin_amdgcn_readfirstlane(F.tid >> 6);
    F.G = gridDim.x; { const int bx = blockIdx.x; F.vcu = (F.G % 8 == 0) ? (bx % 8) * (F.G / 8) + bx / 8 : bx; }
    unsigned char* ws = args.ws;
    F.ctl = (gu32*)(ws + WS_CTL);
    F.x = args.in[0]; F.g_pre = args.in[1]; F.g_post = args.in[2]; F.w_in = args.in[3]; F.w_out = args.in[4]; F.g_fpre = args.in[5]; F.g_fpost = args.in[6];
    F.w_up = args.in[7]; F.conv_w = args.in[8]; F.conv_b = args.in[9]; F.w_down = args.in[10]; F.out = args.out;
    F.Win_t = (bf16*)(ws + WS_WIN); F.Wout_t = (bf16*)(ws + WS_WOUT); F.Wup_t = (bf16*)(ws + WS_WUP); F.Wdn_t = (bf16*)(ws + WS_WDN);
    F.XN = (bf16*)(ws + WS_XN); F.PROJ = (bf16*)(ws + WS_PROJ); F.ACT = (bf16*)(ws + WS_ACT); F.OPART = (bf16*)(ws + WS_OPART); F.MIX = (bf16*)(ws + WS_MIX);
    F.FFN = (bf16*)(ws + WS_FFN); F.MIXED = (bf16*)(ws + WS_MIXED); F.LSE = (float*)(ws + WS_LSE); F.UB = (float*)(ws + WS_UB); F.KV = (float*)(ws + WS_KV);
    F.ROPE = (f32x2v*)(ws + WS_ROPE);
    for (int u = F.tid; u < (LDS_BYTES - LDSCTL_OFF) / 4; u += NTHR) ((LAS unsigned*)(F.lds + LDSCTL_OFF))[u] = 0u;
    __syncthreads();
    XcdBarrier bar; bar.bar = (unsigned*)(F.ctl + CW_BAR) + args.li * XCD_BAR_WORDS; bar.x = 0; bar.st = nullptr;
    const int lo = args.ph_lo, hi = args.ph_hi;
    if (hi - lo > 1) bar = xcd_barrier_post((unsigned*)(F.ctl + CW_BAR) + args.li * XCD_BAR_WORDS, F.MISC + 8);
#define IN(k) (lo <= (k) && (k) < hi)
#ifndef MK_REP_MASK
#define MK_REP_MASK 0
#endif
#define REPEAT(k) _Pragma("unroll") for (int rep_ = 0, nrep_ = ((MK_REP_MASK >> (k)) & 1) ? 2 : 1; rep_ < nrep_; ++rep_)
#define REPSYNC(k) do { if (rep_ + 1 < nrep_) xcd_barrier(bar); } while (0)
#ifdef MK_DIAG_A
    unsigned long long* const tsb = (unsigned long long*)(ws + WS_CTL + 32768);
    if (blockIdx.x == 0 && F.tid == 0) tsb[0] = __builtin_amdgcn_s_memrealtime();
#define SEAM(k) do { if (IN(k) && IN((k) + 1)) { xcd_barrier(bar); if (blockIdx.x == 0 && F.tid == 0) { tsb[(k) + 1] = __builtin_amdgcn_s_memrealtime(); asm volatile("s_waitcnt vmcnt(0)" ::: "memory"); } } } while (0)
#else
#define SEAM(k) do { if (IN(k) && IN((k) + 1)) xcd_barrier(bar); } while (0)
#endif

    if (IN(0)) { REPEAT(0) { p0_prep(F); REPSYNC(0); } SEAM(0); }
    if (IN(1)) {
        pg8::Gemm g{F.XN, F.Win_t, M, INW, DM}; pg8::StaticOrder S; S.init(M, INW, F.G, (int)blockIdx.x);
        pg8::EpiProj E{F.PROJ, QSCALE};
        REPEAT(1) { pg8::gemm_phase<pg8::EpiProj, pg8::StaticOrder, true, true>(F.lds + RING_OFF, g, S, E); REPSYNC(1); }
        SEAM(1);
    }
    if (IN(2)) { REPEAT(2) {
        { const int NU = 3 * 1024; const int u0 = (int)((long)F.vcu * NU / F.G), u1 = (int)((long)(F.vcu + 1) * NU / F.G); attn_units(F, u0, u1); }
        { const int NU = 1024; const int u0 = (int)((long)F.vcu * NU / F.G), u1 = (int)((long)(F.vcu + 1) * NU / F.G); for (int u = u0; u < u1; ++u) retkv_unit(F, u); }
        __syncthreads(); REPSYNC(2); }
        SEAM(2);
    }
    if (IN(3)) { p3_scan_combine(F); SEAM(3); }
    if (IN(4)) { REPEAT(4) {
        { const int NU = 1024; const int u0 = (int)((long)F.vcu * NU / F.G), u1 = (int)((long)(F.vcu + 1) * NU / F.G); for (int u = u0; u < u1; ++u) retout_unit(F, u); }
        __syncthreads(); REPSYNC(4); }
        SEAM(4);
    }
    if (IN(5)) {
        pg8::Gemm g{F.MIXED, F.Wout_t, M, DM, DM}; pg8::StaticOrder S; S.init(M, DM, F.G, (int)blockIdx.x);
        pg8::EpiStore E{F.MIX, DM, 0, 1.0f, -1, 1.0f};
        REPEAT(5) { pg8::gemm_phase<pg8::EpiStore, pg8::StaticOrder, true, true>(F.lds + RING_OFF, g, S, E); REPSYNC(5); }
        SEAM(5);
    }
    if (IN(6)) { REPEAT(6) { p6_resnorm(F); REPSYNC(6); } SEAM(6); }
    if (IN(7)) {
        pg8::Gemm g{F.XN, F.Wup_t, M, FF2, DM}; pg8::StaticOrder S; S.init(M, FF2, F.G, (int)blockIdx.x);
        pg8::EpiConvAct E{F.ACT, F.UB, F.conv_w, F.conv_b};
        REPEAT(7) { pg8::gemm_phase<pg8::EpiConvAct, pg8::StaticOrder, true, true>(F.lds + RING_OFF, g, S, E); REPSYNC(7); }
        SEAM(7);
    }
    if (IN(8)) { REPEAT(8) { p8_fixup(F); REPSYNC(8); } SEAM(8); }
    if (IN(9)) {
        pg8::Gemm g{F.ACT, F.Wdn_t, M, DM, FF}; pg8::StaticOrder S; S.init(M, DM, F.G, (int)blockIdx.x);
        pg8::EpiStore E{F.FFN, DM, 0, 1.0f, -1, 1.0f};
        REPEAT(9) { pg8::gemm_phase<pg8::EpiStore, pg8::StaticOrder, true, true>(F.lds + RING_OFF, g, S, E); REPSYNC(9); }
        SEAM(9);
    }
#ifdef MK_DIAG_A
    if (IN(10)) { const unsigned long long* tsr = (const unsigned long long*)(ws + WS_CTL + 32768);
        const float dA = (float)(__hip_atomic_load(tsr + MK_DIAG_A + 1, __ATOMIC_RELAXED, __HIP_MEMORY_SCOPE_AGENT) - __hip_atomic_load(tsr + MK_DIAG_A, __ATOMIC_RELAXED, __HIP_MEMORY_SCOPE_AGENT)) * 0.01f;
        const float dB = (float)(__hip_atomic_load(tsr + MK_DIAG_B + 1, __ATOMIC_RELAXED, __HIP_MEMORY_SCOPE_AGENT) - __hip_atomic_load(tsr + MK_DIAG_B, __ATOMIC_RELAXED, __HIP_MEMORY_SCOPE_AGENT)) * 0.01f;
        p10_final(F, 1.0f + dA * MK_DIAG_SCALE, dB); }
#else
    if (IN(10)) { p10_final(F, 1.0f, 0.0f); }
#endif
#undef IN
#undef SEAM
}

extern "C" void kernel_launch(void* const* d_in, const int* in_sizes, int n_in, void* d_out, int out_size, void* d_ws, size_t ws_size, hipStream_t stream) {
    static int grid = 0;
    if (grid == 0) {
        if (n_in != 11 || in_sizes[0] != M * DM || out_size != M * DM || ws_size < WS_END) { fprintf(stderr, "kernel_launch: unexpected shapes (n_in %d in0 %d out %d ws %zu); nothing launched\n", n_in, n_in > 0 ? in_sizes[0] : -1, out_size, ws_size); grid = -1; return; }
        int dev = 0, cus = 0, per_cu = 0;
        if (hipGetDevice(&dev) != hipSuccess || hipDeviceGetAttribute(&cus, hipDeviceAttributeMultiprocessorCount, dev) != hipSuccess) { grid = -1; return; }
        if (hipFuncSetAttribute((const void*)mk_fwd, hipFuncAttributeMaxDynamicSharedMemorySize, LDS_BYTES) != hipSuccess) { fprintf(stderr, "kernel_launch: hipFuncSetAttribute failed\n"); grid = -1; return; }
        if (hipOccupancyMaxActiveBlocksPerMultiprocessor(&per_cu, (const void*)mk_fwd, NTHR, LDS_BYTES) != hipSuccess || per_cu < 1) fprintf(stderr, "kernel_launch: occupancy query says %d blocks per CU\n", per_cu);
        (void)hipGetLastError();
        grid = cus;
    }
    if (grid < 0) return;
    if (hipMemsetAsync((char*)d_ws + WS_CTL, 0, CTL_ZERO_BYTES, stream) != hipSuccess) return;
    Args a{};
    for (int i = 0; i < 11; ++i) a.in[i] = (const float*)d_in[i];
    a.out = (float*)d_out; a.ws = (unsigned char*)d_ws;
#if MK_N_LAUNCHES == 1
    a.ph_lo = 0; a.ph_hi = N_PHASES; a.li = 0;
    hipLaunchKernelGGL(mk_fwd, dim3(grid), dim3(NTHR), LDS_BYTES, stream, a);
#else
    for (int li = 0; li < N_PHASES; ++li) { a.ph_lo = li; a.ph_hi = li + 1; a.li = 0; hipLaunchKernelGGL(mk_fwd, dim3(grid), dim3(NTHR), LDS_BYTES, stream, a); }
#endif
}
```

```cpp
#include <hip/hip_runtime.h>
#include <cstdio>
#include <cstdint>
#define MK_N_LAUNCHES 1

namespace pg8 {
#define PG8_LAS __attribute__((address_space(3)))
typedef unsigned short bf16_t;
typedef short bf16x8 __attribute__((ext_vector_type(8)));
typedef float f32x4 __attribute__((ext_vector_type(4)));
typedef unsigned u32x4 __attribute__((ext_vector_type(4)));
constexpr int BM = 256, BK = 64, HALF = 128, HTB = HALF * BK * 2  , STAGE_BYTES = 8 * HTB, NXCD = 8, WGM = 8;

__host__ __device__ __forceinline__ int lds_byte(int r, int c) { const int st = (r >> 4) * 2 + (c >> 5), rr = r & 15, cc = c & 31, ob = rr * 64 + cc * 2; return st * 1024 + (ob ^ (((ob >> 9) & 1) << 5)); }
__host__ __device__ __forceinline__ void stage_rc(int b, int& R, int& C) { const int st = b / 1024, sb = b % 1024, swz = sb ^ (((sb >> 9) & 1) << 5); R = (st >> 1) * 16 + swz / 64; C = (st & 1) * 32 + (swz % 64) / 2; }
__host__ __device__ __forceinline__ int perm32(int rho) { const int n = rho >> 4, i = rho & 15; return 8 * (i >> 2) + 4 * n + (i & 3); }

struct Unit { int pm, pn; };
struct Gemm { const bf16_t* A; const bf16_t* Bt; int M, N, K; };

struct StaticOrder {
    int nM, nN, nwg, G, c;
    __host__ __device__ void init(int M, int N, int G_, int c_) { nM = M / BM; nN = N / BM; nwg = nM * nN; G = G_; c = c_; }
    __host__ __device__ bool next(int i, Unit& u) const {
        const long L = (long)i * G + c; if (L >= nwg) return false;
        int wgid = (int)L; { const int q = nwg / NXCD, r = nwg % NXCD, xcd = wgid % NXCD, off = wgid / NXCD; wgid = (xcd < r ? xcd * (q + 1) : r * (q + 1) + (xcd - r) * q) + off; }
        const int nig = WGM * nN, gid = wgid / nig, fm = gid * WGM, gsz = (nM - fm) < WGM ? (nM - fm) : WGM;
        u.pm = fm + ((wgid % nig) % gsz); u.pn = (wgid % nig) / gsz; return true;
    }
    __device__ __forceinline__ void a_ready(const Unit&) const {}
    __device__ __forceinline__ void done(const Unit&) const {}
};

__device__ __forceinline__ unsigned cvt_pk_bf16(float lo, float hi) { unsigned r; asm volatile("v_cvt_pk_bf16_f32 %0, %1, %2" : "=v"(r) : "v"(lo), "v"(hi)); return r; }
typedef float f32x2 __attribute__((ext_vector_type(2)));
__device__ __forceinline__ f32x2 gelu_pk(f32x2 v) {
    const f32x2 av = __builtin_elementwise_abs(v), d = av * 0.2316418882f + 1.0f;
    f32x2 t; t.x = __builtin_amdgcn_rcpf(d.x); t.y = __builtin_amdgcn_rcpf(d.y);
    f32x2 q = t * 0.5307027145f + (-0.7265760135f); q = q * t + 0.7107068705f; q = q * t + (-0.142248368f); q = q * t + 0.127414796f; q = q * t;
    const f32x2 s = (v * v) * (-0.72134752044f);
    f32x2 e; e.x = __builtin_amdgcn_exp2f(s.x); e.y = __builtin_amdgcn_exp2f(s.y);
    const f32x2 m = v * (q * e), r = v - m;
    f32x2 o; o.x = v.x < 0.f ? m.x : r.x; o.y = v.y < 0.f ? m.y : r.y; return o;
}

template <int ACT  > struct EpiBf16 {
    static constexpr bool PERM = true, AFTER_DRAIN = false; static_assert(ACT == 0 || ACT == 1, "EpiBf16: ACT is 0 (none) or 1 (gelu_pk)");
    bf16_t* O; int ldc; const float* bias; int split_cols; size_t split_stride; float scale0;
    __device__ __forceinline__ void operator()(const f32x4 (&acc)[2][2][4][2], const Unit& u, int wr, int wc, int fr, int fq) const {
        const int row0 = u.pm * BM + wr * 64 + fr; int colt = u.pn * BM; bf16_t* base = O;
        float sc = 1.f; if (split_cols) { const int t = colt / split_cols; base += (size_t)t * split_stride; colt -= t * split_cols; if (t == 0) sc = scale0; }
        const int col0 = colt + wc * 32 + 8 * fq, bcol0 = u.pn * BM + wc * 32 + 8 * fq;
        f32x4 bv[2][2];
#pragma unroll
        for (int bj = 0; bj < 2; ++bj)
#pragma unroll
            for (int n = 0; n < 2; ++n) bv[bj][n] = bias ? *(const f32x4*)(bias + bcol0 + bj * HALF + 4 * n) : (f32x4){0.f, 0.f, 0.f, 0.f};
#pragma unroll
        for (int ai = 0; ai < 2; ++ai)
#pragma unroll
            for (int m = 0; m < 4; ++m) { bf16_t* rowp = base + (size_t)(row0 + ai * HALF + m * 16) * ldc + col0;
#pragma unroll
                for (int bj = 0; bj < 2; ++bj) { f32x4 v0 = acc[ai][bj][m][0] + bv[bj][0], v1 = acc[ai][bj][m][1] + bv[bj][1];
                    if (ACT == 1) { f32x2 a = gelu_pk((f32x2){v0[0], v0[1]}), b = gelu_pk((f32x2){v0[2], v0[3]}), c = gelu_pk((f32x2){v1[0], v1[1]}), d = gelu_pk((f32x2){v1[2], v1[3]});
                        v0 = (f32x4){a.x, a.y, b.x, b.y}; v1 = (f32x4){c.x, c.y, d.x, d.y}; }
                    v0 = v0 * sc; v1 = v1 * sc; u32x4 w; w.x = cvt_pk_bf16(v0[0], v0[1]); w.y = cvt_pk_bf16(v0[2], v0[3]); w.z = cvt_pk_bf16(v1[0], v1[1]); w.w = cvt_pk_bf16(v1[2], v1[3]);
                    *(u32x4*)(rowp + bj * HALF) = w; } }
    }
};

struct PanelStats {
    unsigned* xbuf;
    unsigned* cnt;
    unsigned* tmo;
    int ntn; float eps;
    unsigned code;
    __device__ __forceinline__ bool run(const f32x4 (&v)[2][2][4][2], const Unit& u, int wr, int wc, int fr, int fq, PG8_LAS unsigned char* lds, int wid, int lane) const {
        typedef float f32x2v __attribute__((ext_vector_type(2)));
        PG8_LAS f32x2v* P = (PG8_LAS f32x2v*)lds;
        PG8_LAS f32x2v* S = (PG8_LAS f32x2v*)(lds + 8192);
        PG8_LAS unsigned* flag = (PG8_LAS unsigned*)(lds + 8192 + 2048);
#pragma unroll
        for (int ai = 0; ai < 2; ++ai)
#pragma unroll
            for (int m = 0; m < 4; ++m) {
                float s = 0.f;
#pragma unroll
                for (int bj = 0; bj < 2; ++bj)
#pragma unroll
                    for (int n = 0; n < 2; ++n) { const f32x4 x = v[ai][bj][m][n]; s += (x[0] + x[1]) + (x[2] + x[3]); }
                s += __shfl_xor(s, 16); s += __shfl_xor(s, 32);
                const float mw = s * (1.0f / 64.0f); float q = 0.f;
#pragma unroll
                for (int bj = 0; bj < 2; ++bj)
#pragma unroll
                    for (int n = 0; n < 2; ++n) { const f32x4 d = v[ai][bj][m][n] - mw; q += (d[0] * d[0] + d[1] * d[1]) + (d[2] * d[2] + d[3] * d[3]); }
                q += __shfl_xor(q, 16); q += __shfl_xor(q, 32);
                if (fq == 0) P[(ai * HALF + wr * 64 + m * 16 + fr) * 4 + wc] = (f32x2v){mw, q};
            }
        asm volatile("s_waitcnt lgkmcnt(0)" ::: "memory"); __builtin_amdgcn_s_barrier(); asm volatile("" ::: "memory");
#if defined(BROKEN_EXCHANGE_NO_WAIT)
#warning BROKEN CONTROL BUILD: the row-statistics exchange does not wait; results are wrong by design
        if (blockIdx.x >= 64) { const long long t0_ = clock64(); while (clock64() - t0_ < 60000) __builtin_amdgcn_s_sleep(8); }
#endif
        const int row = wid * 32 + (lane & 31);
        if (lane < 32) {
            const f32x2v a = P[row * 4 + 0], b = P[row * 4 + 1], c = P[row * 4 + 2], d = P[row * 4 + 3];
            const float mt = (a.x + b.x + c.x + d.x) * 0.25f;
            const float da = a.x - mt, db = b.x - mt, dc = c.x - mt, dd = d.x - mt;
            const float m2 = (a.y + b.y) + (c.y + d.y) + 64.0f * ((da * da + db * db) + (dc * dc + dd * dd));
            unsigned long long* slot = (unsigned long long*)xbuf + ((size_t)(u.pm * BM + row) * 4 + u.pn);
            __hip_atomic_store(slot, ((unsigned long long)__float_as_uint(m2) << 32) | __float_as_uint(mt), __ATOMIC_RELAXED, __HIP_MEMORY_SCOPE_AGENT);
        }
        asm volatile("s_waitcnt vmcnt(0)" ::: "memory");
        if (lane == 0) __hip_atomic_fetch_add(cnt + 64 * u.pm, 1u, __ATOMIC_RELAXED, __HIP_MEMORY_SCOPE_AGENT);
        if (wid == 0) {
            bool dead = false; const unsigned long long t0 = __builtin_amdgcn_s_memrealtime(); const unsigned want = 8u * (unsigned)ntn;
            for (;;) {
#if defined(BROKEN_EXCHANGE_NO_WAIT)
                break;
#endif
                if ((unsigned)__builtin_amdgcn_readfirstlane(__hip_atomic_load(cnt + 64 * u.pm, __ATOMIC_RELAXED, __HIP_MEMORY_SCOPE_AGENT)) >= want) break;
                if (__builtin_amdgcn_s_memrealtime() - t0 > 2000000ull) {
                    if (lane == 0) { unsigned expect = 0u; __hip_atomic_compare_exchange_strong(tmo + 1, &expect, code | (unsigned)(u.pm & 0xff), __ATOMIC_RELAXED, __ATOMIC_RELAXED, __HIP_MEMORY_SCOPE_AGENT);
                                     __hip_atomic_store(tmo, 1u, __ATOMIC_RELAXED, __HIP_MEMORY_SCOPE_AGENT); }
                    dead = true; break; }
                __builtin_amdgcn_s_sleep(2);
            }
            __builtin_amdgcn_fence(__ATOMIC_ACQUIRE, "agent");
            if (lane == 0) flag[0] = dead ? 1u : 0u;
        }
        asm volatile("s_waitcnt vmcnt(0) lgkmcnt(0)" ::: "memory"); __builtin_amdgcn_s_barrier(); asm volatile("" ::: "memory");
        const bool bad = flag[0] != 0u;
        if (lane < 32) {
            const unsigned long long* slot = (const unsigned long long*)xbuf + (size_t)(u.pm * BM + row) * 4; float mt[4], m2[4]; float ms = 0.f;
#pragma unroll
            for (int t = 0; t < 4; ++t) { if (t < ntn) { const unsigned long long w = __hip_atomic_load(slot + t, __ATOMIC_RELAXED, __HIP_MEMORY_SCOPE_AGENT); mt[t] = __uint_as_float((unsigned)w); m2[t] = __uint_as_float((unsigned)(w >> 32)); } else { mt[t] = 0.f; m2[t] = 0.f; } ms += mt[t]; }
            const float mean = ms / (float)ntn; float q = 0.f;
#pragma unroll
            for (int t = 0; t < 4; ++t) if (t < ntn) { const float dm = mt[t] - mean; q += m2[t] + 256.0f * dm * dm; }
            S[row] = (f32x2v){mean, 1.0f / sqrtf(q / (256.0f * (float)ntn) + eps)};
        }
        asm volatile("s_waitcnt lgkmcnt(0)" ::: "memory"); __builtin_amdgcn_s_barrier(); asm volatile("" ::: "memory");
        return bad;
    }
};
struct EpiLnRes {
    static constexpr bool PERM = false, AFTER_DRAIN = true;
    const float* base; float* out; int ldc; const float* bias; PanelStats st; unsigned poison;
    __device__ __forceinline__ void fused(f32x4 (&acc)[2][2][4][2], const Unit& u, int wr, int wc, int fr, int fq, PG8_LAS unsigned char* lds, int wid, int lane) const {
        typedef float f32x2v __attribute__((ext_vector_type(2)));
        const PG8_LAS f32x2v* S = (const PG8_LAS f32x2v*)(lds + 8192);
        const int col0 = u.pn * BM + wc * 32 + 4 * fq;
#pragma unroll
        for (int bj = 0; bj < 2; ++bj)
#pragma unroll
            for (int n = 0; n < 2; ++n) { const f32x4 bv = bias ? *(const f32x4*)(bias + col0 + bj * HALF + n * 16) : (f32x4){0.f, 0.f, 0.f, 0.f};
#pragma unroll
                for (int ai = 0; ai < 2; ++ai)
#pragma unroll
                    for (int m = 0; m < 4; ++m) acc[ai][bj][m][n] += bv; }
        f32x4 pre[4][2][2];
#pragma unroll
        for (int m = 0; m < 4; ++m) { const size_t off = (size_t)(u.pm * BM + wr * 64 + m * 16 + fr) * ldc + col0;
#pragma unroll
            for (int bj = 0; bj < 2; ++bj)
#pragma unroll
                for (int n = 0; n < 2; ++n) pre[m][bj][n] = *(const f32x4*)(base + off + bj * HALF + n * 16); }
        const bool bad = st.run(acc, u, wr, wc, fr, fq, lds, wid, lane) || poison != 0u;
        const float qnan = __builtin_nanf("");
#pragma unroll
        for (int ai = 0; ai < 2; ++ai)
#pragma unroll
            for (int m = 0; m < 4; ++m) { const int r = ai * HALF + wr * 64 + m * 16 + fr; const f32x2v sr = S[r]; const size_t off = (size_t)(u.pm * BM + r) * ldc + col0;
#pragma unroll
                for (int bj = 0; bj < 2; ++bj)
#pragma unroll
                    for (int n = 0; n < 2; ++n) { const f32x4 bs = ai == 0 ? pre[m][bj][n] : *(const f32x4*)(base + off + bj * HALF + n * 16); f32x4 o = bs + (acc[ai][bj][m][n] - sr.x) * sr.y;
                        if (bad) o = (f32x4){qnan, qnan, qnan, qnan}; *(f32x4*)(out + off + bj * HALF + n * 16) = o; }
                if (m & 1) asm volatile("" ::: "memory"); }
    }
};
struct EpiLnResLn {
    static constexpr bool PERM = false, AFTER_DRAIN = true;
    const float* base; float* out; bf16_t* xn; int ldc; const float* bias; PanelStats st1, st2; unsigned poison;
    __device__ __forceinline__ void fused(f32x4 (&acc)[2][2][4][2], const Unit& u, int wr, int wc, int fr, int fq, PG8_LAS unsigned char* lds, int wid, int lane) const {
        typedef float f32x2v __attribute__((ext_vector_type(2))); typedef unsigned u32x2v __attribute__((ext_vector_type(2)));
        const PG8_LAS f32x2v* S = (const PG8_LAS f32x2v*)(lds + 8192);
        const int col0 = u.pn * BM + wc * 32 + 4 * fq;
#pragma unroll
        for (int bj = 0; bj < 2; ++bj)
#pragma unroll
            for (int n = 0; n < 2; ++n) { const f32x4 bv = bias ? *(const f32x4*)(bias + col0 + bj * HALF + n * 16) : (f32x4){0.f, 0.f, 0.f, 0.f};
#pragma unroll
                for (int ai = 0; ai < 2; ++ai)
#pragma unroll
                    for (int m = 0; m < 4; ++m) acc[ai][bj][m][n] += bv; }
        bool bad = st1.run(acc, u, wr, wc, fr, fq, lds, wid, lane) || poison != 0u;
        const float qnan = __builtin_nanf("");
#pragma unroll
        for (int ai = 0; ai < 2; ++ai)
#pragma unroll
            for (int m = 0; m < 4; ++m) { const int r = ai * HALF + wr * 64 + m * 16 + fr; const f32x2v sr = S[r]; const size_t off = (size_t)(u.pm * BM + r) * ldc + col0;
#pragma unroll
                for (int bj = 0; bj < 2; ++bj)
#pragma unroll
                    for (int n = 0; n < 2; ++n) { const f32x4 bs = *(const f32x4*)(base + off + bj * HALF + n * 16); acc[ai][bj][m][n] = bs + (acc[ai][bj][m][n] - sr.x) * sr.y; }
                asm volatile("" : "+v"(acc[ai][0][m][0]), "+v"(acc[ai][0][m][1]), "+v"(acc[ai][1][m][0]), "+v"(acc[ai][1][m][1]));
                if (m & 1) asm volatile("" ::: "memory"); }
        const bool bad1 = bad;
        bad = st2.run(acc, u, wr, wc, fr, fq, lds, wid, lane) || bad;
#pragma unroll
        for (int ai = 0; ai < 2; ++ai)
#pragma unroll
            for (int m = 0; m < 4; ++m) { const int r = ai * HALF + wr * 64 + m * 16 + fr; const f32x2v sr = S[r]; const size_t off = (size_t)(u.pm * BM + r) * ldc + col0;
#pragma unroll
                for (int bj = 0; bj < 2; ++bj)
#pragma unroll
                    for (int n = 0; n < 2; ++n) { const f32x4 x1 = acc[ai][bj][m][n]; *(f32x4*)(out + off + bj * HALF + n * 16) = bad1 ? (f32x4){qnan, qnan, qnan, qnan} : x1;
                        const f32x4 o = (x1 - sr.x) * sr.y; u32x2v w; w.x = cvt_pk_bf16(o[0], o[1]); w.y = cvt_pk_bf16(o[2], o[3]);
                        if (bad) { w.x = 0x7fc07fc0u; w.y = 0x7fc07fc0u; } *(u32x2v*)(xn + off + bj * HALF + n * 16) = w; }
                asm volatile("" ::: "memory"); }
    }
};

template <class Epi, class Sched, bool ALIGN_EPI = false, bool SP2 = false>
__device__ __forceinline__ void gemm_phase(PG8_LAS unsigned char* lds, const Gemm g, const Sched& S, const Epi& E) {
    const int tid = threadIdx.x, wid = __builtin_amdgcn_readfirstlane(tid >> 6), lane = tid & 63, wr = wid >> 2, wc = wid & 3, fr = lane & 15, fq = lane >> 4;
    const int K = g.K, nt = K / BK;
    unsigned voffA[2], voffB[2];
#pragma unroll
    for (int i = 0; i < 2; ++i) { int R, C; stage_rc(tid * 16 + i * 8192, R, C); const int Rb = Epi::PERM ? ((R & ~31) + perm32(R & 31)) : R;
        voffA[i] = (unsigned)(R * K + C) * 2u; voffB[i] = (unsigned)(Rb * K + C) * 2u; }
    const size_t kstep = (size_t)(BK * 2);
    const size_t hstep = (size_t)HALF * K * 2;
    const size_t tstep = 2 * hstep;
    const unsigned ldsw = (unsigned)wid * 1024u;
    const int aoff = lds_byte(wr * 64 + fr, fq * 8), boff = lds_byte(wc * 32 + fr, fq * 8);
#define PG8_SA(b, h) (((b) * 2 + (h)) * HTB)
#define PG8_SB(b, h) ((4 + (b) * 2 + (h)) * HTB)
#define PG8_STAGE(bufoff, gbase, voff) do { _Pragma("unroll") for (int _i = 0; _i < 2; ++_i) \
        __builtin_amdgcn_global_load_lds((const unsigned*)((const char*)(gbase) + (voff)[_i]), (PG8_LAS unsigned*)(lds + (bufoff) + ldsw + _i * 8192), 16, 0, 0); } while (0)
#define PG8_LDA(dst, b, h) do { _Pragma("unroll") for (int m = 0; m < 4; ++m) _Pragma("unroll") for (int k = 0; k < 2; ++k) dst[m][k] = *(const PG8_LAS bf16x8*)(lds + PG8_SA(b, h) + aoff + m * 2048 + k * 1024); } while (0)
#define PG8_LDB(dst, b, h) do { _Pragma("unroll") for (int n = 0; n < 2; ++n) _Pragma("unroll") for (int k = 0; k < 2; ++k) dst[n][k] = *(const PG8_LAS bf16x8*)(lds + PG8_SB(b, h) + boff + n * 2048 + k * 1024); } while (0)
#define PG8_MMA(ai, bj, At, Bt) do { __builtin_amdgcn_s_setprio(1); _Pragma("unroll") for (int m = 0; m < 4; ++m) _Pragma("unroll") for (int n = 0; n < 2; ++n) _Pragma("unroll") for (int k = 0; k < 2; ++k) \
        acc[ai][bj][m][n] = __builtin_amdgcn_mfma_f32_16x16x32_bf16(Bt[n][k], At[m][k], acc[ai][bj][m][n], 0, 0, 0); __builtin_amdgcn_s_setprio(0); } while (0)
#define PG8_WAIT_V(n) asm volatile("s_waitcnt vmcnt(" #n ")" ::: "memory")
#define PG8_WAIT_L(n) asm volatile("s_waitcnt lgkmcnt(" #n ")" ::: "memory")
#define PG8_BAR __builtin_amdgcn_s_barrier()
#define PG8_SCHED __builtin_amdgcn_sched_barrier(0)
    Unit cur, nxt; int ui = 0;
    if (!S.next(0, cur)) return;
    f32x4 acc[2][2][4][2];
#pragma unroll
    for (int a = 0; a < 2; ++a)
#pragma unroll
        for (int b = 0; b < 2; ++b)
#pragma unroll
            for (int m = 0; m < 4; ++m)
#pragma unroll
                for (int n = 0; n < 2; ++n) acc[a][b][m][n] = (f32x4){0.f, 0.f, 0.f, 0.f};
    bf16x8 At[4][2], B0[2][2], B1[2][2];
    const char* cA = (const char*)g.A + (size_t)cur.pm * tstep; const char* cB = (const char*)g.Bt + (size_t)cur.pn * tstep;
    S.a_ready(cur);
    if constexpr (SP2) {
        PG8_STAGE(PG8_SB(0, 0), cB, voffB); PG8_STAGE(PG8_SB(0, 1), cB + hstep, voffB); PG8_STAGE(PG8_SA(0, 0), cA, voffA); PG8_STAGE(PG8_SA(0, 1), cA + hstep, voffA);
        if (wr == 1) PG8_BAR;
        PG8_WAIT_V(2); PG8_BAR;
        PG8_STAGE(PG8_SB(1, 0), cB + kstep, voffB); PG8_STAGE(PG8_SA(1, 0), cA + kstep, voffA); PG8_STAGE(PG8_SB(1, 1), cB + hstep + kstep, voffB);
        PG8_WAIT_V(6); PG8_BAR;
    } else {
        PG8_STAGE(PG8_SB(0, 0), cB, voffB); PG8_STAGE(PG8_SA(0, 0), cA, voffA); PG8_STAGE(PG8_SB(0, 1), cB + hstep, voffB); PG8_STAGE(PG8_SA(0, 1), cA + hstep, voffA);
        if (wr == 1) PG8_BAR;
        PG8_WAIT_V(4); PG8_BAR;
        PG8_STAGE(PG8_SB(1, 0), cB + kstep, voffB); PG8_STAGE(PG8_SA(1, 0), cA + kstep, voffA); PG8_STAGE(PG8_SB(1, 1), cB + hstep + kstep, voffB);
        PG8_WAIT_V(6); PG8_BAR;
    }
    for (;;) {
        const bool has_next = S.next(ui + 1, nxt);
        const char* nA = has_next ? (const char*)g.A + (size_t)nxt.pm * tstep : cA; const char* nB = has_next ? (const char*)g.Bt + (size_t)nxt.pn * tstep : cB;
        for (int t = 0; t < nt; t += 2) {
            const bool last = (t == nt - 2);
            const char* a1 = cA + (size_t)(t + 1) * kstep;
            const char* a2 = last ? nA : cA + (size_t)(t + 2) * kstep; const char* b2 = last ? nB : cB + (size_t)(t + 2) * kstep;
            const char* a3 = a2 + kstep; const char* b3 = b2 + kstep;
            if (last && has_next) S.a_ready(nxt);
            if constexpr (SP2) {
            PG8_LDB(B0, 0, 0); PG8_LDB(B1, 0, 1); PG8_SCHED; PG8_LDA(At, 0, 0); PG8_STAGE(PG8_SA(1, 1), a1 + hstep, voffA);
            PG8_WAIT_V(8); PG8_WAIT_L(0); PG8_BAR; PG8_MMA(0, 0, At, B0); PG8_MMA(0, 1, At, B1); PG8_BAR; PG8_SCHED;
            PG8_LDA(At, 0, 1); PG8_STAGE(PG8_SB(0, 0), b2, voffB); PG8_STAGE(PG8_SB(0, 1), b2 + hstep, voffB); PG8_STAGE(PG8_SA(0, 0), a2, voffA);
            PG8_WAIT_V(8); PG8_WAIT_L(0); PG8_BAR; PG8_MMA(1, 0, At, B0); PG8_MMA(1, 1, At, B1); PG8_BAR; PG8_SCHED;
            PG8_LDB(B0, 1, 0); PG8_LDB(B1, 1, 1); PG8_SCHED; PG8_LDA(At, 1, 0); PG8_STAGE(PG8_SA(0, 1), a2 + hstep, voffA);
            PG8_WAIT_V(8); PG8_WAIT_L(0); PG8_BAR; PG8_MMA(0, 0, At, B0); PG8_MMA(0, 1, At, B1); PG8_BAR; PG8_SCHED;
            PG8_LDA(At, 1, 1); PG8_STAGE(PG8_SB(1, 0), b3, voffB); PG8_STAGE(PG8_SB(1, 1), b3 + hstep, voffB); PG8_STAGE(PG8_SA(1, 0), a3, voffA);
            PG8_WAIT_V(8); PG8_WAIT_L(0); PG8_BAR; PG8_MMA(1, 0, At, B0); PG8_MMA(1, 1, At, B1); PG8_BAR; PG8_SCHED;
            } else {
            PG8_LDB(B0, 0, 0); PG8_SCHED; PG8_LDA(At, 0, 0); PG8_STAGE(PG8_SA(1, 1), a1 + hstep, voffA);
            PG8_WAIT_L(8); PG8_BAR; PG8_WAIT_L(0); PG8_MMA(0, 0, At, B0); PG8_BAR; PG8_SCHED;
            PG8_LDB(B1, 0, 1); PG8_STAGE(PG8_SB(0, 0), b2, voffB);
            PG8_BAR; PG8_WAIT_L(0); PG8_MMA(0, 1, At, B1); PG8_BAR;
            PG8_LDA(At, 0, 1); PG8_STAGE(PG8_SA(0, 0), a2, voffA);
            PG8_BAR; PG8_WAIT_L(0); PG8_MMA(1, 0, At, B0); PG8_BAR; PG8_SCHED;
            PG8_STAGE(PG8_SB(0, 1), b2 + hstep, voffB);
            PG8_WAIT_V(6); PG8_BAR; PG8_MMA(1, 1, At, B1); PG8_BAR;
            PG8_LDB(B0, 1, 0); PG8_SCHED; PG8_LDA(At, 1, 0); PG8_STAGE(PG8_SA(0, 1), a2 + hstep, voffA);
            PG8_WAIT_L(8); PG8_BAR; PG8_WAIT_L(0); PG8_MMA(0, 0, At, B0); PG8_BAR; PG8_SCHED;
            PG8_LDB(B1, 1, 1); PG8_STAGE(PG8_SB(1, 0), b3, voffB);
            PG8_BAR; PG8_WAIT_L(0); PG8_MMA(0, 1, At, B1); PG8_BAR;
            PG8_LDA(At, 1, 1); PG8_STAGE(PG8_SA(1, 0), a3, voffA);
            PG8_BAR; PG8_WAIT_L(0); PG8_MMA(1, 0, At, B0); PG8_BAR; PG8_SCHED;
            PG8_STAGE(PG8_SB(1, 1), b3 + hstep, voffB);
            PG8_WAIT_V(6); PG8_BAR; PG8_MMA(1, 1, At, B1); PG8_BAR;
            }
        }
        if constexpr (ALIGN_EPI) { if (wr == 0) PG8_BAR; }
        if constexpr (!Epi::AFTER_DRAIN) { E(acc, cur, wr, wc, fr, fq); S.done(cur); }
        if (!has_next) break;
#pragma unroll
        for (int a = 0; a < 2; ++a)
#pragma unroll
            for (int b = 0; b < 2; ++b)
#pragma unroll
                for (int m = 0; m < 4; ++m)
#pragma unroll
                    for (int n = 0; n < 2; ++n) acc[a][b][m][n] = (f32x4){0.f, 0.f, 0.f, 0.f};
        cur = nxt; cA = nA; cB = nB; ++ui;
        if constexpr (ALIGN_EPI) { if (wr == 1) PG8_BAR; }
    }
    PG8_WAIT_V(0);
    if constexpr (!ALIGN_EPI) { if (wr == 0) PG8_BAR; }
    PG8_BAR;
    if constexpr (Epi::AFTER_DRAIN) { E.fused(acc, cur, wr, wc, fr, fq, lds, wid, lane); S.done(cur); }
#undef PG8_SA
#undef PG8_SB
#undef PG8_STAGE
#undef PG8_LDA
#undef PG8_LDB
#undef PG8_MMA
#undef PG8_WAIT_V
#undef PG8_WAIT_L
#undef PG8_BAR
#undef PG8_SCHED
}
}


#ifdef MK_WT_STORES
__device__ __forceinline__ void st16(void* p, pg8::u32x4 v) { asm volatile("global_store_dwordx4 %0, %1, off sc1\n\ts_nop 1" :: "v"(p), "v"(v) : "memory"); }
__device__ __forceinline__ void st8(void* p, unsigned long long v) { asm volatile("global_store_dwordx2 %0, %1, off sc1\n\ts_nop 1" :: "v"(p), "v"(v) : "memory"); }
#elif defined(MK_NT_STORES)
__device__ __forceinline__ void st16(void* p, pg8::u32x4 v) { __builtin_nontemporal_store(v, (pg8::u32x4*)p); }
__device__ __forceinline__ void st8(void* p, unsigned long long v) { __builtin_nontemporal_store(v, (unsigned long long*)p); }
#else
__device__ __forceinline__ void st16(void* p, pg8::u32x4 v) { *(pg8::u32x4*)p = v; }
__device__ __forceinline__ void st8(void* p, unsigned long long v) { *(unsigned long long*)p = v; }
#endif
namespace pg8 {
struct EpiStore {
    static constexpr bool PERM = true, AFTER_DRAIN = false;
    bf16_t* O; int ldc; int n_lo; float sc_lo; int pn_one; float sc_one;
    __device__ __forceinline__ void operator()(const f32x4 (&acc)[2][2][4][2], const Unit& u, int wr, int wc, int fr, int fq) const {
        const int row0 = u.pm * BM + wr * 64 + fr; const int col0 = u.pn * BM + wc * 32 + 8 * fq;
        const float sc = (u.pn < n_lo) ? sc_lo : ((u.pn == pn_one) ? sc_one : 1.0f);
#pragma unroll
        for (int ai = 0; ai < 2; ++ai)
#pragma unroll
            for (int m = 0; m < 4; ++m) { bf16_t* rowp = O + (size_t)(row0 + ai * HALF + m * 16) * ldc + col0;
#pragma unroll
                for (int bj = 0; bj < 2; ++bj) { f32x4 v0 = acc[ai][bj][m][0] * sc, v1 = acc[ai][bj][m][1] * sc;
                    u32x4 w; w.x = cvt_pk_bf16(v0[0], v0[1]); w.y = cvt_pk_bf16(v0[2], v0[3]); w.z = cvt_pk_bf16(v1[0], v1[1]); w.w = cvt_pk_bf16(v1[2], v1[3]);
                    st16(rowp + bj * HALF, w); } }
    }
};

struct EpiNull {
    static constexpr bool PERM = true, AFTER_DRAIN = false;
    __device__ __forceinline__ void operator()(const f32x4 (&acc)[2][2][4][2], const Unit& u, int wr, int wc, int fr, int fq) const {
#pragma unroll
        for (int ai = 0; ai < 2; ++ai)
#pragma unroll
            for (int bj = 0; bj < 2; ++bj)
#pragma unroll
                for (int m = 0; m < 4; ++m) { asm volatile("" :: "v"(acc[ai][bj][m][0]), "v"(acc[ai][bj][m][1])); }
    }
};
struct EpiProj {
    static constexpr bool PERM = true, AFTER_DRAIN = false;
    bf16_t* P; float qscale;
    __device__ __forceinline__ void operator()(const f32x4 (&acc)[2][2][4][2], const Unit& u, int wr, int wc, int fr, int fq) const {
        const int b = u.pm >> 5, tb = u.pm & 31, pn = u.pn;
        constexpr size_t Mi = 1u << 20;
#pragma unroll
        for (int bj = 0; bj < 2; ++bj) {
            size_t base; int rstride;  float sc = 1.0f; bool posmap = false;
            if (pn < 6) { const int head = (pn & 1) * 4 + 2 * bj + (wc >> 1); base = (size_t)(pn >> 1) * 16 * Mi + (size_t)(b * 8 + head) * 8192 * 64 + (wc & 1) * 32 + 8 * fq; rstride = 64; posmap = true; if (pn < 2) sc = qscale; }
            else if (pn < 8) { const int head = 2 * bj + (wc >> 1); base = 48 * Mi + (size_t)(pn - 6) * 8 * Mi + (size_t)(b * 4 + head) * 8192 * 64 + (wc & 1) * 32 + 8 * fq; rstride = 64; if (pn == 7) sc = 0.125f; }
            else { const int head = ((pn - 8) & 1) * 2 + bj; base = 64 * Mi + (size_t)((pn - 8) >> 1) * 16 * Mi + (size_t)(b * 4 + head) * 8192 * 128 + 32 * wc + 8 * fq; rstride = 128; }
#pragma unroll
            for (int ai = 0; ai < 2; ++ai)
#pragma unroll
                for (int m = 0; m < 4; ++m) {
                    const int ridx = posmap ? (fr * 512 + tb * 16 + 8 * ai + 4 * wr + m) : (tb * 256 + 128 * ai + 64 * wr + 16 * m + fr);
                    const f32x4 v0 = acc[ai][bj][m][0] * sc, v1 = acc[ai][bj][m][1] * sc;
                    u32x4 w; w.x = cvt_pk_bf16(v0[0], v0[1]); w.y = cvt_pk_bf16(v0[2], v0[3]); w.z = cvt_pk_bf16(v1[0], v1[1]); w.w = cvt_pk_bf16(v1[2], v1[3]);
                    st16(P + base + (size_t)ridx * rstride, w); }
        }
    }
};

__device__ __forceinline__ float dpp_ror1(float v) { return __builtin_bit_cast(float, __builtin_amdgcn_update_dpp(0, __builtin_bit_cast(int, v), 0x121, 0xf, 0xf, false)); }
__device__ __forceinline__ float dpp_ror2(float v) { return __builtin_bit_cast(float, __builtin_amdgcn_update_dpp(0, __builtin_bit_cast(int, v), 0x122, 0xf, 0xf, false)); }
__device__ __forceinline__ float gelu_tanh_f(float x) {
    const float A = -2.302208198f, Bc = -0.1029432397f;
    const float t = x * (A + Bc * x * x);
    return x * __builtin_amdgcn_rcpf(1.0f + __builtin_amdgcn_exp2f(t));
}
struct EpiConvAct {
    static constexpr bool PERM = true, AFTER_DRAIN = false;
    bf16_t* act; bf16_t* ub; const float* cw; const float* cb;
    __device__ __forceinline__ void operator()(const f32x4 (&acc)[2][2][4][2], const Unit& u, int wr, int wc, int fr, int fq) const {
        constexpr int FFc = 2816, FF2c = 5632;
#pragma unroll
        for (int n = 0; n < 2; ++n) {
            const int j = u.pn * 128 + wc * 32 + 8 * fq + 4 * n;
            const f32x4 w0g = *(const f32x4*)(cw + j), w1g = *(const f32x4*)(cw + FF2c + j), w2g = *(const f32x4*)(cw + 2 * FF2c + j), bg = *(const f32x4*)(cb + j);
            const f32x4 w0u = *(const f32x4*)(cw + FFc + j), w1u = *(const f32x4*)(cw + FF2c + FFc + j), w2u = *(const f32x4*)(cw + 2 * FF2c + FFc + j), bu = *(const f32x4*)(cb + FFc + j);
#pragma unroll
            for (int ai = 0; ai < 2; ++ai) {
                const int g = u.pm * 4 + ai * 2 + wr;
                f32x4 qg1 = {0.f, 0.f, 0.f, 0.f}, qg2 = qg1, qu1 = qg1, qu2 = qg1;
#pragma unroll
                for (int m = 0; m < 4; ++m) {
                    const f32x4 ug = acc[ai][0][m][n], uu = acc[ai][1][m][n];
                    f32x4 ag1, ag2, au1, au2;
#pragma unroll
                    for (int k = 0; k < 4; ++k) { ag1[k] = dpp_ror1(ug[k]); ag2[k] = dpp_ror2(ug[k]); au1[k] = dpp_ror1(uu[k]); au2[k] = dpp_ror2(uu[k]); }
                    f32x4 pg1, pg2, pu1, pu2;
#pragma unroll
                    for (int k = 0; k < 4; ++k) { pg1[k] = (fr >= 1) ? ag1[k] : qg1[k]; pg2[k] = (fr >= 2) ? ag2[k] : qg2[k]; pu1[k] = (fr >= 1) ? au1[k] : qu1[k]; pu2[k] = (fr >= 2) ? au2[k] : qu2[k]; }
                    qg1 = ag1; qg2 = ag2; qu1 = au1; qu2 = au2;
                    const f32x4 yg = bg + w2g * ug + w1g * pg1 + w0g * pg2;
                    const f32x4 yu = bu + w2u * uu + w1u * pu1 + w0u * pu2;
                    float a0 = gelu_tanh_f(yg[0]) * yu[0], a1 = gelu_tanh_f(yg[1]) * yu[1], a2 = gelu_tanh_f(yg[2]) * yu[2], a3 = gelu_tanh_f(yg[3]) * yu[3];
                    const int row = u.pm * BM + ai * HALF + wr * 64 + m * 16 + fr;
                    typedef unsigned u32x2 __attribute__((ext_vector_type(2)));
                    u32x2 w; w.x = cvt_pk_bf16(a0, a1); w.y = cvt_pk_bf16(a2, a3);
                    if (!(m == 0 && fr < 2)) st8(act + (size_t)row * FFc + j, (unsigned long long)w.x | ((unsigned long long)w.y << 32));
                    if ((m == 0 && fr < 2) || (m == 3 && fr >= 14)) { const int slot = (m == 0) ? (2 + fr) : (fr - 14); bf16_t* p = ub + ((size_t)(g * 4 + slot) * 2) * FFc + j;
                        u32x2 wg, wu; wg.x = cvt_pk_bf16(ug[0], ug[1]); wg.y = cvt_pk_bf16(ug[2], ug[3]); wu.x = cvt_pk_bf16(uu[0], uu[1]); wu.y = cvt_pk_bf16(uu[2], uu[3]);
                        *(u32x2*)p = wg; *(u32x2*)(p + FFc) = wu; }
                }
            }
        }
    }
};
}
#define GAS __attribute__((address_space(1)))
#define LAS __attribute__((address_space(3)))
typedef unsigned short bf16;
typedef unsigned v4u __attribute__((ext_vector_type(4)));
typedef float f32x4 __attribute__((ext_vector_type(4)));
typedef short bf16x8 __attribute__((ext_vector_type(8)));
typedef GAS unsigned gu32;
typedef GAS unsigned long long gu64;
#define RLX_AGENT __ATOMIC_RELAXED, __HIP_MEMORY_SCOPE_AGENT
#define LDS_WAIT() asm volatile("s_waitcnt lgkmcnt(0)" ::: "memory")
#define VM_WAIT() asm volatile("s_waitcnt vmcnt(0)" ::: "memory")
__device__ __forceinline__ unsigned long long rt() { return __builtin_amdgcn_s_memrealtime(); }
__device__ __forceinline__ unsigned f2bf(float f) { unsigned u = __builtin_bit_cast(unsigned, f); return (u + 0x7fffu + ((u >> 16) & 1u)) >> 16; }
__device__ __forceinline__ unsigned pk2(float lo, float hi) { return f2bf(lo) | (f2bf(hi) << 16); }

#define XB_TMO      128
#define XB_XCNT(j)  (256  + 64 * (j))
#define XB_XSUB(j)  (1280 + 64 * (j))
#define XB_XGEN(j)  (2304 + 64 * (j))
#define XB_TOP      3328
#define XB_TOPGEN   3392
#define XCD_BAR_WORDS 3456
#define XB_SPIN_CAP (1u << 18)

__device__ __forceinline__ unsigned xb_ld(unsigned* p)              { return __hip_atomic_load(p, __ATOMIC_RELAXED, __HIP_MEMORY_SCOPE_AGENT); }
__device__ __forceinline__ unsigned xb_add(unsigned* p, unsigned v) { return __hip_atomic_fetch_add(p, v, __ATOMIC_RELAXED, __HIP_MEMORY_SCOPE_AGENT); }
__device__ __forceinline__ unsigned xb_xcc_id() { return (unsigned)__builtin_amdgcn_s_getreg((3 << 11) | 20) & 0xFu; }
#define XB_SPIN(cond, bar) do { unsigned _sp = 0; while (cond) { __builtin_amdgcn_s_sleep(1); \
    if ((++_sp & 255u) == 0u) { if (xb_ld(&(bar)[XB_TMO])) break; if (_sp > XB_SPIN_CAP) { atomicAdd(&(bar)[XB_TMO], 1u); break; } } } } while (0)

struct XcdBarrier {
    unsigned* bar; unsigned x;
    volatile LAS unsigned* st;
};

__device__ __forceinline__ XcdBarrier xcd_barrier_post(unsigned* bar, volatile LAS unsigned* st) {
    XcdBarrier b; b.bar = bar; b.x = xb_xcc_id(); b.st = st;
    if (threadIdx.x == 0) (void)xb_add(&bar[XB_XCNT(b.x)], 1u);
    return b;
}
__device__ __forceinline__ void xcd_barrier_complete(unsigned* bar, unsigned x, unsigned& nloc, unsigned& nx) {
    const unsigned G = gridDim.x * gridDim.y * gridDim.z;
    unsigned sum, cnt, mine, sp = 0u;
    for (;;) {
        sum = 0u; cnt = 0u; mine = 0u;
#pragma unroll
        for (unsigned j = 0; j < 16; ++j) { const unsigned c = xb_ld(&bar[XB_XCNT(j)]); sum += c; cnt += (c > 0u) ? 1u : 0u; mine = (j == x) ? c : mine; }
        if (sum == G) break;
        __builtin_amdgcn_s_sleep(1);
        if ((++sp & 255u) == 0u) { if (xb_ld(&bar[XB_TMO])) break; if (sp > XB_SPIN_CAP) { atomicAdd(&bar[XB_TMO], 1u); break; } }
    }
    nloc = mine > 0u ? mine : 1u; nx = cnt > 0u ? cnt : 1u;
}

__device__ __forceinline__ void xcd_barrier(const XcdBarrier& b) {
    asm volatile("s_waitcnt vmcnt(0)" ::: "memory");
    __syncthreads();
    if (threadIdx.x == 0) {
        unsigned* bar = b.bar;
        __builtin_amdgcn_s_waitcnt(0);
        unsigned nloc = b.st[0], nx = b.st[1];
        if (nloc == 0u) { xcd_barrier_complete(bar, b.x, nloc, nx); b.st[0] = nloc; b.st[1] = nx; }
        const unsigned old = xb_add(&bar[XB_XSUB(b.x)], 1u);
        const unsigned gen = old / nloc;
        if (old + 1u == (gen + 1u) * nloc) {
            __builtin_amdgcn_fence(__ATOMIC_RELEASE, "agent");
            asm volatile("s_waitcnt vmcnt(0)" ::: "memory");
            const unsigned og = xb_add(&bar[XB_TOP], 1u);
            const unsigned tg = og / nx;
            if (og + 1u == (tg + 1u) * nx) xb_add(&bar[XB_TOPGEN], 1u);
            else XB_SPIN(xb_ld(&bar[XB_TOPGEN]) == tg, bar);
            __builtin_amdgcn_fence(__ATOMIC_ACQUIRE, "agent");
            xb_add(&bar[XB_XGEN(b.x)], 1u);
            asm volatile("s_waitcnt vmcnt(0)" ::: "memory");
        } else {
            XB_SPIN(xb_ld(&bar[XB_XGEN(b.x)]) == gen, bar);
            __builtin_amdgcn_fence(__ATOMIC_ACQUIRE, "agent");
            asm volatile("s_waitcnt vmcnt(0)" ::: "memory");
        }
    }
    __syncthreads();
}

constexpr int NWAVES = 8, NTHR = 512;
#ifndef MK_N_LAUNCHES
#define MK_N_LAUNCHES 1
#endif
constexpr int N_PHASES = 11;
#ifndef MK_ALIGN
#define MK_ALIGN true
#endif
#ifndef MK_SP2
#define MK_SP2 true
#endif
constexpr int BATCH = 4, SEQ = 8192, DM = 1024, M = BATCH * SEQ, INW = 3072, FF = 2816, FF2 = 5632;
constexpr float NORM_EPS = 1e-6f;
constexpr float QSCALE = 0.125f * 1.4426950408889634f;
constexpr size_t MiB = 1u << 20;
constexpr size_t WS_CTL = 0, CTL_ZERO_BYTES = 65536;
constexpr size_t WS_ROPE = 1 * MiB;
constexpr size_t WS_WIN = 4 * MiB, WS_WOUT = 10 * MiB, WS_WUP = 12 * MiB, WS_WDN = 23 * MiB;
constexpr size_t WS_XN = 32 * MiB;
constexpr size_t WS_PROJ = 96 * MiB;
constexpr size_t WS_ACT = 96 * MiB;
constexpr size_t WS_OPART = 288 * MiB;
constexpr size_t WS_LSE = 384 * MiB;
constexpr size_t WS_MIX = 288 * MiB;
constexpr size_t WS_FFN = 352 * MiB;
constexpr size_t WS_MIXED = 416 * MiB;
constexpr size_t WS_UB = 416 * MiB;
constexpr size_t WS_KV = 480 * MiB;
constexpr size_t WS_END = 512 * MiB;
constexpr int CW_TMO = 0, CW_BAR = 4096;
constexpr int RING_OFF = 0, RING_BYTES = 133120;
constexpr int LDSCTL_OFF = RING_BYTES, MISC_OFF = LDSCTL_OFF + 320;
constexpr int LDS_BYTES = 147456;
static_assert(MISC_OFF + 128 <= LDS_BYTES, "LDS map");

__device__ const float ROPE_F[32] = {1.000000000e+00f, 7.498942018e-01f, 5.623413324e-01f, 4.216965139e-01f, 3.162277639e-01f, 2.371373773e-01f, 1.778279394e-01f, 1.333521456e-01f, 1.000000015e-01f, 7.498942316e-02f, 5.623413250e-02f, 4.216964915e-02f, 3.162277490e-02f, 2.371373773e-02f, 1.778279431e-02f, 1.333521400e-02f, 9.999999776e-03f, 7.498942316e-03f, 5.623413250e-03f, 4.216964822e-03f, 3.162277630e-03f, 2.371373819e-03f, 1.778279431e-03f, 1.333521446e-03f, 1.000000047e-03f, 7.498941850e-04f, 5.623413017e-04f, 4.216965172e-04f, 3.162277571e-04f, 2.371373703e-04f, 1.778279402e-04f, 1.333521504e-04f};

typedef float f32x16 __attribute__((ext_vector_type(16)));
typedef short s16x4 __attribute__((ext_vector_type(4)));
typedef unsigned u32x2 __attribute__((ext_vector_type(2)));
typedef float f32x2v __attribute__((ext_vector_type(2)));
typedef __bf16 bf16x2_t __attribute__((ext_vector_type(2)));
__device__ __forceinline__ unsigned cvtpk(float lo, float hi) { f32x2v v = {lo, hi}; bf16x2_t b = __builtin_convertvector(v, bf16x2_t); return __builtin_bit_cast(unsigned, b); }
__device__ __forceinline__ float bf_lo(unsigned w) { return __builtin_bit_cast(float, w << 16); }
__device__ __forceinline__ float bf_hi(unsigned w) { return __builtin_bit_cast(float, w & 0xffff0000u); }
__device__ __forceinline__ int crow(int r, int hi) { return (r & 3) + 8 * (r >> 2) + 4 * hi; }
__device__ __forceinline__ s16x4 tr16(const LAS unsigned char* p) { typedef short v4i16_t __attribute__((ext_vector_type(4))); return __builtin_bit_cast(s16x4, __builtin_amdgcn_ds_read_tr16_b64_v4i16((LAS v4i16_t*)p)); }
__device__ __forceinline__ bf16x8 mk8(s16x4 a, s16x4 b) { return (bf16x8){a[0], a[1], a[2], a[3], b[0], b[1], b[2], b[3]}; }
__device__ __forceinline__ float wave_sum(float v) {
#pragma unroll
    for (int o = 1; o < 64; o <<= 1) v += __shfl_xor(v, o);
    return v;
}
__device__ __forceinline__ float lg2gamma(int h) { return log2f(1.0f - exp2f(-5.0f - (float)h)); }

struct Frame {
    LAS unsigned char* lds;
    volatile LAS unsigned* MISC;
    gu32* ctl;
    int tid, lane, wave, vcu, G;
    const float *x, *g_pre, *g_post, *w_in, *w_out, *g_fpre, *g_fpost, *w_up, *conv_w, *conv_b, *w_down;
    float* out;
    bf16 *Win_t, *Wout_t, *Wup_t, *Wdn_t, *XN, *PROJ, *ACT, *OPART, *MIX, *FFN, *MIXED;
    float *LSE; bf16 *UB, *KV; f32x2v* ROPE;
};

__device__ __forceinline__ void p0_transpose_item(const float* W, int K, int N, bf16* WT, int row_off, LAS float* scr, int kb, int nb, int lane) {
    const int k0 = 64 * kb, n0 = 32 * nb;
#pragma unroll 8
    for (int i = 0; i < 32; ++i) { const int kk = 2 * i + (lane >> 5); scr[kk * 33 + (lane & 31)] = W[(size_t)(k0 + kk) * N + n0 + (lane & 31)]; }
    LDS_WAIT(); asm volatile("" ::: "memory");
    const int c = lane & 7;
#pragma unroll
    for (int j = 0; j < 4; ++j) { const int n = (lane >> 3) + 8 * j; const LAS float* s = scr + (8 * c) * 33 + n;
        v4u o; o.x = cvtpk(s[0 * 33], s[1 * 33]); o.y = cvtpk(s[2 * 33], s[3 * 33]); o.z = cvtpk(s[4 * 33], s[5 * 33]); o.w = cvtpk(s[6 * 33], s[7 * 33]);
        *(GAS v4u*)(WT + (size_t)(row_off + n0 + n) * K + k0 + 8 * c) = o; }
    LDS_WAIT(); asm volatile("" ::: "memory");
}
__device__ __forceinline__ void rms_row_to_bf16(const float* xrow, const float* gain, bf16* orow, int lane) {
    const GAS f32x4* xr = (const GAS f32x4*)xrow + lane; const GAS f32x4* gr = (const GAS f32x4*)gain + lane;
    f32x4 v[4]; float s = 0.f;
#pragma unroll
    for (int j = 0; j < 4; ++j) { v[j] = xr[64 * j]; s += (v[j].x * v[j].x + v[j].y * v[j].y) + (v[j].z * v[j].z + v[j].w * v[j].w); }
    const float rstd = 1.f / sqrtf(wave_sum(s) * (1.f / DM) + NORM_EPS);
    GAS unsigned long long* o8 = (GAS unsigned long long*)orow + lane;
#pragma unroll
    for (int j = 0; j < 4; ++j) { const f32x4 g = gr[64 * j];
        o8[64 * j] = (unsigned long long)cvtpk(v[j].x * rstd * g.x, v[j].y * rstd * g.y) | ((unsigned long long)cvtpk(v[j].z * rstd * g.z, v[j].w * rstd * g.w) << 32); }
}
__device__ __forceinline__ void rms_rows4_to_bf16(const float* xrow, const float* gain, bf16* orow, int lane) {
    const GAS f32x4* gr = (const GAS f32x4*)gain + lane;
    f32x4 v[4][4]; float s[4];
#pragma unroll
    for (int r = 0; r < 4; ++r) { const GAS f32x4* xr = (const GAS f32x4*)(xrow + (size_t)r * DM) + lane;
#pragma unroll
        for (int j = 0; j < 4; ++j) v[r][j] = xr[64 * j]; }
#pragma unroll
    for (int r = 0; r < 4; ++r) { s[r] = 0.f;
#pragma unroll
        for (int j = 0; j < 4; ++j) s[r] += (v[r][j].x * v[r][j].x + v[r][j].y * v[r][j].y) + (v[r][j].z * v[r][j].z + v[r][j].w * v[r][j].w); }
#pragma unroll
    for (int o = 1; o < 64; o <<= 1) {
#pragma unroll
        for (int r = 0; r < 4; ++r) s[r] += __shfl_xor(s[r], o); }
#pragma unroll
    for (int r = 0; r < 4; ++r) { const float rstd = 1.f / sqrtf(s[r] * (1.f / DM) + NORM_EPS); GAS unsigned long long* o8 = (GAS unsigned long long*)(orow + (size_t)r * DM) + lane;
#pragma unroll
        for (int j = 0; j < 4; ++j) { const f32x4 g = gr[64 * j];
            o8[64 * j] = (unsigned long long)cvtpk(v[r][j].x * rstd * g.x, v[r][j].y * rstd * g.y) | ((unsigned long long)cvtpk(v[r][j].z * rstd * g.z, v[r][j].w * rstd * g.w) << 32); } }
}
__device__ __forceinline__ void p0_prep(Frame& F) {
    LAS float* scr = (LAS float*)(F.lds + RING_OFF + F.wave * 16384);
    const int gw = F.vcu * NWAVES + F.wave, NGW = F.G * NWAVES;
    constexpr int I_IN = (DM / 64) * (INW / 32), I_OUT = (DM / 64) * (DM / 32), I_UP = (DM / 64) * (FF2 / 32), I_DN = (FF / 64) * (DM / 32);
    constexpr int NITEMS = I_IN + I_OUT + I_UP + I_DN;
    for (int it = gw; it < NITEMS; it += NGW) {
        int r = it;
        if (r < I_IN) { const int nblk = INW / 32; p0_transpose_item(F.w_in, DM, INW, F.Win_t, 0, scr, r / nblk, r % nblk, F.lane); continue; } r -= I_IN;
        if (r < I_OUT) { const int nblk = DM / 32; p0_transpose_item(F.w_out, DM, DM, F.Wout_t, 0, scr, r / nblk, r % nblk, F.lane); continue; } r -= I_OUT;
        if (r < I_UP) { const int nblk = FF2 / 32; const int kb = r / nblk, nb = r % nblk; const int n0 = 32 * nb;
            const int dest = (n0 < FF) ? ((n0 / 128) * 256 + (n0 % 128)) : (((n0 - FF) / 128) * 256 + 128 + ((n0 - FF) % 128));
            p0_transpose_item(F.w_up, DM, FF2, F.Wup_t, dest - n0, scr, kb, nb, F.lane); continue; } r -= I_UP;
        { const int nblk = DM / 32; p0_transpose_item(F.w_down, FF, DM, F.Wdn_t, 0, scr, r / nblk, r % nblk, F.lane); }
    }
    for (int m = gw * 4; m < M; m += NGW * 4) rms_rows4_to_bf16(F.x + (size_t)m * DM, F.g_pre, F.XN + (size_t)m * DM, F.lane);
    for (int idx = F.vcu * NTHR + F.tid; idx < SEQ * 32; idx += F.G * NTHR) { const int t = idx >> 5, i = idx & 31; const float ang = (float)t * ROPE_F[i]; F.ROPE[idx] = (f32x2v){cosf(ang), sinf(ang)}; }
}

namespace att {
constexpr int NKEY = 384, K_OFF = 0, K_BYTES = NKEY * 128, V_OFF = K_BYTES, VHALF = NKEY * 64, V_BYTES = 2 * VHALF, SCR_OFF = V_OFF + V_BYTES, OST_OFF = SCR_OFF + 8 * 256, END = OST_OFF + 8 * 4096;
static_assert(END <= RING_BYTES, "attention LDS");
}
struct AttnPre { v4u k[6], v[6]; bf16x8 q[4]; };
template <bool FUSED> __device__ __forceinline__ void attn_load(Frame& F, int u, AttnPre& P) {
    const int tid = F.tid, lane = F.lane, w = F.wave, r32 = lane & 31, hi = lane >> 5;
    const int bh = FUSED ? (u >> 5) : (u >> 6), p = FUSED ? 2 : ((u >> 5) & 1), xx = u & 31;
    const int dsh = (p == 0) ? 4 : ((p == 1) ? 2 : 0);
    const int nsb = 32 >> dsh, r = xx / nsb, sb = xx % nsb;
    const bf16* Qh = F.PROJ + (size_t)bh * SEQ * 64;
    const int nst = 16 >> dsh, per = 384 / nst;
#pragma unroll
    for (int it = 0; it < 6; ++it) { const int idx = tid + NTHR * it, q = idx >> 3, c = idx & 7, kk = (q % per) * nst + q / per; int sp = 256 * sb - 128 + kk; sp = sp < 0 ? 0 : sp;
        const int t = (sp << dsh) + r; const bf16* src = Qh + (size_t)((t & 15) * 512 + (t >> 4)) * 64 + c * 8;
        P.k[it] = *(const GAS v4u*)(src + ((size_t)16 << 20)); P.v[it] = *(const GAS v4u*)(src + ((size_t)32 << 20)); }
    const int qt_ = ((256 * sb + 32 * w + r32) << dsh) + r;
#pragma unroll
    for (int d0 = 0; d0 < 4; ++d0) P.q[d0] = *(const GAS bf16x8*)(Qh + (size_t)((qt_ & 15) * 512 + (qt_ >> 4)) * 64 + d0 * 16 + hi * 8);
}
template <bool FUSED> __device__ __forceinline__ void attn_units(Frame& F, int u0, int u1) {
    using namespace att;
    if (u0 >= u1) return;
    const int tid = F.tid, lane = F.lane, w = F.wave, r32 = lane & 31, hi = lane >> 5;
    LAS unsigned char* lds = F.lds + RING_OFF;
    AttnPre P;
#ifndef MK_ATT_NOPREF
    attn_load<FUSED>(F, u0, P);
#endif
    for (int u = u0; u < u1; ++u) {
#ifdef MK_ATT_NOPREF
    attn_load<FUSED>(F, u, P);
#endif
    const int bh = FUSED ? (u >> 5) : (u >> 6), p = FUSED ? 2 : ((u >> 5) & 1), xx = u & 31;
    const int dsh = (p == 0) ? 4 : ((p == 1) ? 2 : 0);
    const int nsb = 32 >> dsh, r = xx / nsb, sb = xx % nsb;
    __syncthreads();
    const int nst = 16 >> dsh, per = 384 / nst;
#pragma unroll
    for (int it = 0; it < 6; ++it) { const int idx = tid + NTHR * it, q = idx >> 3, c = idx & 7, kk = (q % per) * nst + q / per;
        *(LAS v4u*)(lds + K_OFF + kk * 128 + ((c ^ ((kk >> 1) & 7)) << 4)) = P.k[it];
        *(LAS v4u*)(lds + V_OFF + (c >> 2) * VHALF + kk * 64 + (c & 3) * 16) = P.v[it]; }
    bf16x8 qr[4];
#pragma unroll
    for (int d0 = 0; d0 < 4; ++d0) qr[d0] = P.q[d0];
    const int qtk = ((256 * sb + 32 * w + r32) << dsh) + r;
    __syncthreads();
#ifndef MK_ATT_NOPREF
    if (u + 1 < u1) attn_load<FUSED>(F, u + 1, P);
#endif
    f32x16 pt[5];
#pragma unroll
    for (int j = 0; j < 5; ++j) {
        pt[j] = (f32x16){0.f, 0.f, 0.f, 0.f, 0.f, 0.f, 0.f, 0.f, 0.f, 0.f, 0.f, 0.f, 0.f, 0.f, 0.f, 0.f};
        const int row = 32 * (w + j) + r32;
#pragma unroll
        for (int d0 = 0; d0 < 4; ++d0) { const bf16x8 kf = *(const LAS bf16x8*)(lds + K_OFF + row * 128 + (((2 * d0 + hi) ^ ((row >> 1) & 7)) << 4));
            pt[j] = __builtin_amdgcn_mfma_f32_32x32x16_bf16(kf, qr[d0], pt[j], 0, 0, 0); }
    }
    const float NEG = -1e30f;
#pragma unroll
    for (int rr = 0; rr < 16; ++rr) { const int kr = crow(rr, hi); if (kr < r32) pt[0][rr] = NEG; if (kr > r32) pt[4][rr] = NEG; }
    if (sb == 0) {
#pragma unroll
        for (int j = 0; j < 4; ++j) if (w + j < 4) {
#pragma unroll
            for (int rr = 0; rr < 16; ++rr) pt[j][rr] = NEG; }
    }
    float mx = NEG;
#pragma unroll
    for (int j = 0; j < 5; ++j)
#pragma unroll
        for (int rr = 0; rr < 16; ++rr) mx = fmaxf(mx, pt[j][rr]);
    mx = fmaxf(mx, __shfl_xor(mx, 32));
    float ls = 0.f;
#pragma unroll
    for (int j = 0; j < 5; ++j)
#pragma unroll
        for (int rr = 0; rr < 16; ++rr) { const float e = __builtin_amdgcn_exp2f(pt[j][rr] - mx); pt[j][rr] = e; ls += e; }
    ls += __shfl_xor(ls, 32);
    v4u pw[5][2];
#pragma unroll
    for (int j = 0; j < 5; ++j)
#pragma unroll
        for (int s = 0; s < 2; ++s) { pw[j][s].x = cvtpk(pt[j][8 * s + 0], pt[j][8 * s + 1]); pw[j][s].y = cvtpk(pt[j][8 * s + 2], pt[j][8 * s + 3]); pw[j][s].z = cvtpk(pt[j][8 * s + 4], pt[j][8 * s + 5]); pw[j][s].w = cvtpk(pt[j][8 * s + 6], pt[j][8 * s + 7]); }
    __builtin_amdgcn_sched_barrier(0);
    v4u pa_[4], pb_[4]; float l0_[4], l1_[4];
    if (FUSED) {
#pragma unroll
        for (int i = 0; i < 4; ++i) { const int tok = 256 * sb + 32 * w + i * 8 + (lane >> 3); const size_t li = (size_t)bh * SEQ + (tok & 15) * 512 + (tok >> 4);
            l0_[i] = F.LSE[li]; l1_[i] = F.LSE[(size_t)32 * SEQ + li];
            pa_[i] = *(const GAS v4u*)(F.OPART + li * 64 + (lane & 7) * 8); pb_[i] = *(const GAS v4u*)(F.OPART + ((size_t)16 << 20) + li * 64 + (lane & 7) * 8); }
    }
    f32x16 o[2];
    o[0] = (f32x16){0.f, 0.f, 0.f, 0.f, 0.f, 0.f, 0.f, 0.f, 0.f, 0.f, 0.f, 0.f, 0.f, 0.f, 0.f, 0.f}; o[1] = o[0];
    const LAS unsigned char* vb = lds + V_OFF + ((lane >> 4) & 1) * 32 + (lane & 3) * 8 + (4 * hi + ((lane & 15) >> 2)) * 64;
#pragma unroll
    for (int j = 0; j < 5; ++j)
#pragma unroll
        for (int s = 0; s < 2; ++s) {
            const bf16x8 pa = __builtin_bit_cast(bf16x8, pw[j][s]);
            const int k0 = 32 * (w + j) + 16 * s;
#pragma unroll
            for (int d0 = 0; d0 < 2; ++d0) { const LAS unsigned char* vp = vb + d0 * VHALF + k0 * 64;
                const bf16x8 vf = mk8(tr16(vp), tr16(vp + 512));
                o[d0] = __builtin_amdgcn_mfma_f32_32x32x16_bf16(pa, vf, o[d0], 0, 0, 0); }
        }
#ifdef MK_ATT_DUP
    {
        f32x16 dm = o[0];
#pragma unroll
        for (int j = 0; j < 5; ++j) { const int row = 32 * (w + j) + r32;
#pragma unroll
            for (int d0 = 0; d0 < 4; ++d0) { const bf16x8 kf = *(const LAS bf16x8*)(lds + K_OFF + row * 128 + (((2 * d0 + hi) ^ ((row >> 1) & 7)) << 4)); asm volatile("" : "+v"(dm));
                dm = __builtin_amdgcn_mfma_f32_32x32x16_bf16(kf, qr[d0], dm, 0, 0, 0); } }
#pragma unroll
        for (int j = 0; j < 5; ++j)
#pragma unroll
            for (int s = 0; s < 2; ++s) { const int k0 = 32 * (w + j) + 16 * s;
#pragma unroll
                for (int d0 = 0; d0 < 2; ++d0) { const LAS unsigned char* vp = vb + d0 * VHALF + k0 * 64; const bf16x8 vf = mk8(tr16(vp), tr16(vp + 512)); asm volatile("" : "+v"(dm));
                    dm = __builtin_amdgcn_mfma_f32_32x32x16_bf16(qr[d0], vf, dm, 0, 0, 0); } }
        asm volatile("" :: "v"(dm));
    }
#endif
    volatile LAS float* scr = (volatile LAS float*)(lds + SCR_OFF) + w * 64;
    if (hi == 0) { scr[r32] = ls; if (FUSED) scr[32 + r32] = mx + log2f(ls); }
    LDS_WAIT();
    LAS bf16* stg = (LAS bf16*)(lds + OST_OFF) + w * 2048;
#pragma unroll
    for (int rr = 0; rr < 16; ++rr) { const int orow = crow(rr, hi); const float rl = 1.0f / scr[orow];
#pragma unroll
        for (int d0 = 0; d0 < 2; ++d0) stg[orow * 64 + d0 * 32 + r32] = (bf16)(cvtpk(o[d0][rr] * rl, 0.f) & 0xffffu); }
    LDS_WAIT(); asm volatile("" ::: "memory");
    if (!FUSED) {
    bf16* Op = F.OPART + ((size_t)p * 32 + bh) * SEQ * 64;
#pragma unroll
    for (int i = 0; i < 4; ++i) { const int row = i * 8 + (lane >> 3), ch = lane & 7; const v4u v = *(const LAS v4u*)(stg + row * 64 + ch * 8);
        const int tok = ((256 * sb + 32 * w + row) << dsh) + r;
        *(GAS v4u*)(Op + (size_t)((tok & 15) * 512 + (tok >> 4)) * 64 + ch * 8) = v; }
    if (hi == 0) F.LSE[((size_t)p * 32 + bh) * SEQ + (qtk & 15) * 512 + (qtk >> 4)] = mx + log2f(ls);
    } else {
    bf16* Mp = F.MIXED + (size_t)(bh >> 3) * SEQ * DM + (bh & 7) * 64;
#pragma unroll
    for (int i = 0; i < 4; ++i) { const int row = i * 8 + (lane >> 3), ch = lane & 7; const v4u cq = *(const LAS v4u*)(stg + row * 64 + ch * 8);
        const int tok = 256 * sb + 32 * w + row; const float l2 = scr[32 + row], l0 = l0_[i], l1 = l1_[i];
        const float mxl = fmaxf(l0, fmaxf(l1, l2)); float w0 = __builtin_amdgcn_exp2f(l0 - mxl), w1 = __builtin_amdgcn_exp2f(l1 - mxl), w2 = __builtin_amdgcn_exp2f(l2 - mxl);
        const float inv = 1.0f / (w0 + w1 + w2); w0 *= inv; w1 *= inv; w2 *= inv;
        const v4u a = pa_[i], bq = pb_[i]; v4u ov;
        ov.x = cvtpk(w0 * bf_lo(a.x) + w1 * bf_lo(bq.x) + w2 * bf_lo(cq.x), w0 * bf_hi(a.x) + w1 * bf_hi(bq.x) + w2 * bf_hi(cq.x));
        ov.y = cvtpk(w0 * bf_lo(a.y) + w1 * bf_lo(bq.y) + w2 * bf_lo(cq.y), w0 * bf_hi(a.y) + w1 * bf_hi(bq.y) + w2 * bf_hi(cq.y));
        ov.z = cvtpk(w0 * bf_lo(a.z) + w1 * bf_lo(bq.z) + w2 * bf_lo(cq.z), w0 * bf_hi(a.z) + w1 * bf_hi(bq.z) + w2 * bf_hi(cq.z));
        ov.w = cvtpk(w0 * bf_lo(a.w) + w1 * bf_lo(bq.w) + w2 * bf_lo(cq.w), w0 * bf_hi(a.w) + w1 * bf_hi(bq.w) + w2 * bf_hi(cq.w));
        *(GAS v4u*)(Mp + (size_t)tok * DM + ch * 8) = ov; }
    }
    }
}

namespace ret {
constexpr int KRP = 192, VRP = 320;
constexpr int KV_K = 0, KV_V = 128 * KRP;
static_assert(KV_V + 128 * VRP <= RING_BYTES, "ret kv LDS");
constexpr int QRP = 144;
constexpr int O_QA = 0, O_QD = 128 * QRP, O_KA = 2 * 128 * QRP, O_VA = 3 * 128 * QRP, O_SA = O_VA + 128 * VRP, O_END = O_SA + 128 * QRP;
static_assert(O_END <= RING_BYTES, "ret out LDS");
constexpr int O_OUT = 0;
}
__device__ __forceinline__ void rot8(const v4u a, const v4u bq, const f32x2v* cs, float sc, v4u& o1, v4u& o2) {
    float x1[8], x2[8], y1[8], y2[8];
    x1[0] = bf_lo(a.x); x1[1] = bf_hi(a.x); x1[2] = bf_lo(a.y); x1[3] = bf_hi(a.y); x1[4] = bf_lo(a.z); x1[5] = bf_hi(a.z); x1[6] = bf_lo(a.w); x1[7] = bf_hi(a.w);
    x2[0] = bf_lo(bq.x); x2[1] = bf_hi(bq.x); x2[2] = bf_lo(bq.y); x2[3] = bf_hi(bq.y); x2[4] = bf_lo(bq.z); x2[5] = bf_hi(bq.z); x2[6] = bf_lo(bq.w); x2[7] = bf_hi(bq.w);
#pragma unroll
    for (int i = 0; i < 8; ++i) { const f32x2v c = cs[i]; y1[i] = (x1[i] * c.x - x2[i] * c.y) * sc; y2[i] = (x1[i] * c.y + x2[i] * c.x) * sc; }
    o1.x = cvtpk(y1[0], y1[1]); o1.y = cvtpk(y1[2], y1[3]); o1.z = cvtpk(y1[4], y1[5]); o1.w = cvtpk(y1[6], y1[7]);
    o2.x = cvtpk(y2[0], y2[1]); o2.y = cvtpk(y2[2], y2[3]); o2.z = cvtpk(y2[4], y2[5]); o2.w = cvtpk(y2[6], y2[7]);
}
__device__ __forceinline__ void retkv_unit(Frame& F, int u) {
    using namespace ret;
    const int tid = F.tid, lane = F.lane, w = F.wave, r32 = lane & 31, hi = lane >> 5;
    const int bh = u >> 6, n = u & 63, b = bh >> 2, h = bh & 3;
    LAS unsigned char* lds = F.lds + RING_OFF;
    const bf16* Kh = F.PROJ + ((size_t)56 << 20) + ((size_t)bh * SEQ + 128 * n) * 64;
    const bf16* Vh = F.PROJ + ((size_t)64 << 20) + ((size_t)bh * SEQ + 128 * n) * 128;
    const float lg = lg2gamma(h);
    __syncthreads();
    {
        const int j = tid >> 2, c = tid & 3, t = 128 * n + j;
        const bf16* src = Kh + (size_t)j * 64 + 8 * c;
        const v4u a = *(const GAS v4u*)src, bq = *(const GAS v4u*)(src + 32);
        f32x2v cs[8];
#pragma unroll
        for (int i = 0; i < 8; ++i) cs[i] = F.ROPE[t * 32 + 8 * c + i];
        v4u o1, o2; rot8(a, bq, cs, __builtin_amdgcn_exp2f(lg * (float)(127 - j)), o1, o2);
        *(LAS v4u*)(lds + KV_K + j * KRP + 16 * c) = o1; *(LAS v4u*)(lds + KV_K + j * KRP + 64 + 16 * c) = o2;
#pragma unroll
        for (int it = 0; it < 4; ++it) { const int idx = tid + NTHR * it, jj = idx >> 4, cc = idx & 15;
            *(LAS v4u*)(lds + KV_V + jj * VRP + 16 * cc) = *(const GAS v4u*)(Vh + (size_t)jj * 128 + 8 * cc); }
    }
    __syncthreads();
    const int dt = w & 1, et = w >> 1;
    f32x16 acc = (f32x16){0.f, 0.f, 0.f, 0.f, 0.f, 0.f, 0.f, 0.f, 0.f, 0.f, 0.f, 0.f, 0.f, 0.f, 0.f, 0.f};
    const int rq = 4 * hi + ((lane & 15) >> 2), cq = 16 * ((lane >> 4) & 1) + 4 * (lane & 3);
    const LAS unsigned char* ka = lds + KV_K + rq * KRP + (32 * dt + cq) * 2;
    const LAS unsigned char* va = lds + KV_V + rq * VRP + (32 * et + cq) * 2;
#pragma unroll
    for (int ks = 0; ks < 8; ++ks) {
        const bf16x8 af = mk8(tr16(ka + 16 * ks * KRP), tr16(ka + (16 * ks + 8) * KRP));
        const bf16x8 bfv = mk8(tr16(va + 16 * ks * VRP), tr16(va + (16 * ks + 8) * VRP));
        acc = __builtin_amdgcn_mfma_f32_32x32x16_bf16(af, bfv, acc, 0, 0, 0);
    }
    bf16* dst = F.KV + (size_t)u * 8192 + (size_t)(32 * et + r32) * 64 + 32 * dt + 4 * hi;
#pragma unroll
    for (int g4 = 0; g4 < 4; ++g4) { u32x2 o; o.x = cvtpk(acc[4 * g4], acc[4 * g4 + 1]); o.y = cvtpk(acc[4 * g4 + 2], acc[4 * g4 + 3]); *(GAS u32x2*)(dst + 8 * g4) = o; }
}

__device__ __forceinline__ void p3_scan(Frame& F) {
    if (F.tid < 256)
    for (int e = F.vcu * 256 + F.tid; e < 16 * 4096; e += F.G * 256) {
        const int bh = e >> 12, de2 = e & 4095; const float cd = __builtin_amdgcn_exp2f(lg2gamma(bh & 3) * 128.0f);
        GAS unsigned* p = (GAS unsigned*)(F.KV + (size_t)bh * 64 * 8192) + de2; float s0 = 0.f, s1 = 0.f;
        unsigned cur[64];
#pragma unroll
        for (int i = 0; i < 64; ++i) cur[i] = p[(size_t)i * 4096];
#pragma unroll
        for (int i = 0; i < 64; ++i) { p[(size_t)i * 4096] = cvtpk(s0, s1); s0 = cd * s0 + bf_lo(cur[i]); s1 = cd * s1 + bf_hi(cur[i]); }
    }
}

__device__ __forceinline__ void retout_unit(Frame& F, int u) {
    using namespace ret;
    const int tid = F.tid, lane = F.lane, w = F.wave, r32 = lane & 31, hi = lane >> 5;
    const int bh = u >> 6, n = u & 63, b = bh >> 2, h = bh & 3;
    LAS unsigned char* lds = F.lds + RING_OFF;
    const size_t row0 = (size_t)b * SEQ + 128 * n;
    const size_t hrow0 = (size_t)bh * SEQ + 128 * n;
    const bf16* Qh = F.PROJ + ((size_t)48 << 20) + hrow0 * 64; const bf16* Kh = F.PROJ + ((size_t)56 << 20) + hrow0 * 64;
    const bf16* Vh = F.PROJ + ((size_t)64 << 20) + hrow0 * 128; const bf16* Gh = F.PROJ + ((size_t)80 << 20) + hrow0 * 128;
    const float lg = lg2gamma(h);
    __syncthreads();
    {
        const int i = tid >> 2, c = tid & 3, t = 128 * n + i;
        f32x2v cs[8];
#pragma unroll
        for (int k = 0; k < 8; ++k) cs[k] = F.ROPE[t * 32 + 8 * c + k];
        const bf16* sq = Qh + (size_t)i * 64 + 8 * c;
        v4u a = *(const GAS v4u*)sq, bq = *(const GAS v4u*)(sq + 32), o1, o2;
        rot8(a, bq, cs, 1.0f, o1, o2);
        *(LAS v4u*)(lds + O_QA + i * QRP + 16 * c) = o1; *(LAS v4u*)(lds + O_QA + i * QRP + 64 + 16 * c) = o2;
        rot8(a, bq, cs, __builtin_amdgcn_exp2f(lg * (float)(i + 1)), o1, o2);
        *(LAS v4u*)(lds + O_QD + i * QRP + 16 * c) = o1; *(LAS v4u*)(lds + O_QD + i * QRP + 64 + 16 * c) = o2;
        const bf16* sk = Kh + (size_t)i * 64 + 8 * c;
        a = *(const GAS v4u*)sk; bq = *(const GAS v4u*)(sk + 32);
        rot8(a, bq, cs, 1.0f, o1, o2);
        *(LAS v4u*)(lds + O_KA + i * QRP + 16 * c) = o1; *(LAS v4u*)(lds + O_KA + i * QRP + 64 + 16 * c) = o2;
#pragma unroll
        for (int it = 0; it < 4; ++it) { const int idx = tid + NTHR * it, jj = idx >> 4, cc = idx & 15;
            *(LAS v4u*)(lds + O_VA + jj * VRP + 16 * cc) = *(const GAS v4u*)(Vh + (size_t)jj * 128 + 8 * cc); }
        const bf16* sp = F.KV + (size_t)u * 8192 + tid * 16; const int se = tid >> 2, sd = (tid & 3) * 16;
        const v4u q0 = *(const GAS v4u*)sp, q1 = *(const GAS v4u*)(sp + 8);
        *(LAS v4u*)(lds + O_SA + se * QRP + sd * 2) = q0; *(LAS v4u*)(lds + O_SA + se * QRP + sd * 2 + 16) = q1;
    }
    __syncthreads();
    const int qt = w & 3, eh = w >> 2;
    bf16x8 qf[4], qd[4];
#pragma unroll
    for (int ds = 0; ds < 4; ++ds) { qf[ds] = *(const LAS bf16x8*)(lds + O_QA + (32 * qt + r32) * QRP + (2 * ds + hi) * 16); qd[ds] = *(const LAS bf16x8*)(lds + O_QD + (32 * qt + r32) * QRP + (2 * ds + hi) * 16); }
    f32x16 o[2];
    o[0] = (f32x16){0.f, 0.f, 0.f, 0.f, 0.f, 0.f, 0.f, 0.f, 0.f, 0.f, 0.f, 0.f, 0.f, 0.f, 0.f, 0.f}; o[1] = o[0];
    const int rq = (lane & 15) >> 2, cq = 16 * ((lane >> 4) & 1) + 4 * (lane & 3);
#pragma unroll
    for (int kt = 0; kt < 4; ++kt) if (kt <= qt) {
        f32x16 pt = (f32x16){0.f, 0.f, 0.f, 0.f, 0.f, 0.f, 0.f, 0.f, 0.f, 0.f, 0.f, 0.f, 0.f, 0.f, 0.f, 0.f};
#pragma unroll
        for (int ds = 0; ds < 4; ++ds) { const bf16x8 kf = *(const LAS bf16x8*)(lds + O_KA + (32 * kt + r32) * QRP + (2 * ds + hi) * 16);
            pt = __builtin_amdgcn_mfma_f32_32x32x16_bf16(kf, qf[ds], pt, 0, 0, 0); }
#pragma unroll
        for (int rr = 0; rr < 16; ++rr) { const int dd = (32 * qt + r32) - (32 * kt + crow(rr, hi)); pt[rr] = (dd >= 0) ? pt[rr] * __builtin_amdgcn_exp2f(lg * (float)dd) : 0.f; }
#pragma unroll
        for (int s = 0; s < 2; ++s) {
            v4u pw; pw.x = cvtpk(pt[8 * s + 0], pt[8 * s + 1]); pw.y = cvtpk(pt[8 * s + 2], pt[8 * s + 3]); pw.z = cvtpk(pt[8 * s + 4], pt[8 * s + 5]); pw.w = cvtpk(pt[8 * s + 6], pt[8 * s + 7]);
            const bf16x8 pa = __builtin_bit_cast(bf16x8, pw);
#pragma unroll
            for (int d0 = 0; d0 < 2; ++d0) { const LAS unsigned char* vp = lds + O_VA + (32 * kt + 16 * s + 4 * hi + rq) * VRP + (64 * eh + 32 * d0 + cq) * 2;
                o[d0] = __builtin_amdgcn_mfma_f32_32x32x16_bf16(pa, mk8(tr16(vp), tr16(vp + 8 * VRP)), o[d0], 0, 0, 0); }
        }
    }
#pragma unroll
    for (int ds = 0; ds < 4; ++ds)
#pragma unroll
        for (int d0 = 0; d0 < 2; ++d0) { const bf16x8 sf = *(const LAS bf16x8*)(lds + O_SA + (64 * eh + 32 * d0 + r32) * QRP + (2 * ds + hi) * 16);
            o[d0] = __builtin_amdgcn_mfma_f32_32x32x16_bf16(qd[ds], sf, o[d0], 0, 0, 0); }
    __syncthreads();
    LAS float* outl = (LAS float*)(lds + O_OUT);
#pragma unroll
    for (int rr = 0; rr < 16; ++rr)
#pragma unroll
        for (int d0 = 0; d0 < 2; ++d0) outl[(32 * qt + crow(rr, hi)) * 128 + 64 * eh + 32 * d0 + r32] = o[d0][rr];
    __syncthreads();
    {
        const int i = tid >> 2, part = tid & 3;
        float v[32]; float ss = 0.f;
#pragma unroll
        for (int k = 0; k < 8; ++k) { const f32x4 t4 = *(const LAS f32x4*)(outl + i * 128 + 32 * part + 4 * k); v[4 * k] = t4.x; v[4 * k + 1] = t4.y; v[4 * k + 2] = t4.z; v[4 * k + 3] = t4.w; ss += (t4.x * t4.x + t4.y * t4.y) + (t4.z * t4.z + t4.w * t4.w); }
        ss += __shfl_xor(ss, 1); ss += __shfl_xor(ss, 2);
        const float rstd = 1.0f / sqrtf(ss * (1.0f / 128.0f) + NORM_EPS);
        const bf16* gp = Gh + (size_t)i * 128 + 32 * part;
        bf16* op = F.MIXED + (row0 + i) * DM + 512 + h * 128 + 32 * part;
#pragma unroll
        for (int k = 0; k < 4; ++k) { const v4u g = *(const GAS v4u*)(gp + 8 * k); float gv[8];
            gv[0] = bf_lo(g.x); gv[1] = bf_hi(g.x); gv[2] = bf_lo(g.y); gv[3] = bf_hi(g.y); gv[4] = bf_lo(g.z); gv[5] = bf_hi(g.z); gv[6] = bf_lo(g.w); gv[7] = bf_hi(g.w);
            float ov[8];
#pragma unroll
            for (int q = 0; q < 8; ++q) { const float sg = gv[q] * __builtin_amdgcn_rcpf(1.0f + __builtin_amdgcn_exp2f(-1.4426950408889634f * gv[q])); ov[q] = v[8 * k + q] * rstd * sg; }
            v4u ow; ow.x = cvtpk(ov[0], ov[1]); ow.y = cvtpk(ov[2], ov[3]); ow.z = cvtpk(ov[4], ov[5]); ow.w = cvtpk(ov[6], ov[7]);
            *(GAS v4u*)(op + 8 * k) = ow; }
    }
}

__device__ __forceinline__ void load_bf16_row(const bf16* row, int lane, f32x4 (&v)[4]) {
    const GAS u32x2* p = (const GAS u32x2*)row + lane;
#pragma unroll
    for (int j = 0; j < 4; ++j) { const u32x2 w = p[64 * j]; v[j] = (f32x4){bf_lo(w.x), bf_hi(w.x), bf_lo(w.y), bf_hi(w.y)}; }
}
__device__ __forceinline__ float sumsq4(const f32x4 (&v)[4]) { float s = 0.f;
#pragma unroll
    for (int j = 0; j < 4; ++j) s += (v[j].x * v[j].x + v[j].y * v[j].y) + (v[j].z * v[j].z + v[j].w * v[j].w);
    return s; }
__device__ __forceinline__ void p6_resnorm(Frame& F) {
    constexpr int R = 4;
    const int gw = F.vcu * NWAVES + F.wave, NGW = F.G * NWAVES, lane = F.lane;
    const GAS f32x4* g2 = (const GAS f32x4*)F.g_post + lane; const GAS f32x4* g3 = (const GAS f32x4*)F.g_fpre + lane;
    for (int m0 = gw * R; m0 < M; m0 += NGW * R) {
        f32x4 a[R][4], xv[R][4];
#pragma unroll
        for (int r = 0; r < R; ++r) { load_bf16_row(F.MIX + (size_t)(m0 + r) * DM, lane, a[r]); const GAS f32x4* xr = (const GAS f32x4*)(F.x + (size_t)(m0 + r) * DM) + lane;
#pragma unroll
            for (int j = 0; j < 4; ++j) xv[r][j] = xr[64 * j]; }
        float s[R];
#pragma unroll
        for (int r = 0; r < R; ++r) s[r] = sumsq4(a[r]);
#pragma unroll
        for (int o = 1; o < 64; o <<= 1) {
#pragma unroll
            for (int r = 0; r < R; ++r) s[r] += __shfl_xor(s[r], o); }
#pragma unroll
        for (int r = 0; r < R; ++r) { const float r2 = 1.f / sqrtf(s[r] * (1.f / DM) + NORM_EPS); GAS unsigned long long* x1b = (GAS unsigned long long*)(F.MIX + (size_t)(m0 + r) * DM) + lane;
#pragma unroll
            for (int j = 0; j < 4; ++j) { a[r][j] = xv[r][j] + a[r][j] * r2 * g2[64 * j];
                x1b[64 * j] = (unsigned long long)cvtpk(a[r][j].x, a[r][j].y) | ((unsigned long long)cvtpk(a[r][j].z, a[r][j].w) << 32); }
            s[r] = sumsq4(a[r]); }
#pragma unroll
        for (int o = 1; o < 64; o <<= 1) {
#pragma unroll
            for (int r = 0; r < R; ++r) s[r] += __shfl_xor(s[r], o); }
#pragma unroll
        for (int r = 0; r < R; ++r) { const float r3 = 1.f / sqrtf(s[r] * (1.f / DM) + NORM_EPS); GAS unsigned long long* o8 = (GAS unsigned long long*)(F.XN + (size_t)(m0 + r) * DM) + lane;
#pragma unroll
            for (int j = 0; j < 4; ++j) { const f32x4 g = g3[64 * j]; o8[64 * j] = (unsigned long long)cvtpk(a[r][j].x * r3 * g.x, a[r][j].y * r3 * g.y) | ((unsigned long long)cvtpk(a[r][j].z * r3 * g.z, a[r][j].w * r3 * g.w) << 32); } }
    }
}
__device__ __forceinline__ void p10_final(Frame& F, const float dscale, const float dadd) {
    constexpr int R = 4;
    const int gw = F.vcu * NWAVES + F.wave, NGW = F.G * NWAVES, lane = F.lane;
    const GAS f32x4* g4 = (const GAS f32x4*)F.g_fpost + lane;
    for (int m0 = gw * R; m0 < M; m0 += NGW * R) {
        f32x4 a[R][4], xv[R][4];
#pragma unroll
        for (int r = 0; r < R; ++r) { load_bf16_row(F.FFN + (size_t)(m0 + r) * DM, lane, a[r]); load_bf16_row(F.MIX + (size_t)(m0 + r) * DM, lane, xv[r]); }
        float s[R];
#pragma unroll
        for (int r = 0; r < R; ++r) s[r] = sumsq4(a[r]);
#pragma unroll
        for (int o = 1; o < 64; o <<= 1) {
#pragma unroll
            for (int r = 0; r < R; ++r) s[r] += __shfl_xor(s[r], o); }
#pragma unroll
        for (int r = 0; r < R; ++r) { const float r4 = 1.f / sqrtf(s[r] * (1.f / DM) + NORM_EPS); GAS f32x4* orow = (GAS f32x4*)(F.out + (size_t)(m0 + r) * DM) + lane;
#pragma unroll
            for (int j = 0; j < 4; ++j) { f32x4 o = (xv[r][j] + a[r][j] * r4 * g4[64 * j]) * dscale; if (m0 + r == 0 && lane == 0 && j == 0) o.x += dadd; orow[64 * j] = o; } }
    }
}
__device__ __forceinline__ void p8_fixup(Frame& F) {
    for (int it = F.vcu * NTHR + F.tid; it < (M / 64) * 2 * (FF / 4); it += F.G * NTHR) {
        const int ri = it / (FF / 4), j = (it % (FF / 4)) * 4, g = ri >> 1, which = ri & 1; const bool first = (g % (SEQ / 64)) == 0;
        f32x4 y[2];
#pragma unroll
        for (int hf = 0; hf < 2; ++hf) {
            const bf16* ubg = F.UB + ((size_t)g * 8 + hf) * FF + j;
            const bf16* ubp = ubg - (size_t)8 * FF;
            const int c = hf * FF + j;
            const u32x2 z = {0u, 0u};
            const u32x2 wt = *(const GAS u32x2*)(ubg + (size_t)(2 + which) * 2 * FF);
            const u32x2 w1 = which ? *(const GAS u32x2*)(ubg + (size_t)2 * 2 * FF) : (first ? z : *(const GAS u32x2*)(ubp + (size_t)1 * 2 * FF));
            const u32x2 w2 = first ? z : (which ? *(const GAS u32x2*)(ubp + (size_t)1 * 2 * FF) : *(const GAS u32x2*)ubp);
            const f32x4 ut = {bf_lo(wt.x), bf_hi(wt.x), bf_lo(wt.y), bf_hi(wt.y)}, u1 = {bf_lo(w1.x), bf_hi(w1.x), bf_lo(w1.y), bf_hi(w1.y)}, u2 = {bf_lo(w2.x), bf_hi(w2.x), bf_lo(w2.y), bf_hi(w2.y)};
            y[hf] = *(const GAS f32x4*)(F.conv_b + c) + *(const GAS f32x4*)(F.conv_w + 2 * FF2 + c) * ut + *(const GAS f32x4*)(F.conv_w + FF2 + c) * u1 + *(const GAS f32x4*)(F.conv_w + c) * u2;
        }
        u32x2 o; o.x = cvtpk(pg8::gelu_tanh_f(y[0].x) * y[1].x, pg8::gelu_tanh_f(y[0].y) * y[1].y); o.y = cvtpk(pg8::gelu_tanh_f(y[0].z) * y[1].z, pg8::gelu_tanh_f(y[0].w) * y[1].w);
        *(GAS u32x2*)(F.ACT + (size_t)(64 * g + which) * FF + j) = o;
    }
}

struct Args { const float* in[11]; float* out; unsigned char* ws; int ph_lo, ph_hi, li, pad; };
__global__ void __launch_bounds__(NTHR, 2) mk_fwd(Args args) {
    extern __shared__ __attribute__((aligned(16))) unsigned char lds[];
    Frame F;
    F.lds = (LAS unsigned char*)lds;
    F.MISC = (volatile LAS unsigned*)(F.lds + MISC_OFF);
    F.tid = threadIdx.x; F.lane = F.tid & 63; F.wave = __builtin_amdgcn_readfirstlane(F.tid >> 6);
    F.G = gridDim.x; { const int bx = blockIdx.x; F.vcu = (F.G % 8 == 0) ? (bx % 8) * (F.G / 8) + bx / 8 : bx; }
    unsigned char* ws = args.ws;
    F.ctl = (gu32*)(ws + WS_CTL);
    F.x = args.in[0]; F.g_pre = args.in[1]; F.g_post = args.in[2]; F.w_in = args.in[3]; F.w_out = args.in[4]; F.g_fpre = args.in[5]; F.g_fpost = args.in[6];
    F.w_up = args.in[7]; F.conv_w = args.in[8]; F.conv_b = args.in[9]; F.w_down = args.in[10]; F.out = args.out;
    F.Win_t = (bf16*)(ws + WS_WIN); F.Wout_t = (bf16*)(ws + WS_WOUT); F.Wup_t = (bf16*)(ws + WS_WUP); F.Wdn_t = (bf16*)(ws + WS_WDN);
    F.XN = (bf16*)(ws + WS_XN); F.PROJ = (bf16*)(ws + WS_PROJ); F.ACT = (bf16*)(ws + WS_ACT); F.OPART = (bf16*)(ws + WS_OPART); F.MIX = (bf16*)(ws + WS_MIX);
    F.FFN = (bf16*)(ws + WS_FFN); F.MIXED = (bf16*)(ws + WS_MIXED); F.LSE = (float*)(ws + WS_LSE); F.UB = (bf16*)(ws + WS_UB); F.KV = (bf16*)(ws + WS_KV);
    F.ROPE = (f32x2v*)(ws + WS_ROPE);
    for (int u = F.tid; u < (LDS_BYTES - LDSCTL_OFF) / 4; u += NTHR) ((LAS unsigned*)(F.lds + LDSCTL_OFF))[u] = 0u;
    __syncthreads();
    XcdBarrier bar; bar.bar = (unsigned*)(F.ctl + CW_BAR) + args.li * XCD_BAR_WORDS; bar.x = 0; bar.st = nullptr;
    const int lo = args.ph_lo, hi = args.ph_hi;
    if (hi - lo > 1) bar = xcd_barrier_post((unsigned*)(F.ctl + CW_BAR) + args.li * XCD_BAR_WORDS, F.MISC + 8);
#define IN(k) (lo <= (k) && (k) < hi)
#ifndef MK_STAG_US
#define MK_STAG_US 0
#endif
#define STAGGER(us) do { if ((us) > 0 && (blockIdx.x & 1)) { const unsigned long long t0_ = __builtin_amdgcn_s_memrealtime(); while (__builtin_amdgcn_s_memrealtime() - t0_ < (unsigned long long)((us) * 100)) __builtin_amdgcn_s_sleep(8); } } while (0)
#ifndef MK_REP_MASK
#define MK_REP_MASK 0
#endif
#define REPEAT(k) _Pragma("unroll") for (int rep_ = 0, nrep_ = ((MK_REP_MASK >> (k)) & 1) ? 2 : 1; rep_ < nrep_; ++rep_)
#define REPSYNC(k) do { if (rep_ + 1 < nrep_) xcd_barrier(bar); } while (0)
#ifdef MK_DIAG_A
    unsigned long long* const tsb = (unsigned long long*)(ws + WS_CTL + 32768);
    if (blockIdx.x == 0 && F.tid == 0) tsb[0] = __builtin_amdgcn_s_memrealtime();
#define SEAM(k) do { if (IN(k) && IN((k) + 1)) { xcd_barrier(bar); if (blockIdx.x == 0 && F.tid == 0) { tsb[(k) + 1] = __builtin_amdgcn_s_memrealtime(); asm volatile("s_waitcnt vmcnt(0)" ::: "memory"); } } } while (0)
#else
#define SEAM(k) do { if (IN(k) && IN((k) + 1)) xcd_barrier(bar); } while (0)
#endif

    if (IN(0)) { REPEAT(0) { p0_prep(F); REPSYNC(0); } SEAM(0); }
    if (IN(1)) {
        pg8::Gemm g{F.XN, F.Win_t, M, INW, DM}; pg8::StaticOrder S; S.init(M, INW, F.G, (int)blockIdx.x);
        pg8::EpiProj E{F.PROJ, QSCALE};
        STAGGER(MK_STAG_US);
#ifdef MK_NULL_G1
        { pg8::EpiNull EN; pg8::gemm_phase<pg8::EpiNull, pg8::StaticOrder, MK_ALIGN, MK_SP2>(F.lds + RING_OFF, g, S, EN); xcd_barrier(bar); }
#endif
        REPEAT(1) { pg8::gemm_phase<pg8::EpiProj, pg8::StaticOrder, MK_ALIGN, MK_SP2>(F.lds + RING_OFF, g, S, E); REPSYNC(1); }
        SEAM(1);
    }
    if (IN(2)) { REPEAT(2) {
        { const int NU = 2 * 1024; const int u0 = (int)((long)F.vcu * NU / F.G), u1 = (int)((long)(F.vcu + 1) * NU / F.G); attn_units<false>(F, u0, u1); }
        { const int NU = 1024; const int u0 = (int)((long)F.vcu * NU / F.G), u1 = (int)((long)(F.vcu + 1) * NU / F.G); for (int u = u0; u < u1; ++u) retkv_unit(F, u); }
        __syncthreads(); REPSYNC(2); }
        SEAM(2);
    }
    if (IN(3)) { p3_scan(F);
        { const int NU = 1024; const int u0 = (int)((long)F.vcu * NU / F.G), u1 = (int)((long)(F.vcu + 1) * NU / F.G); attn_units<true>(F, u0, u1); }
        __syncthreads();
        SEAM(3); }
    if (IN(4)) { REPEAT(4) {
        { const int NU = 1024; const int u0 = (int)((long)F.vcu * NU / F.G), u1 = (int)((long)(F.vcu + 1) * NU / F.G); for (int u = u0; u < u1; ++u) retout_unit(F, u); }
        __syncthreads(); REPSYNC(4); }
        SEAM(4);
    }
    if (IN(5)) {
        pg8::Gemm g{F.MIXED, F.Wout_t, M, DM, DM}; pg8::StaticOrder S; S.init(M, DM, F.G, (int)blockIdx.x);
        pg8::EpiStore E{F.MIX, DM, 0, 1.0f, -1, 1.0f};
        STAGGER(MK_STAG_US);
        REPEAT(5) { pg8::gemm_phase<pg8::EpiStore, pg8::StaticOrder, MK_ALIGN, MK_SP2>(F.lds + RING_OFF, g, S, E); REPSYNC(5); }
        SEAM(5);
    }
    if (IN(6)) { REPEAT(6) { p6_resnorm(F); REPSYNC(6); } SEAM(6); }
    if (IN(7)) {
        pg8::Gemm g{F.XN, F.Wup_t, M, FF2, DM}; pg8::StaticOrder S; S.init(M, FF2, F.G, (int)blockIdx.x);
        pg8::EpiConvAct E{F.ACT, F.UB, F.conv_w, F.conv_b};
        STAGGER(MK_STAG_US);
        REPEAT(7) { pg8::gemm_phase<pg8::EpiConvAct, pg8::StaticOrder, MK_ALIGN, MK_SP2>(F.lds + RING_OFF, g, S, E); REPSYNC(7); }
        SEAM(7);
    }
    if (IN(8)) { REPEAT(8) { p8_fixup(F); REPSYNC(8); } SEAM(8); }
    if (IN(9)) {
        pg8::Gemm g{F.ACT, F.Wdn_t, M, DM, FF}; pg8::StaticOrder S; S.init(M, DM, F.G, (int)blockIdx.x);
        pg8::EpiStore E{F.FFN, DM, 0, 1.0f, -1, 1.0f};
        STAGGER(MK_STAG_US);
        REPEAT(9) { pg8::gemm_phase<pg8::EpiStore, pg8::StaticOrder, MK_ALIGN, MK_SP2>(F.lds + RING_OFF, g, S, E); REPSYNC(9); }
        SEAM(9);
    }
#ifdef MK_DIAG_A
    if (IN(10)) { const unsigned long long* tsr = (const unsigned long long*)(ws + WS_CTL + 32768);
        const float dA = (float)(__hip_atomic_load(tsr + MK_DIAG_A + 1, __ATOMIC_RELAXED, __HIP_MEMORY_SCOPE_AGENT) - __hip_atomic_load(tsr + MK_DIAG_A, __ATOMIC_RELAXED, __HIP_MEMORY_SCOPE_AGENT)) * 0.01f;
        const float dB = (float)(__hip_atomic_load(tsr + MK_DIAG_B + 1, __ATOMIC_RELAXED, __HIP_MEMORY_SCOPE_AGENT) - __hip_atomic_load(tsr + MK_DIAG_B, __ATOMIC_RELAXED, __HIP_MEMORY_SCOPE_AGENT)) * 0.01f;
        (void)dA; p10_final(F, 1.0f, dB * (1.0f / 32.0f)); }
#else
    if (IN(10)) { REPEAT(10) { p10_final(F, 1.0f, 0.0f); REPSYNC(10); } }
#endif
#undef IN
#undef SEAM
}

extern "C" void kernel_launch(void* const* d_in, const int* in_sizes, int n_in, void* d_out, int out_size, void* d_ws, size_t ws_size, hipStream_t stream) {
    static int grid = 0;
    if (grid == 0) {
        if (n_in != 11 || in_sizes[0] != M * DM || out_size != M * DM || ws_size < WS_END) { fprintf(stderr, "kernel_launch: unexpected shapes (n_in %d in0 %d out %d ws %zu); nothing launched\n", n_in, n_in > 0 ? in_sizes[0] : -1, out_size, ws_size); grid = -1; return; }
        int dev = 0, cus = 0, per_cu = 0;
        if (hipGetDevice(&dev) != hipSuccess || hipDeviceGetAttribute(&cus, hipDeviceAttributeMultiprocessorCount, dev) != hipSuccess) { grid = -1; return; }
        if (hipFuncSetAttribute((const void*)mk_fwd, hipFuncAttributeMaxDynamicSharedMemorySize, LDS_BYTES) != hipSuccess) { fprintf(stderr, "kernel_launch: hipFuncSetAttribute failed\n"); grid = -1; return; }
        if (hipOccupancyMaxActiveBlocksPerMultiprocessor(&per_cu, (const void*)mk_fwd, NTHR, LDS_BYTES) != hipSuccess || per_cu < 1) fprintf(stderr, "kernel_launch: occupancy query says %d blocks per CU\n", per_cu);
        (void)hipGetLastError();
        grid = cus;
    }
    if (grid < 0) return;
    if (hipMemsetAsync((char*)d_ws + WS_CTL, 0, CTL_ZERO_BYTES, stream) != hipSuccess) return;
    Args a{};
    for (int i = 0; i < 11; ++i) a.in[i] = (const float*)d_in[i];
    a.out = (float*)d_out; a.ws = (unsigned char*)d_ws;
#if MK_N_LAUNCHES == 1
    a.ph_lo = 0; a.ph_hi = N_PHASES; a.li = 0;
    hipLaunchKernelGGL(mk_fwd, dim3(grid), dim3(NTHR), LDS_BYTES, stream, a);
#else
    for (int li = 0; li < N_PHASES; ++li) { a.ph_lo = li; a.ph_hi = li + 1; a.li = 0; hipLaunchKernelGGL(mk_fwd, dim3(grid), dim3(NTHR), LDS_BYTES, stream, a); }
#endif
}
```
